# Optimizing an MI355X kernel written in HIP

```python
import jax, jax.numpy as jnp
from jax import lax
import numpy as np

D_MODEL = 1024
BATCH = 4
SEQ = 8192
DEPTH = 2

GRID_W = 64
M_HEADS = 4
M_HEAD_DIM = 128
M_WIDTH = M_HEADS * M_HEAD_DIM
M_CHUNK = 128
CONV_W = 3
A_HEADS = 8
A_KV_HEADS = 2
A_HEAD_DIM = 64
A_WIDTH = A_HEADS * A_HEAD_DIM
A_KV_WIDTH = A_KV_HEADS * A_HEAD_DIM
Q_BLOCK = 128
ROPE_THETA = 10000.0
AXIS_DIM = A_HEAD_DIM // 2
D_MIX = M_WIDTH + A_WIDTH
N_GATES = 4 * M_HEADS
P_IN = 4 * M_WIDTH + N_GATES + A_WIDTH + 2 * A_KV_WIDTH
N_GROUPS = 4
EXP_PER_GROUP = 8
N_EXPERTS = N_GROUPS * EXP_PER_GROUP
TOP_K = 2
D_EXPERT = D_MODEL // 2
MOE_BLOCK = 128
NORM_EPS = 1e-6

kernel_name = "hymba_mlstm_axialgqa_hiermoe_encoder"


def rmsnorm(x, g):
    xf = x.astype(jnp.float32)
    y = xf * lax.rsqrt(jnp.mean(xf * xf, axis=-1, keepdims=True) + NORM_EPS)
    return (y * g).astype(x.dtype)


def centred_dwconv(x, w, b):
    c = x.shape[-1]
    y = lax.conv_general_dilated(
        x, w[:, None, :].astype(x.dtype), window_strides=(1,),
        padding=[(CONV_W // 2, CONV_W // 2)],
        dimension_numbers=("NWC", "WIO", "NWC"), feature_group_count=c)
    return y + b.astype(x.dtype)


def axial_rope_tables(seq_len):
    rows_n = seq_len // GRID_W
    row = jnp.repeat(jnp.arange(rows_n, dtype=jnp.float32), GRID_W)
    col = jnp.tile(jnp.arange(GRID_W, dtype=jnp.float32), rows_n)
    inv = ROPE_THETA ** (-jnp.arange(0, AXIS_DIM, 2, dtype=jnp.float32) / AXIS_DIM)
    ar = row[:, None] * inv
    ac = col[:, None] * inv
    ang = jnp.concatenate([ar, ar, ac, ac], axis=-1)
    return jnp.cos(ang), jnp.sin(ang)


def axial_rope(t, cos, sin):
    tf = t.astype(jnp.float32)
    tr = tf.reshape(*t.shape[:-1], 2, 2, AXIS_DIM // 2)
    rot = jnp.stack([-tr[..., 1, :], tr[..., 0, :]], axis=-2).reshape(t.shape)
    return (tf * cos[None, :, None, :] + rot * sin[None, :, None, :]).astype(t.dtype)


def head_rmsnorm(t, g):
    tf = t.astype(jnp.float32)
    y = tf * lax.rsqrt(jnp.mean(tf * tf, axis=-1, keepdims=True) + NORM_EPS)
    return (y * g).astype(t.dtype)


def mlstm_chunkwise(q, k, v, ig, lf):
    f32 = jnp.float32
    bsz, nh, s, dh = q.shape
    nc, L = s // M_CHUNK, M_CHUNK
    q = q.astype(f32).reshape(bsz, nh, nc, L, dh) * (dh ** -0.5)
    k = k.astype(f32).reshape(bsz, nh, nc, L, dh)
    v = v.astype(f32).reshape(bsz, nh, nc, L, dh)
    ig = ig.reshape(bsz, nh, nc, L)
    lf = lf.reshape(bsz, nh, nc, L)
    b = jnp.cumsum(lf, axis=-1)
    b_last = b[..., -1]
    a = b_last[..., None] - b + ig
    m_loc = jnp.max(a, axis=-1)
    w_loc = jnp.exp(a - m_loc[..., None])
    c_loc = jnp.einsum('bhnlk,bhnlv->bhnkv', k * w_loc[..., None], v)
    n_loc = jnp.einsum('bhnl,bhnlk->bhnk', w_loc, k)

    def step(carry, inp):
        c, n, m = carry
        cl, nl, ml, bl = inp
        m_new = jnp.maximum(bl + m, ml)
        d_old = jnp.exp(bl + m - m_new)
        d_new = jnp.exp(ml - m_new)
        c_new = d_old[..., None, None] * c + d_new[..., None, None] * cl
        n_new = d_old[..., None] * n + d_new[..., None] * nl
        return (c_new, n_new, m_new), (c, n, m)

    init = (jnp.zeros((bsz, nh, dh, dh), f32), jnp.zeros((bsz, nh, dh), f32),
            jnp.zeros((bsz, nh), f32))
    xs = (jnp.moveaxis(c_loc, 2, 0), jnp.moveaxis(n_loc, 2, 0),
          jnp.moveaxis(m_loc, 2, 0), jnp.moveaxis(b_last, 2, 0))
    _, (c_prev, n_prev, m_prev) = lax.scan(step, init, xs)
    c_prev = jnp.moveaxis(c_prev, 0, 2)
    n_prev = jnp.moveaxis(n_prev, 0, 2)
    m_prev = jnp.moveaxis(m_prev, 0, 2)

    lower = jnp.tril(jnp.ones((L, L), dtype=bool))
    dmat = jnp.where(lower, b[..., :, None] - b[..., None, :] + ig[..., None, :], -jnp.inf)
    m_inter = b + m_prev[..., None]
    m_i = jnp.maximum(jnp.max(dmat, axis=-1), m_inter)
    s_intra = jnp.einsum('bhnik,bhnjk->bhnij', q, k) * jnp.exp(dmat - m_i[..., None])
    inter = jnp.exp(m_inter - m_i)
    num = (jnp.einsum('bhnij,bhnjv->bhniv', s_intra, v)
           + inter[..., None] * jnp.einsum('bhnik,bhnkv->bhniv', q, c_prev))
    den = jnp.sum(s_intra, axis=-1) + inter * jnp.einsum('bhnik,bhnk->bhni', q, n_prev)
    h = num / jnp.maximum(jnp.abs(den), jnp.exp(-m_i))[..., None]
    return h.reshape(bsz, nh, s, dh)


def bidir_block_attention(q, k, v):
    bsz, s, nh, dh = q.shape
    g = nh // A_KV_HEADS
    nqb = s // Q_BLOCK
    qb = q.reshape(bsz, nqb, Q_BLOCK, A_KV_HEADS, g, dh).transpose(1, 0, 2, 3, 4, 5)
    scale = dh ** -0.5

    def one_block(qblk):
        sc = jnp.einsum('bqkgd,bskd->bkgqs', qblk, k).astype(jnp.float32) * scale
        p = jax.nn.softmax(sc, axis=-1).astype(v.dtype)
        return jnp.einsum('bkgqs,bskd->bqkgd', p, v)

    o = lax.map(one_block, qb)
    return o.transpose(1, 0, 2, 3, 4, 5).reshape(bsz, s, nh * dh)


def mixer_layer(x, cos, sin, n1, w_in, conv_w, conv_b, gate_b, m_norm_g, qn_g, kn_g, w_out):
    bsz, s, _ = x.shape
    h = rmsnorm(x, n1)
    proj = h @ w_in
    cuts = [M_WIDTH, 2 * M_WIDTH, 3 * M_WIDTH, 4 * M_WIDTH, 4 * M_WIDTH + N_GATES,
            4 * M_WIDTH + N_GATES + A_WIDTH, 4 * M_WIDTH + N_GATES + A_WIDTH + A_KV_WIDTH]
    mq, mk, mv, mo, mg, aq, ak, av = jnp.split(proj, cuts, axis=-1)

    qk = jax.nn.silu(centred_dwconv(jnp.concatenate([mq, mk], axis=-1), conv_w, conv_b))
    mq, mk = jnp.split(qk, 2, axis=-1)
    gates = mg.astype(jnp.float32).reshape(bsz, s, 4, M_HEADS) + gate_b.astype(jnp.float32)
    i_f, f_f, i_b, f_b = jnp.transpose(gates, (2, 0, 3, 1))

    def heads(t):
        return t.reshape(bsz, s, M_HEADS, M_HEAD_DIM).transpose(0, 2, 1, 3)

    def flip(t):
        return jnp.flip(t, axis=2)

    q, k, v = heads(mq), heads(mk), heads(mv)
    h_fwd = mlstm_chunkwise(q, k, v, i_f, jax.nn.log_sigmoid(f_f))
    h_bwd = flip(mlstm_chunkwise(flip(q), flip(k), flip(v), flip(i_b),
                                 flip(jax.nn.log_sigmoid(f_b))))
    hm = h_fwd + h_bwd
    hm = hm * lax.rsqrt(jnp.mean(hm * hm, axis=-1, keepdims=True) + NORM_EPS)
    hm = hm.transpose(0, 2, 1, 3).reshape(bsz, s, M_WIDTH) * m_norm_g.astype(jnp.float32)
    hm = (hm * jax.nn.sigmoid(mo.astype(jnp.float32))).astype(x.dtype)

    aq = aq.reshape(bsz, s, A_HEADS, A_HEAD_DIM)
    ak = ak.reshape(bsz, s, A_KV_HEADS, A_HEAD_DIM)
    av = av.reshape(bsz, s, A_KV_HEADS, A_HEAD_DIM)
    aq = axial_rope(head_rmsnorm(aq, qn_g), cos, sin)
    ak = axial_rope(head_rmsnorm(ak, kn_g), cos, sin)
    ha = bidir_block_attention(aq, ak, av).astype(x.dtype)

    return x + jnp.concatenate([hm, ha], axis=-1) @ w_out


def hier_moe(xn, wg, bg, we, be, w1, w3, w2):
    bsz, s, d = xn.shape
    n = bsz * s
    xf = xn.reshape(n, d)
    gprob = jax.nn.softmax((xf @ wg).astype(jnp.float32) + bg.astype(jnp.float32), axis=-1)
    gval, gidx = lax.top_k(gprob, 1)
    elog = ((xf @ we).astype(jnp.float32) + be.astype(jnp.float32)).reshape(n, N_GROUPS, EXP_PER_GROUP)
    elog_sel = jnp.take_along_axis(elog, gidx[:, :, None], axis=1)[:, 0]
    evals, eidx = lax.top_k(elog_sel, TOP_K)
    ew = jax.nn.softmax(evals, axis=-1) * gval
    expert = gidx * EXP_PER_GROUP + eidx

    flat_e = expert.reshape(-1)
    flat_w = ew.reshape(-1)
    flat_tok = jnp.repeat(jnp.arange(n, dtype=jnp.int32), TOP_K)
    order = jnp.argsort(flat_e)
    se = flat_e[order]
    counts = jax.ops.segment_sum(jnp.ones_like(flat_e), flat_e, num_segments=N_EXPERTS)
    padded = (counts + MOE_BLOCK - 1) // MOE_BLOCK * MOE_BLOCK
    pad_end = jnp.cumsum(padded)
    pad_start = pad_end - padded
    start = jnp.cumsum(counts) - counts
    rank = jnp.arange(n * TOP_K, dtype=jnp.int32)
    dest = pad_start[se] + rank - start[se]
    m_rows = n * TOP_K + N_EXPERTS * MOE_BLOCK
    nblk = m_rows // MOE_BLOCK
    buf_tok = jnp.full((m_rows,), n, dtype=jnp.int32).at[dest].set(flat_tok[order])
    buf_w = jnp.zeros((m_rows,), jnp.float32).at[dest].set(flat_w[order])
    blk_e = jnp.clip(jnp.searchsorted(pad_end, jnp.arange(nblk, dtype=jnp.int32) * MOE_BLOCK,
                                      side='right'), 0, N_EXPERTS - 1)
    xpad = jnp.concatenate([xf, jnp.zeros((1, d), xf.dtype)], axis=0)
    xb = xpad[buf_tok].reshape(nblk, MOE_BLOCK, d)

    def expert_block(args):
        xblk, e = args
        hid = jax.nn.silu(xblk @ w1[e]) * (xblk @ w3[e])
        return hid @ w2[e]

    yb = lax.map(expert_block, (xb, blk_e)).reshape(m_rows, d)
    y = jax.ops.segment_sum(yb * buf_w[:, None].astype(yb.dtype), buf_tok, num_segments=n + 1)[:n]
    return y.reshape(bsz, s, d)


def setup_inputs(seed: int = 0) -> dict:
    key = jax.random.key(seed)
    ks = jax.random.split(key, 24)
    f32 = jnp.float32

    def nrm(k, shape, sc):
        return jax.random.normal(k, shape, f32) * sc

    ig_b = nrm(ks[5], (DEPTH, 2, M_HEADS), 0.1)
    fg_b = 3.0 + 3.0 * jax.random.uniform(ks[6], (DEPTH, 2, M_HEADS), f32)
    gate_b = jnp.stack([ig_b[:, 0], fg_b[:, 0], ig_b[:, 1], fg_b[:, 1]], axis=1)
    return {
        "x": nrm(ks[0], (BATCH, SEQ, D_MODEL), 1.0),
        "norm1_g": 1.0 + nrm(ks[1], (DEPTH, D_MODEL), 0.02),
        "w_in": nrm(ks[2], (DEPTH, D_MODEL, P_IN), D_MODEL ** -0.5),
        "conv_w": nrm(ks[3], (DEPTH, CONV_W, 2 * M_WIDTH), CONV_W ** -0.5),
        "conv_b": nrm(ks[4], (DEPTH, 2 * M_WIDTH), 0.02),
        "gate_b": gate_b,
        "mlstm_norm_g": 1.0 + nrm(ks[7], (DEPTH, M_WIDTH), 0.02),
        "q_norm_g": 1.0 + nrm(ks[8], (DEPTH, A_HEAD_DIM), 0.02),
        "k_norm_g": 1.0 + nrm(ks[9], (DEPTH, A_HEAD_DIM), 0.02),
        "w_out": nrm(ks[10], (DEPTH, D_MIX, D_MODEL), D_MIX ** -0.5),
        "norm2_g": 1.0 + nrm(ks[11], (DEPTH, D_MODEL), 0.02),
        "router_g_w": nrm(ks[12], (DEPTH, D_MODEL, N_GROUPS), D_MODEL ** -0.5),
        "router_g_b": nrm(ks[13], (DEPTH, N_GROUPS), 0.01),
        "router_e_w": nrm(ks[14], (DEPTH, D_MODEL, N_EXPERTS), D_MODEL ** -0.5),
        "router_e_b": nrm(ks[15], (DEPTH, N_EXPERTS), 0.01),
        "w1": nrm(ks[16], (DEPTH, N_EXPERTS, D_MODEL, D_EXPERT), D_MODEL ** -0.5),
        "w3": nrm(ks[17], (DEPTH, N_EXPERTS, D_MODEL, D_EXPERT), D_MODEL ** -0.5),
        "w2": nrm(ks[18], (DEPTH, N_EXPERTS, D_EXPERT, D_MODEL), D_EXPERT ** -0.5),
        "final_norm_g": 1.0 + nrm(ks[19], (D_MODEL,), 0.02),
    }


def reference(x, norm1_g, w_in, conv_w, conv_b, gate_b, mlstm_norm_g, q_norm_g, k_norm_g,
              w_out, norm2_g, router_g_w, router_g_b, router_e_w, router_e_b, w1, w3, w2,
              final_norm_g):
    cos, sin = axial_rope_tables(x.shape[1])
    for l in range(DEPTH):
        x = mixer_layer(x, cos, sin, norm1_g[l], w_in[l], conv_w[l], conv_b[l], gate_b[l],
                        mlstm_norm_g[l], q_norm_g[l], k_norm_g[l], w_out[l])
        x = x + hier_moe(rmsnorm(x, norm2_g[l]), router_g_w[l], router_g_b[l], router_e_w[l],
                         router_e_b[l], w1[l], w3[l], w2[l])
    return rmsnorm(x, final_norm_g)
```

```cpp
#include <hip/hip_runtime.h>
#include <hip/hip_cooperative_groups.h>
#include <cstdint>
#include <cstdio>

typedef unsigned short bf16_t;
typedef unsigned u32x4 __attribute__((ext_vector_type(4)));
typedef unsigned u32x2 __attribute__((ext_vector_type(2)));

constexpr int NB = 4, SEQ = 8192, M = NB * SEQ, D = 1024;
constexpr int NWIN = 2816;
constexpr int PIN_ = 2832;
constexpr int NSLOT = 2 * M + 32 * 256;
constexpr float EPS = 1e-6f;
constexpr float QSCALE = 0.125f * 1.4426950408889634f;

constexpr size_t MiB = 1u << 20;
constexpr size_t WS_CTL = 0;
constexpr size_t WS_WIN = 1 * MiB;
constexpr size_t WS_WOUT = 12 * MiB;
constexpr size_t WS_ROPE = 17 * MiB;
constexpr size_t WS_GATES = 18 * MiB;
constexpr size_t WS_TOPE = 20 * MiB;
constexpr size_t WS_TOPW = 20 * MiB + 256 * 1024;
constexpr size_t WS_SLOT = 20 * MiB + 512 * 1024;
constexpr size_t WS_SLOTW = 21 * MiB;
constexpr size_t WS_W13 = 22 * MiB;
constexpr size_t WS_W2 = 86 * MiB;
constexpr size_t WS_XN = 118 * MiB;
constexpr size_t WS_R1 = 182 * MiB;
constexpr size_t WS_QKC = 246 * MiB;
constexpr size_t WS_MVO = 310 * MiB;
constexpr size_t WS_AQKV = 374 * MiB;
constexpr size_t WS_CST = 422 * MiB;
constexpr size_t WS_HID = 246 * MiB;
constexpr size_t WS_Y = 318 * MiB;
constexpr size_t WS_XB = 446 * MiB;
constexpr size_t WS_RIMG = 510 * MiB;
constexpr size_t WS_END = 511 * MiB;
constexpr int CW_CNT = 1024;
constexpr int CW_FILL = 1024 + 64;

struct P {
    float* out;
    unsigned char* ws;
    const unsigned char* tab;
};
__device__ __forceinline__ const float* pin(const P& p, int k) {
    const u32x2 v = *(const u32x2*)(p.tab + 8 * k);
    const unsigned lo = (unsigned)__builtin_amdgcn_readfirstlane((int)v.x), hi = (unsigned)__builtin_amdgcn_readfirstlane((int)v.y);
    return (const float*)(((unsigned long long)hi << 32) | lo);
}

__device__ __forceinline__ int ltid() { int t = threadIdx.x; asm volatile("" : "+v"(t)); return t; }
__device__ __forceinline__ float bf2f(unsigned v) { return __uint_as_float(v << 16); }
__device__ __forceinline__ unsigned f2bf(float f) { unsigned u = __float_as_uint(f); return (u + 0x7fffu + ((u >> 16) & 1u)) >> 16; }
typedef float pk_f32x2 __attribute__((ext_vector_type(2))); typedef __bf16 pk_bf16x2 __attribute__((ext_vector_type(2)));
__device__ __forceinline__ unsigned pk2(float lo, float hi) { const pk_f32x2 v = {lo, hi}; return __builtin_bit_cast(unsigned, __builtin_convertvector(v, pk_bf16x2)); }
template <int MASK> __device__ __forceinline__ float shx(float x) {
    if constexpr (MASK == 32) { const auto rr = __builtin_amdgcn_permlane32_swap(__float_as_uint(x), __float_as_uint(x), false, false);
        const unsigned a = rr[0], b = rr[1]; return __uint_as_float(a ^ b ^ __float_as_uint(x)); }
    else if constexpr (MASK == 1) return __uint_as_float((unsigned)__builtin_amdgcn_mov_dpp((int)__float_as_uint(x), 0xB1, 0xF, 0xF, true));
    else if constexpr (MASK == 2) return __uint_as_float((unsigned)__builtin_amdgcn_mov_dpp((int)__float_as_uint(x), 0x4E, 0xF, 0xF, true));
    else return __uint_as_float((unsigned)__builtin_amdgcn_ds_swizzle((int)__float_as_uint(x), (MASK << 10) | 0x1f));
}
__device__ __forceinline__ float wave_sum(float v) {
    v += shx<1>(v); v += shx<2>(v); v += shx<4>(v); v += shx<8>(v); v += shx<16>(v); v += shx<32>(v);
    return v;
}
__device__ __forceinline__ float lane_bcast(float v, int srclane  ) { return __uint_as_float((unsigned)__builtin_amdgcn_readlane((int)__float_as_uint(v), srclane)); }
__device__ __forceinline__ float silu_f(float x) { return x * __builtin_amdgcn_rcpf(1.f + __expf(-x)); }
__device__ __forceinline__ float sigmoid_f(float x) { return __builtin_amdgcn_rcpf(1.f + __expf(-x)); }
__device__ __forceinline__ float logsigmoid_f(float x) { const float y = __expf(-fabsf(x));
    const float l1p = (y < 0.0625f) ? y * (1.f - y * (0.5f - y * (0.33333334f - 0.25f * y))) : __logf(1.f + y); return fminf(x, 0.f) - l1p; }
__device__ __forceinline__ void unpack8(u32x4 w, float* f) {
    f[0] = bf2f(w.x & 0xffffu); f[1] = bf2f(w.x >> 16); f[2] = bf2f(w.y & 0xffffu); f[3] = bf2f(w.y >> 16);
    f[4] = bf2f(w.z & 0xffffu); f[5] = bf2f(w.z >> 16); f[6] = bf2f(w.w & 0xffffu); f[7] = bf2f(w.w >> 16);
}

__device__ __forceinline__ void ph_prep_small(const P& p) {
    float* rope = (float*)(p.ws + WS_ROPE);
    const int gt = blockIdx.x * 512 + ltid();
    if (gt < 2048) {
        const double C1[16] = {0.54030230586813977, 0.84600910641876459, 0.95041528091621519, 0.98423023475537852, 0.99500416512926237, 0.99841927779381845, 0.99950004171911222, 0.99984189027985781, 0.99995000041890036, 0.99998418865337735, 0.99999500000426333, 0.99999841886154905, 0.99999949999999416, 0.99999984188613433, 0.99999995000000319, 0.99999998418861191};
        const double S1[16] = {0.8414709848078965, 0.53316844604357783, 0.31098359088696603, 0.17689218465882672, 0.099833418129499904, 0.056204499194192764, 0.031617504700607077, 0.017781857090886144, 0.0099998331106604232, 0.0056233836119069999, 0.0031622723591389961, 0.0017782784939288374, 0.00099999988083076933, 0.00056234127206397698, 0.00031622775186866914, 0.00017782793926880789};
        double c1 = 0.0, s1 = 0.0;
        const int fq = gt & 15, pos = gt >> 4;
#pragma unroll
        for (int f = 0; f < 16; ++f) { c1 = (fq == f) ? C1[f] : c1; s1 = (fq == f) ? S1[f] : s1; }
        double c = 1.0, sn = 0.0;
#pragma unroll
        for (int bit = 0; bit < 7; ++bit) {
            if ((pos >> bit) & 1) { const double cn = c * c1 - sn * s1; sn = sn * c1 + c * s1; c = cn; }
            const double c2 = c1 * c1 - s1 * s1; s1 = 2.0 * c1 * s1; c1 = c2; }
        rope[2 * gt] = (float)c; rope[2 * gt + 1] = (float)sn;
    }
}

constexpr int RIMG_PART = (2 * 32 * 64 + 32 * 16) * 8;
__device__ __forceinline__ void ph_router_image(const P& p) {
    bf16_t* img = (bf16_t*)(p.ws + WS_RIMG);
    for (int idx = blockIdx.x * 512 + ltid(); idx < 2 * 36 * 1024; idx += gridDim.x * 512) {
        const int l = idx / 36864, r = idx % 36864, k = r / 36, col = r % 36;
        const float w = pin(p, 10)[l * 1024 + k] * (col < 32 ? pin(p, 13)[(size_t)l * 32768 + k * 32 + col] : pin(p, 11)[l * 4096 + k * 4 + (col - 32)]);
        const unsigned h = f2bf(w); const unsigned lo = f2bf(w - bf2f(h));
        const int ks = k >> 5, kq = (k >> 3) & 3, j = k & 7;
        const int off = (col < 32) ? (((col >> 4) * 32 + ks) * 64 + kq * 16 + (col & 15)) * 8 + j : 32768 + ((ks * 4 + kq) * 4 + (col - 32)) * 8 + j;
        bf16_t* base = img + (size_t)l * 2 * RIMG_PART;
        base[off] = (bf16_t)h; base[RIMG_PART + off] = (bf16_t)lo;
    }
}

template <int MODE> __device__ __forceinline__ int transpose_nitems() { return MODE == 0 ? 16 * 44 : MODE == 1 ? 16 * 16 : MODE == 2 ? 32 * 16 * 16 : 32 * 8 * 16; }
template <int MODE> __device__ __forceinline__ void transpose_load(const P& p, int l, int item, float4 (&v)[2]) {
    constexpr int K = (MODE == 3) ? 512 : 1024, NT = (MODE == 0) ? 44 : 16, KT = K / 64;
    const int tid = ltid();
    const int e = item / (KT * NT), r = item % (KT * NT), kt = r / NT, nt = r % NT, k0 = kt * 64, n0 = nt * 64;
#pragma unroll
    for (int i = 0; i < 2; ++i) {
        const int idx = tid + 512 * i, kk = idx >> 4, j = idx & 15;
        const float* src;
        if (MODE == 0) { const int sc = (n0 < 2048 ? n0 : n0 + 16) + 4 * j; src = pin(p, 2) + ((size_t)l * 1024 + k0 + kk) * PIN_ + sc; }
        else if (MODE == 1) { src = pin(p, 9) + ((size_t)l * 1024 + k0 + kk) * 1024 + n0 + 4 * j; }
        else if (MODE == 2) { const int g = (n0 >> 3) + (j >> 1); const float* base = (j & 1) ? pin(p, 16) : pin(p, 15);
            src = base + (((size_t)l * 32 + e) * 1024 + k0 + kk) * 512 + 4 * g; }
        else { src = pin(p, 17) + (((size_t)l * 32 + e) * 512 + k0 + kk) * 1024 + n0 + 4 * j; }
        v[i] = *(const float4*)src;
    }
}
template <int MODE> __device__ __forceinline__ void transpose_to_lds(const float4 (&v)[2], float* tile) {
    const int tid = ltid();
#pragma unroll
    for (int i = 0; i < 2; ++i) {
        const int idx = tid + 512 * i, kk = idx >> 4, j = idx & 15;
        const int dcol = (MODE == 2) ? 8 * (j >> 1) + 4 * (j & 1) : 4 * j;
        float* t = tile + kk * 65 + dcol; t[0] = v[i].x; t[1] = v[i].y; t[2] = v[i].z; t[3] = v[i].w;
    }
}
template <int MODE> __device__ __forceinline__ void transpose_from_lds(const P& p, int l, int item, const float* tile) {
    constexpr int K = (MODE == 3) ? 512 : 1024, NT = (MODE == 0) ? 44 : 16, KT = K / 64;
    const int tid = ltid();
    const int e = item / (KT * NT), r = item % (KT * NT), kt = r / NT, nt = r % NT, k0 = kt * 64, n0 = nt * 64;
    const int n = tid >> 3, c = tid & 7; const float* s = tile + (8 * c) * 65 + n;
    u32x4 o; o.x = pk2(s[0], s[65]); o.y = pk2(s[2 * 65], s[3 * 65]); o.z = pk2(s[4 * 65], s[5 * 65]); o.w = pk2(s[6 * 65], s[7 * 65]);
    bf16_t* dst;
    if (MODE == 0) dst = (bf16_t*)(p.ws + WS_WIN) + (size_t)l * NWIN * 1024;
    else if (MODE == 1) dst = (bf16_t*)(p.ws + WS_WOUT) + (size_t)l * 1024 * 1024;
    else if (MODE == 2) dst = (bf16_t*)(p.ws + WS_W13) + (size_t)e * 1024 * 1024;
    else dst = (bf16_t*)(p.ws + WS_W2) + (size_t)e * 1024 * 512;
    *(u32x4*)(dst + (size_t)(n0 + n) * K + k0 + 8 * c) = o;
}
template <int MODE> __device__ __forceinline__ void ph_transpose(const P& p, int l, unsigned char* smem, int it0 = 0, int it1 = -1, int vb = -1, int vg = 0) {
    float* tile0 = (float*)smem; float* tile1 = tile0 + 64 * 65 + 32;
    const int n = (it1 < 0) ? transpose_nitems<MODE>() : it1, G = (vb < 0) ? (int)gridDim.x : vg;
    int it = it0 + ((vb < 0) ? (int)blockIdx.x : vb);
    float4 na[2], nb[2];
    if (it < n) transpose_load<MODE>(p, l, it, na);
    if (it + G < n) transpose_load<MODE>(p, l, it + G, nb);
    for (; it < n; it += 2 * G) {
        const bool hb = it + G < n;
        float4 ca[2], cb[2]; ca[0] = na[0]; ca[1] = na[1]; cb[0] = nb[0]; cb[1] = nb[1];
        if (it + 2 * G < n) transpose_load<MODE>(p, l, it + 2 * G, na);
        if (it + 3 * G < n) transpose_load<MODE>(p, l, it + 3 * G, nb);
        transpose_to_lds<MODE>(ca, tile0); if (hb) transpose_to_lds<MODE>(cb, tile1);
        __syncthreads();
        transpose_from_lds<MODE>(p, l, it, tile0); if (hb) transpose_from_lds<MODE>(p, l, it + G, tile1);
        __syncthreads();
    }
}

constexpr int BG_HALF2 = 2 * 8192, BG_TOTAL = BG_HALF2 + 2 * 4096;
struct BgJob { int next, stride; };
__device__ __forceinline__ void bg_decode(int hid, bool& m2, int& e, int& k0, int& n0) {
    m2 = hid < BG_HALF2; const int item = (m2 ? hid : hid - BG_HALF2) >> 1, half = hid & 1;
    const int sh = m2 ? 8 : 7;
    e = item >> sh; const int r = item & ((1 << sh) - 1), kt = r >> 4, nt = r & 15; k0 = kt * 64 + 32 * half; n0 = nt * 64;
}
__device__ __forceinline__ void bg_glds16(const void* gsrc, unsigned lds_dst) { unsigned keep;
    asm volatile("s_mov_b32 %0, m0\n\ts_mov_b32 m0, %2\n\ts_nop 0\n\tglobal_load_lds_dwordx4 %1, off\n\ts_mov_b32 m0, %0" : "=&s"(keep) : "v"(gsrc), "s"(lds_dst) : "memory"); }
__device__ __forceinline__ void bg_dma(const P& p, int l, int hid, unsigned tile_lds) {
    const int lane = ltid() & 63; bool m2; int e, k0, n0; bg_decode(hid, m2, e, k0, n0);
    const int kk = lane >> 4, j = lane & 15;
    const float* w1 = pin(p, 15); const float* w3 = pin(p, 16); const float* w2 = pin(p, 17);
    const float* src = m2 ? ((j & 1) ? w3 : w1) + (((size_t)l * 32 + e) * 1024 + k0 + kk) * 512 + 4 * ((n0 >> 3) + (j >> 1))
                          : w2 + (((size_t)l * 32 + e) * 512 + k0 + kk) * 1024 + n0 + 4 * j;
    const size_t step = m2 ? 4 * 512 : 4 * 1024;
#pragma unroll
    for (int i = 0; i < 8; ++i) bg_glds16(src + (size_t)i * step, (unsigned)__builtin_amdgcn_readfirstlane(tile_lds + i * 1024));
}
__device__ __forceinline__ void bg_finish(const P& p, int hid, const float* tile  ) {
    const int lane = ltid() & 63; bool m2; int e, k0, n0; bg_decode(hid, m2, e, k0, n0);
    const int ng = lane & 15, kg = lane >> 4;
    float4 tv[8];
#pragma unroll
    for (int i = 0; i < 8; ++i) tv[i] = *(const float4*)(tile + (8 * kg + i) * 64 + 4 * ng);
    bf16_t* dst = m2 ? (bf16_t*)(p.ws + WS_W13) + (size_t)e * 1024 * 1024 + (size_t)(n0 + 4 * ng) * 1024 + k0 + 8 * kg : (bf16_t*)(p.ws + WS_W2) + (size_t)e * 1024 * 512 + (size_t)(n0 + 4 * ng) * 512 + k0 + 8 * kg;
    const int K = m2 ? 1024 : 512;
    { u32x4 o; o.x = pk2(tv[0].x, tv[1].x); o.y = pk2(tv[2].x, tv[3].x); o.z = pk2(tv[4].x, tv[5].x); o.w = pk2(tv[6].x, tv[7].x); *(u32x4*)(dst) = o; }
    { u32x4 o; o.x = pk2(tv[0].y, tv[1].y); o.y = pk2(tv[2].y, tv[3].y); o.z = pk2(tv[4].y, tv[5].y); o.w = pk2(tv[6].y, tv[7].y); *(u32x4*)(dst + K) = o; }
    { u32x4 o; o.x = pk2(tv[0].z, tv[1].z); o.y = pk2(tv[2].z, tv[3].z); o.z = pk2(tv[4].z, tv[5].z); o.w = pk2(tv[6].z, tv[7].z); *(u32x4*)(dst + 2 * K) = o; }
    { u32x4 o; o.x = pk2(tv[0].w, tv[1].w); o.y = pk2(tv[2].w, tv[3].w); o.z = pk2(tv[4].w, tv[5].w); o.w = pk2(tv[6].w, tv[7].w); *(u32x4*)(dst + 3 * K) = o; }
    asm volatile("s_waitcnt lgkmcnt(0)" ::: "memory");
}

constexpr int LDS_RING = 131072;
constexpr int LDS_MISC = LDS_RING;
constexpr int LDS_LCNT = 148480;
constexpr int LDS_BIAS = 148032;
constexpr int WROW = 1028;
constexpr int LDS_PTAB = 163840 - 512;
__device__ __forceinline__ float dot4(const float4 a, const float4 b) { return (a.x * b.x + a.y * b.y) + (a.z * b.z + a.w * b.w); }
__device__ __forceinline__ void dot4acc(pk_f32x2& acc, const float4 a, const float4 b) {
    acc = __builtin_elementwise_fma((pk_f32x2){a.x, a.y}, (pk_f32x2){b.x, b.y}, acc); acc = __builtin_elementwise_fma((pk_f32x2){a.z, a.w}, (pk_f32x2){b.z, b.w}, acc); }
template <int NH, int MASK, int N> __device__ __forceinline__ void tree_step(float (&v)[N], int lane) {
    const bool up = (lane & MASK) != 0;
#pragma unroll
    for (int i = 0; i < NH; ++i) { const float send = up ? v[i] : v[i + NH], keep = up ? v[i + NH] : v[i]; v[i] = keep + shx<MASK>(send); }
}
template <int N> __device__ __forceinline__ float tree_reduce(float (&v)[N], int lane) {
    static_assert(N == 4 || N == 8 || N == 16, "tree_reduce: N");
    if constexpr (N == 16) { tree_step<8, 32>(v, lane); tree_step<4, 16>(v, lane); tree_step<2, 8>(v, lane); tree_step<1, 4>(v, lane); float r = v[0]; r += shx<2>(r); r += shx<1>(r); return r; }
    else if constexpr (N == 8) { tree_step<4, 32>(v, lane); tree_step<2, 16>(v, lane); tree_step<1, 8>(v, lane); float r = v[0]; r += shx<4>(r); r += shx<2>(r); r += shx<1>(r); return r; }
    else { tree_step<2, 32>(v, lane); tree_step<1, 16>(v, lane); float r = v[0]; r += shx<8>(r); r += shx<4>(r); r += shx<2>(r); r += shx<1>(r); return r; }
}
template <int MODE, bool COMB> __device__ __forceinline__ void rowpass(const P& p, int l, int nblk, int bid, unsigned char* smem, bool real = true) {
    float* const outp = real ? p.out : (float*)(p.ws + WS_R1);
    constexpr bool XBF = !(MODE == 1 && !COMB);
    const int tid = ltid(), lane = tid & 63, wave = tid >> 6;
    const int gw = bid * 8 + wave, NGW = nblk * 8;
    float* W = (float*)smem; unsigned* lcnt = (unsigned*)(smem + LDS_LCNT);
    if (MODE == 1) { const float* src = pin(p, 2) + (size_t)l * 1024 * PIN_ + 2048;
#pragma unroll 8
        for (int i = tid; i < 16 * 1024; i += 512) W[(i & 15) * WROW + (i >> 4)] = src[(size_t)(i >> 4) * PIN_ + (i & 15)]; }
    if (MODE == 2) { const float* sg = pin(p, 11) + (size_t)l * 4096; const float* se = pin(p, 13) + (size_t)l * 32768;
#pragma unroll 8
        for (int i = tid; i < 4096; i += 512) W[(i & 3) * WROW + (i >> 2)] = sg[i];
#pragma unroll 16
        for (int i = tid; i < 32768; i += 512) W[(4 + (i & 31)) * WROW + (i >> 5)] = se[i];
        if (tid < 32) lcnt[tid] = 0u;
        if (tid < 4) ((float*)(smem + LDS_BIAS))[tid] = pin(p, 12)[l * 4 + tid];
        if (tid >= 64 && tid < 96) ((float*)(smem + LDS_BIAS))[4 + tid - 64] = pin(p, 14)[l * 32 + tid - 64]; }
    if (MODE == 1) { if (tid < 16) ((float*)(smem + LDS_BIAS))[tid] = pin(p, 5)[l * 16 + tid]; }
    const float* biasl = (const float*)(smem + LDS_BIAS);
    if (MODE != 3) __syncthreads();
    const float* gain = (MODE == 1) ? pin(p, 1) + l * 1024 : (MODE == 2) ? pin(p, 10) + l * 1024 : pin(p, 18);
    float4 g4[4];
#pragma unroll
    for (int j = 0; j < 4; ++j) g4[j] = ((const float4*)gain)[lane + 64 * j];
    bf16_t* XN = (bf16_t*)(p.ws + WS_XN);
    const bf16_t* Y = (const bf16_t*)(p.ws + WS_Y);
    const float* xbase = pin(p, 0); const bf16_t* xbb = (const bf16_t*)(p.ws + WS_XB);
    constexpr int R = 2;
    float4 nv[R][4]; u32x2 nx[R][4], na[R][4], nb[R][4];
#define ROW_LOAD(r, mm) do { _Pragma("unroll") for (int j = 0; j < 4; ++j) { if (XBF) nx[r][j] = ((const u32x2*)(xbb + (size_t)(mm) * 1024))[lane + 64 * j]; else nv[r][j] = ((const float4*)(xbase + (size_t)(mm) * 1024))[lane + 64 * j]; \
        if (COMB) { na[r][j] = ((const u32x2*)(Y + (size_t)(2 * (mm)) * 1024))[lane + 64 * j]; nb[r][j] = ((const u32x2*)(Y + (size_t)(2 * (mm) + 1) * 1024))[lane + 64 * j]; } } } while (0)
#pragma unroll
    for (int r = 0; r < R; ++r) if (gw + r * NGW < M) ROW_LOAD(r, gw + r * NGW);
    for (int m0 = gw; m0 < M; m0 += R * NGW) {
        float4 v[R][4]; int mr[R]; bool ok[R];
#pragma unroll
        for (int r = 0; r < R; ++r) { mr[r] = m0 + r * NGW; ok[r] = mr[r] < M;
#pragma unroll
            for (int j = 0; j < 4; ++j) { if (XBF) { v[r][j].x = bf2f(nx[r][j].x & 0xffffu); v[r][j].y = bf2f(nx[r][j].x >> 16); v[r][j].z = bf2f(nx[r][j].y & 0xffffu); v[r][j].w = bf2f(nx[r][j].y >> 16); } else v[r][j] = nv[r][j];
                if (COMB) { v[r][j].x += bf2f(na[r][j].x & 0xffffu) + bf2f(nb[r][j].x & 0xffffu); v[r][j].y += bf2f(na[r][j].x >> 16) + bf2f(nb[r][j].x >> 16);
                            v[r][j].z += bf2f(na[r][j].y & 0xffffu) + bf2f(nb[r][j].y & 0xffffu); v[r][j].w += bf2f(na[r][j].y >> 16) + bf2f(nb[r][j].y >> 16); } } }
#pragma unroll
        for (int r = 0; r < R; ++r) if (m0 + (R + r) * NGW < M) ROW_LOAD(r, m0 + (R + r) * NGW);
        if (MODE == 1) {
#pragma unroll
            for (int r = 0; r < R; ++r) if (ok[r]) {
#pragma unroll
                for (int j = 0; j < 4; ++j) { u32x2 o; o.x = pk2(v[r][j].x, v[r][j].y); o.y = pk2(v[r][j].z, v[r][j].w); ((u32x2*)((bf16_t*)outp + (size_t)mr[r] * 1024))[lane + 64 * j] = o; } }
        }
        float ss[R];
#pragma unroll
        for (int r = 0; r < R; ++r) { ss[r] = 0.f;
#pragma unroll
            for (int j = 0; j < 4; ++j) ss[r] += dot4(v[r][j], v[r][j]); }
#pragma unroll
        for (int r = 0; r < R; ++r) ss[r] = wave_sum(ss[r]);
#pragma unroll
        for (int r = 0; r < R; ++r) { const float rn = 1.0f / sqrtf(ss[r] * (1.0f / 1024.0f) + EPS);
#pragma unroll
            for (int j = 0; j < 4; ++j) { v[r][j].x *= rn * g4[j].x; v[r][j].y *= rn * g4[j].y; v[r][j].z *= rn * g4[j].z; v[r][j].w *= rn * g4[j].w; } }
        if (MODE == 3) {
#pragma unroll
            for (int r = 0; r < R; ++r) if (ok[r]) {
#pragma unroll
                for (int j = 0; j < 4; ++j) ((float4*)(outp + (size_t)mr[r] * 1024))[lane + 64 * j] = v[r][j]; }
            continue;
        }
#pragma unroll
        for (int r = 0; r < R; ++r) if (ok[r]) {
#pragma unroll
            for (int j = 0; j < 4; ++j) { u32x2 o; o.x = pk2(v[r][j].x, v[r][j].y); o.y = pk2(v[r][j].z, v[r][j].w); ((u32x2*)(XN + (size_t)mr[r] * 1024))[lane + 64 * j] = o; } }
        if (MODE == 1) {
            float acc[R][16];
#pragma unroll
            for (int g = 0; g < 16; ++g) { pk_f32x2 s0 = {0.f, 0.f}, s1 = {0.f, 0.f};
#pragma unroll
                for (int j = 0; j < 4; ++j) { const float4 w = ((const float4*)(W + g * WROW))[lane + 64 * j]; dot4acc(s0, v[0][j], w); dot4acc(s1, v[1][j], w); }
                acc[0][g] = s0.x + s0.y; acc[1][g] = s1.x + s1.y; if ((g & 3) == 3) asm volatile("" ::: "memory"); }
            float val[R];
#pragma unroll
            for (int r = 0; r < R; ++r) val[r] = tree_reduce<16>(acc[r], lane);
            if ((lane & 3) == 0) { const int o = ((lane >> 5) & 1) * 8 + ((lane >> 4) & 1) * 4 + ((lane >> 3) & 1) * 2 + ((lane >> 2) & 1); const float gb = biasl[o];
#pragma unroll
                for (int r = 0; r < R; ++r) if (ok[r]) { float pre = val[r] + gb; if ((o >> 2) & 1) pre = logsigmoid_f(pre); ((float*)(p.ws + WS_GATES))[(size_t)mr[r] * 16 + o] = pre; } }
        } else {
            float ga[R][4];
#pragma unroll
            for (int g = 0; g < 4; ++g) { pk_f32x2 s0 = {0.f, 0.f}, s1 = {0.f, 0.f};
#pragma unroll
                for (int j = 0; j < 4; ++j) { const float4 w = ((const float4*)(W + g * WROW))[lane + 64 * j]; dot4acc(s0, v[0][j], w); dot4acc(s1, v[1][j], w); }
                ga[0][g] = s0.x + s0.y; ga[1][g] = s1.x + s1.y; }
            float gv[R];
#pragma unroll
            for (int r = 0; r < R; ++r) gv[r] = tree_reduce<4>(ga[r], lane);
            const float* bg = biasl; const float* be = biasl + 4;
            int gi[R]; float gval[R];
#pragma unroll
            for (int r = 0; r < R; ++r) { float gl[4];
#pragma unroll
                for (int g = 0; g < 4; ++g) gl[g] = lane_bcast(gv[r], 16 * g) + bg[g];
                int gix = 0; float gm = gl[0];
#pragma unroll
                for (int g = 1; g < 4; ++g) if (gl[g] > gm) { gm = gl[g]; gix = g; }
                float gs = 0.f;
#pragma unroll
                for (int g = 0; g < 4; ++g) gs += __expf(gl[g] - gm);
                gval[r] = 1.0f / gs; gi[r] = __builtin_amdgcn_readfirstlane(gix); }
            float ea[R][8];
#pragma unroll
            for (int i = 0; i < 8; ++i) {
#pragma unroll
                for (int r = 0; r < R; ++r) { const float* We = W + (4 + 8 * gi[r] + i) * WROW; pk_f32x2 sacc = {0.f, 0.f};
#pragma unroll
                    for (int j = 0; j < 4; ++j) dot4acc(sacc, v[r][j], ((const float4*)We)[lane + 64 * j]);
                    ea[r][i] = sacc.x + sacc.y; }
                if (i & 1) asm volatile("" ::: "memory"); }
            float ev[R];
#pragma unroll
            for (int r = 0; r < R; ++r) ev[r] = tree_reduce<8>(ea[r], lane);
#pragma unroll
            for (int r = 0; r < R; ++r) {
                float sel[8];
#pragma unroll
                for (int i = 0; i < 8; ++i) sel[i] = lane_bcast(ev[r], 32 * ((i >> 2) & 1) + 16 * ((i >> 1) & 1) + 8 * (i & 1)) + be[8 * gi[r] + i];
                int i0 = 0; float v0 = sel[0];
#pragma unroll
                for (int i = 1; i < 8; ++i) if (sel[i] > v0) { v0 = sel[i]; i0 = i; }
                int i1 = -1; float v1 = -INFINITY;
#pragma unroll
                for (int i = 0; i < 8; ++i) if (i != i0 && sel[i] > v1) { v1 = sel[i]; i1 = i; }
                const float e1 = __expf(v1 - v0); const float w0 = gval[r] / (1.f + e1), w1 = gval[r] * e1 / (1.f + e1);
                if (lane == 0 && ok[r]) {
                    const int m = mr[r], ea_ = gi[r] * 8 + i0, eb_ = gi[r] * 8 + i1;
                    ((int*)(p.ws + WS_TOPE))[2 * m] = ea_; ((int*)(p.ws + WS_TOPE))[2 * m + 1] = eb_;
                    ((float*)(p.ws + WS_TOPW))[2 * m] = w0; ((float*)(p.ws + WS_TOPW))[2 * m + 1] = w1;
                    atomicAdd(&lcnt[ea_], 1u); atomicAdd(&lcnt[eb_], 1u);
                }
            }
        }
    }
#undef ROW_LOAD
    if (MODE == 2) { __syncthreads(); if (real && tid < 32 && lcnt[tid]) atomicAdd((unsigned*)(p.ws + WS_CTL) + CW_CNT + l * 32 + tid, lcnt[tid]); }
}

__device__ __forceinline__ void moe_pad_start(const unsigned* cnt, int* ps  ) {
    int acc = 0;
#pragma unroll
    for (int e = 0; e < 32; ++e) { ps[e] = acc; acc += ((int)cnt[e] + 255) & ~255; }
    ps[32] = acc;
}
__device__ __forceinline__ void ph_scatter(const P& p, int l, unsigned char* smem) {
    unsigned* lcnt = (unsigned*)smem; unsigned* lbase = lcnt + 32; int* lps = (int*)(lbase + 32);
    const int tid = ltid();
    const unsigned* cnt = (const unsigned*)(p.ws + WS_CTL) + CW_CNT + l * 32;
    unsigned* fill = (unsigned*)(p.ws + WS_CTL) + CW_FILL + l * 32;
    int* slot_tok = (int*)(p.ws + WS_SLOT); float* slot_w = (float*)(p.ws + WS_SLOTW); const float* topw = (const float*)(p.ws + WS_TOPW);
    const int* tope = (const int*)(p.ws + WS_TOPE);
    if (tid == 0) { int acc = 0; for (int e = 0; e < 32; ++e) { lps[e] = acc; acc += ((int)cnt[e] + 255) & ~255; } lps[32] = acc; }
    __syncthreads();
    for (int e = blockIdx.x; e < 32; e += gridDim.x) for (int s = lps[e] + (int)cnt[e] + tid; s < lps[e + 1]; s += 512) slot_tok[s] = -1;
    for (int t0 = blockIdx.x * 128; t0 < M; t0 += gridDim.x * 128) {
        if (tid < 32) lcnt[tid] = 0u;
        __syncthreads();
        const bool act = tid < 128; const int m = t0 + (tid & 127);
        int ea = 0, eb = 0; unsigned ia = 0u, ib = 0u; float wa = 0.f, wb = 0.f;
        if (act) { ea = tope[2 * m]; eb = tope[2 * m + 1]; wa = topw[2 * m]; wb = topw[2 * m + 1]; ia = atomicAdd(&lcnt[ea], 1u); ib = atomicAdd(&lcnt[eb], 1u); }
        __syncthreads();
        if (tid < 32) lbase[tid] = lcnt[tid] ? atomicAdd(&fill[tid], lcnt[tid]) : 0u;
        __syncthreads();
        if (act) { const int sa = lps[ea] + (int)(lbase[ea] + ia), sb = lps[eb] + (int)(lbase[eb] + ib); slot_tok[sa] = 2 * m; slot_tok[sb] = 2 * m + 1; slot_w[sa] = wa; slot_w[sb] = wb; }
        __syncthreads();
    }
}

enum { EPI_INPROJ = 0, EPI_OUTPROJ = 1, EPI_MOE1 = 2, EPI_MOE2 = 3 };
#ifndef NTAIL2
#define NTAIL2 2048
#endif
__device__ __forceinline__ int tail_items() { return gridDim.x == 256 ? NTAIL2 : 0; }
namespace attn_body {
using bf16=unsigned short;
using bf16x8=__attribute__((ext_vector_type(8)))short;
using s16x4=__attribute__((ext_vector_type(4)))short;
using f32x16=__attribute__((ext_vector_type(16)))float;
using u32x4=__attribute__((ext_vector_type(4)))unsigned;
constexpr int SEQ=8192,D=64,QP=768,OP=1024;
constexpr int NW=8,QBLK=32,QB=QBLK*NW,KVBLK=64,NQB=SEQ/QB;
constexpr int ATTN_UNIT_ROWS=QB;
__device__ __forceinline__ int crow(int r,int hi){return (r&3)+8*(r>>2)+4*hi;}
#define SBAR() __builtin_amdgcn_sched_barrier(0)
__device__ __forceinline__ void cmask(f32x16&p0,f32x16&p1,int jb,int qrel,int hi){
  const float NEG=-INFINITY; int kb=64*jb+4*hi;
  #pragma unroll
  for(int r=0;r<16;++r){int kv=kb+(r&3)+8*(r>>2); if(kv>qrel)p0[r]=NEG; if(kv+32>qrel)p1[r]=NEG;}
}

constexpr int NSLOT=4, SLOTB=8192;
constexpr int LDS_K=0, LDS_V=NSLOT*SLOTB, LDS_WS=2*NSLOT*SLOTB, LDS_OST=LDS_WS+NW*64*4, LDS_BYTES=LDS_OST+NW*4096;
constexpr float C2=0.125f*1.4426950408889634f;
__device__ __forceinline__ void glds16(const void*gsrc,unsigned lds_dst){unsigned keep;
  asm volatile("s_mov_b32 %0, m0\n\ts_mov_b32 m0, %2\n\ts_nop 0\n\tglobal_load_lds_dwordx4 %1, off\n\ts_mov_b32 m0, %0":"=&s"(keep):"v"(gsrc),"s"(lds_dst):"memory");}
__device__ __forceinline__ float max3f(float a,float b,float c){float r;asm("v_max3_f32 %0, %1, %2, %3":"=v"(r):"v"(a),"v"(b),"v"(c));return r;}
__device__ __forceinline__ float max2f(float a,float b){float r;asm("v_max_f32_e32 %0, %1, %2":"=v"(r):"v"(a),"v"(b));return r;}
__device__ __forceinline__ float fadd_s(float a,float b){float r;asm("v_add_f32_e32 %0, %1, %2":"=v"(r):"v"(a),"v"(b));return r;}
__device__ __forceinline__ float fsub_s(float a,float b){float r;asm("v_sub_f32_e32 %0, %1, %2":"=v"(r):"v"(a),"v"(b));return r;}
typedef float f32x2_t __attribute__((ext_vector_type(2))); typedef __bf16 bf16x2_t __attribute__((ext_vector_type(2)));
__device__ __forceinline__ unsigned cvtpk_s(float lo,float hi){f32x2_t v={lo,hi};bf16x2_t b=__builtin_convertvector(v,bf16x2_t);return __builtin_bit_cast(unsigned,b);}
#define WAIT_BAR(N) asm volatile("s_waitcnt vmcnt(" #N ") lgkmcnt(0)\n\ts_barrier":::"memory")

__device__ __forceinline__ void qkt(f32x16&p0,f32x16&p1,const char*Kslot,const bf16x8*qr,const f32x16&negm,int r32,int hi){
  const char*kb=Kslot+hi*1024+r32*16;
  #pragma unroll
  for(int d0=0;d0<4;++d0){
    const bf16x8 b0=*reinterpret_cast<const bf16x8*>(kb+d0*2048);
    const bf16x8 b1=*reinterpret_cast<const bf16x8*>(kb+d0*2048+512);
    if(d0==0){p0=__builtin_amdgcn_mfma_f32_32x32x16_bf16(b0,qr[0],negm,0,0,0);p1=__builtin_amdgcn_mfma_f32_32x32x16_bf16(b1,qr[0],negm,0,0,0);}
    else{p0=__builtin_amdgcn_mfma_f32_32x32x16_bf16(b0,qr[d0],p0,0,0,0);p1=__builtin_amdgcn_mfma_f32_32x32x16_bf16(b1,qr[d0],p1,0,0,0);}}
}
typedef __attribute__((address_space(3))) const char* lds_cptr;
typedef short v4i16_t __attribute__((ext_vector_type(4)));
__device__ __forceinline__ void kload8(bf16x8*kf,lds_cptr kp){
  kf[0]=*(const __attribute__((address_space(3))) bf16x8*)(kp);      kf[1]=*(const __attribute__((address_space(3))) bf16x8*)(kp+512);
  kf[2]=*(const __attribute__((address_space(3))) bf16x8*)(kp+2048); kf[3]=*(const __attribute__((address_space(3))) bf16x8*)(kp+2560);
  kf[4]=*(const __attribute__((address_space(3))) bf16x8*)(kp+4096); kf[5]=*(const __attribute__((address_space(3))) bf16x8*)(kp+4608);
  kf[6]=*(const __attribute__((address_space(3))) bf16x8*)(kp+6144); kf[7]=*(const __attribute__((address_space(3))) bf16x8*)(kp+6656);
}
__device__ __forceinline__ void kload2(bf16x8*kf,lds_cptr kp,int j){ kf[2*j]=*(const __attribute__((address_space(3))) bf16x8*)(kp+j*2048); kf[2*j+1]=*(const __attribute__((address_space(3))) bf16x8*)(kp+j*2048+512); }
__device__ __forceinline__ s16x4 vtr(lds_cptr p){ return __builtin_bit_cast(s16x4,__builtin_amdgcn_ds_read_tr16_b64_v4i16((__attribute__((address_space(3))) v4i16_t*)p)); }
__device__ __forceinline__ float rowmax(const f32x16&p0,const f32x16&p1){
  float a=max3f(p0[0],p0[1],p1[0]),b=max3f(p0[2],p0[3],p1[1]);a=max3f(a,p1[2],p1[3]);
  #pragma unroll
  for(int r=4;r<16;r+=4){a=max3f(a,p0[r],p0[r+1]);b=max3f(b,p0[r+2],p0[r+3]);a=max3f(a,p1[r],p1[r+1]);b=max3f(b,p1[r+2],p1[r+3]);}
  const float m=max2f(a,b);
  auto rr=__builtin_amdgcn_permlane32_swap(__float_as_uint(m),__float_as_uint(m),false,false);
  return max2f(__uint_as_float(rr[0]),__uint_as_float(rr[1]));
}
__device__ __forceinline__ void pv(f32x16*o,int vb,bf16x8 pa0,bf16x8 pa1,bf16x8 pa2,bf16x8 pa3){
  #pragma unroll
  for(int d0=0;d0<2;++d0){s16x4 lo[4],hi[4];
    #pragma unroll
    for(int ks=0;ks<4;++ks){
      asm volatile("ds_read_b64_tr_b16 %0,%1 offset:%c2":"=&v"(lo[ks]):"v"(vb),"i"(d0*4096+ks*1024):"memory");
      asm volatile("ds_read_b64_tr_b16 %0,%1 offset:%c2":"=&v"(hi[ks]):"v"(vb),"i"(d0*4096+ks*1024+512):"memory");}
    asm volatile("s_waitcnt lgkmcnt(0)":::"memory");SBAR();
    #define PK(k) (bf16x8){lo[k][0],lo[k][1],lo[k][2],lo[k][3],hi[k][0],hi[k][1],hi[k][2],hi[k][3]}
    o[d0]=__builtin_amdgcn_mfma_f32_32x32x16_bf16(pa0,PK(0),o[d0],0,0,0);
    o[d0]=__builtin_amdgcn_mfma_f32_32x32x16_bf16(pa1,PK(1),o[d0],0,0,0);
    o[d0]=__builtin_amdgcn_mfma_f32_32x32x16_bf16(pa2,PK(2),o[d0],0,0,0);
    o[d0]=__builtin_amdgcn_mfma_f32_32x32x16_bf16(pa3,PK(3),o[d0],0,0,0);
    #undef PK
  }
}

#ifndef ATTN_STORE16
#define ATTN_STORE16(p,v) (*(u32x4*)(p)=(v))
#endif
typedef float f32x4v __attribute__((ext_vector_type(4)));
__device__ __forceinline__ void qload(bf16x8 (&qr)[4],const bf16*Qrow,int hi){
  #pragma unroll
  for(int d0=0;d0<4;++d0)qr[d0]=*reinterpret_cast<const bf16x8*>(&Qrow[d0*16+hi*8]);
}
__device__ __forceinline__ void qfetch(bf16x8 (&qr0)[4],bf16x8 (&qr1)[4],const bf16*AQ,int b,int hh,int qb){
  const int tid=ltid(),lane=tid&63,r32=lane&31,hi=lane>>5,wq=(tid>>6)&3;
  const bf16*Qw=AQ+((long)b*SEQ+qb*QB+wq*64)*QP+hh*D;
  qload(qr0,Qw+(long)r32*QP,hi); qload(qr1,Qw+(long)(32+r32)*QP,hi);
}
__device__ __forceinline__ void qprep(bf16x8 (&qr)[4],int tpos,int hi,const float*qgain,const float*rope){
  float qv[4][8]; float ss=0.f;
  #pragma unroll
  for(int d0=0;d0<4;++d0){ const u32x4 x=__builtin_bit_cast(u32x4,qr[d0]);
    qv[d0][0]=__uint_as_float(x.x<<16);qv[d0][1]=__uint_as_float(x.x&0xffff0000u);qv[d0][2]=__uint_as_float(x.y<<16);qv[d0][3]=__uint_as_float(x.y&0xffff0000u);
    qv[d0][4]=__uint_as_float(x.z<<16);qv[d0][5]=__uint_as_float(x.z&0xffff0000u);qv[d0][6]=__uint_as_float(x.w<<16);qv[d0][7]=__uint_as_float(x.w&0xffff0000u);
    #pragma unroll
    for(int j=0;j<8;++j)ss+=qv[d0][j]*qv[d0][j]; }
  { auto rr=__builtin_amdgcn_permlane32_swap(__float_as_uint(ss),__float_as_uint(ss),false,false); ss=__uint_as_float(rr[0])+__uint_as_float(rr[1]); }
  const float rn=(1.0f/sqrtf(ss*(1.0f/64.0f)+1e-6f))*C2;
  #pragma unroll
  for(int d0=0;d0<4;++d0){ const float4 g0=*reinterpret_cast<const float4*>(qgain+16*d0+8*hi), g1=*reinterpret_cast<const float4*>(qgain+16*d0+8*hi+4);
    qv[d0][0]*=rn*g0.x;qv[d0][1]*=rn*g0.y;qv[d0][2]*=rn*g0.z;qv[d0][3]*=rn*g0.w;qv[d0][4]*=rn*g1.x;qv[d0][5]*=rn*g1.y;qv[d0][6]*=rn*g1.z;qv[d0][7]*=rn*g1.w; }
  #pragma unroll
  for(int a=0;a<2;++a){ const int pos=a?(tpos&63):(tpos>>6); const float4*rp=reinterpret_cast<const float4*>(rope+2*(pos*16+8*hi));
    #pragma unroll
    for(int j2=0;j2<4;++j2){ const float4 cs=rp[j2];
      { const float x0=qv[2*a][2*j2],x1=qv[2*a+1][2*j2]; qv[2*a][2*j2]=x0*cs.x-x1*cs.y; qv[2*a+1][2*j2]=x1*cs.x+x0*cs.y; }
      { const float x0=qv[2*a][2*j2+1],x1=qv[2*a+1][2*j2+1]; qv[2*a][2*j2+1]=x0*cs.z-x1*cs.w; qv[2*a+1][2*j2+1]=x1*cs.z+x0*cs.w; } } }
  #pragma unroll
  for(int d0=0;d0<4;++d0){ u32x4 w; w.x=cvtpk_s(qv[d0][0],qv[d0][1]);w.y=cvtpk_s(qv[d0][2],qv[d0][3]);w.z=cvtpk_s(qv[d0][4],qv[d0][5]);w.w=cvtpk_s(qv[d0][6],qv[d0][7]); qr[d0]=__builtin_bit_cast(bf16x8,w); }
}
template<int THRL> __device__ __forceinline__ void attn_unit(int b,int hh,int kvh,int qb,const bf16*AQ,bf16*O,char*shm,float sref,const float*qgain,const float*rope,bf16x8 (&qr0)[4],bf16x8 (&qr1)[4],int nxt,const P&pp,int layer,BgJob&jb){
  const int tid=ltid(),lane=tid&63,r32=lane&31,hi=lane>>5; const int wid=__builtin_amdgcn_readfirstlane(tid>>6);
  const long rowbase=(long)b*SEQ; const int q0=qb*QB;
  const bf16*Kh=AQ+rowbase*QP+512+kvh*D,*Vh=AQ+rowbase*QP+640+kvh*D;
  const unsigned lds0=(unsigned)(uintptr_t)shm;
  const int NT=SEQ/KVBLK;
  if(wid>=4){
    const int lw=wid-4;
    const bf16*ksrc=Kh+(long)lane*QP+(2*lw)*8;
    const bf16*vsrc=Vh+(long)(16*((2*lw)&3)+(lane>>2))*QP+((2*lw)>>2)*32+(lane&3)*8;
    const unsigned kdst=lds0+LDS_K+(2*lw)*1024, vdst=lds0+LDS_V+(2*lw)*1024;
    #define LD_K(t) do{ const unsigned d_=(unsigned)__builtin_amdgcn_readfirstlane(kdst+((t)&3)*SLOTB); glds16(ksrc+(long)(t)*KVBLK*QP,d_); glds16(ksrc+(long)(t)*KVBLK*QP+8,d_+1024); }while(0)
    #define LD_V(t) do{ const unsigned d_=(unsigned)__builtin_amdgcn_readfirstlane(vdst+((t)&3)*SLOTB); glds16(vsrc+(long)(t)*KVBLK*QP,d_); glds16(vsrc+((long)(t)*KVBLK+16)*QP,d_+1024); }while(0)
    LD_K(0);LD_V(0);LD_K(1);LD_K(2);LD_V(1);
    asm volatile("s_waitcnt vmcnt(4)\n\ts_barrier":::"memory");
    bool active=false; const unsigned bgl=lds0+LDS_BYTES+lw*8192; const float*bgt=(const float*)(shm+LDS_BYTES+lw*8192);
    for(int t=-1;t<NT-1;++t){
      const int ph=(t+1+lw)&3;
      if(ph==0)active=(jb.next<BG_TOTAL)&&(t+8<NT);
      if(t+4<NT){
        if(active&&ph==0){ bg_dma(pp,layer,jb.next,bgl); LD_K(t+4); LD_V(t+3); asm volatile("s_waitcnt vmcnt(12)\n\ts_barrier":::"memory"); }
        else if(active&&ph==2){ LD_K(t+4); LD_V(t+3); bg_finish(pp,jb.next,bgt); asm volatile("s_waitcnt vmcnt(8)\n\ts_barrier":::"memory"); }
        else { LD_K(t+4); LD_V(t+3); asm volatile("s_waitcnt vmcnt(4)\n\ts_barrier":::"memory"); if(active&&ph==3){active=false;jb.next+=jb.stride;} }
      }
      else { if(t+3<NT)LD_V(t+3); asm volatile("s_waitcnt vmcnt(0)\n\ts_barrier":::"memory"); }
    }
    #undef LD_K
    #undef LD_V
    _Pragma("unroll") for(int i=0;i<4;++i){qr0[i]=bf16x8{};qr1[i]=bf16x8{};}
    return;
  }
  const int wq=wid;
  float*wsf=(float*)(shm+LDS_WS)+wid*64;
  bf16x8 kf[4];
  const lds_cptr shm3=(lds_cptr)shm; const lds_cptr kp0=shm3+LDS_K+hi*1024+r32*16; const lds_cptr vp0=shm3+LDS_V+((lane>>4)&1)*32+(lane&3)*8+(4*hi+((lane&15)>>2))*64;
  { const int tpos=(q0+wq*64+r32)&(SEQ-1);
    qprep(qr0,tpos,hi,qgain,rope); qprep(qr1,tpos+32,hi,qgain,rope); }
  float l0=0.f,l1=0.f; f32x16 o00=f32x16{},o01=f32x16{},o10=f32x16{},o11=f32x16{}; f32x16 negm;
  float nsref=-sref; asm volatile("":"+v"(nsref),"+v"(qr1[3]));
  _Pragma("unroll") for(int r=0;r<16;++r)negm[r]=nsref;
  asm volatile("":"+v"(negm));
  f32x16 pA0,pA1,pB0,pB1;
  #define MFMA_(a,b,c) __builtin_amdgcn_mfma_f32_32x32x16_bf16(a,b,c,0,0,0)
  #define KLD(j,base) (*(const __attribute__((address_space(3))) bf16x8*)((base)+(j)*2048))
  #define WAIT_BARC() asm volatile("s_waitcnt lgkmcnt(0)\n\ts_barrier":::"memory")
  WAIT_BARC();
  { _Pragma("unroll") for(int d0=0;d0<4;++d0){ const bf16x8 kk=KLD(d0,kp0);
      if(d0==0){pA0=MFMA_(kk,qr0[0],negm);pA1=MFMA_(kk,qr1[0],negm);} else {pA0=MFMA_(kk,qr0[d0],pA0);pA1=MFMA_(kk,qr1[d0],pA1);} } }
  asm volatile("s_nop 15\n\ts_nop 7":"+v"(pA0),"+v"(pA1));
  _Pragma("unroll") for(int r=0;r<16;++r)pA0[r]=__builtin_amdgcn_exp2f(pA0[r]);
  _Pragma("unroll") for(int r=0;r<16;++r)pA1[r]=__builtin_amdgcn_exp2f(pA1[r]);
  { _Pragma("unroll") for(int j=0;j<4;++j)kf[j]=KLD(j,kp0+512); }
  s16x4 vlo[4],vhi[4]; u32x4 pw00,pw01,pw10,pw11;
  #define PKW(P,B) cvtpk_s(P[B],P[B+1])
  #define PAF(k) __builtin_bit_cast(bf16x8,pw##k)
  #define VFR(i) (bf16x8){vlo[i][0],vlo[i][1],vlo[i][2],vlo[i][3],vhi[i][0],vhi[i][1],vhi[i][2],vhi[i][3]}
  #define PIN(x) asm volatile("":"+v"(x))
  #define GAPA(MF,ADDS,W0,W1,PW) do{ MF; ADDS; W0; W1; PIN(PW); SBAR(); }while(0)
  #define EX(v) __builtin_amdgcn_exp2f(v)
  #define GAPB(MF,X,B) do{ MF; X[B]=EX(X[B]); X[B+1]=EX(X[B+1]); X[B+2]=EX(X[B+2]); X[B+3]=EX(X[B+3]); PIN(X); SBAR(); }while(0)
  #define VRD(i) do{ vlo[i]=vtr(vp_+(((i)>>1)*4096+((i)&1)*1024)); vhi[i]=vtr(vp_+(((i)>>1)*4096+((i)&1)*1024+512)); }while(0)
  #define KRD(G,j) do{ if(G){ kf[j]=KLD(j,kp_); SBAR(); } }while(0)
  #define STEP(C0,C1,P0,P1,VOFF,KOFF,GL) do{ SBAR(); \
    const lds_cptr vp_=vp0+(VOFF); const lds_cptr kp_=kp0+(KOFF); \
    VRD(0); SBAR(); float s0=(P0[0]+P0[1]); float s1; \
    GAPA(C0=MFMA_(kf[0],qr0[0],negm), s0+=P0[2];s0+=P0[3];s0+=P0[4];s0+=P0[5];PIN(s0),     pw00[0]=PKW(P0,0), pw00[1]=PKW(P0,2), pw00); \
    GAPA(C1=MFMA_(kf[0],qr1[0],negm), s0+=P0[6];s0+=P0[7];s0+=P0[8];s0+=P0[9];PIN(s0),     pw00[2]=PKW(P0,4), pw00[3]=PKW(P0,6), pw00); \
    VRD(2); SBAR(); \
    GAPA(C0=MFMA_(kf[1],qr0[1],C0),   s0+=P0[10];s0+=P0[11];s0+=P0[12];s0+=P0[13];PIN(s0), pw10[0]=PKW(P1,0), pw10[1]=PKW(P1,2), pw10); \
    GAPA(C1=MFMA_(kf[1],qr1[1],C1),   s0+=P0[14];s0+=P0[15];s1=(P1[0]+P1[1]);s1+=P1[2];PIN(s0);PIN(s1), pw10[2]=PKW(P1,4), pw10[3]=PKW(P1,6), pw10); \
    VRD(1); SBAR(); \
    GAPA(C0=MFMA_(kf[2],qr0[2],C0),   s1+=P1[3];s1+=P1[4];s1+=P1[5];s1+=P1[6];PIN(s1),     pw01[0]=PKW(P0,8), pw01[1]=PKW(P0,10), pw01); \
    GAPA(C1=MFMA_(kf[2],qr1[2],C1),   s1+=P1[7];s1+=P1[8];s1+=P1[9];s1+=P1[10];PIN(s1),    pw01[2]=PKW(P0,12),pw01[3]=PKW(P0,14), pw01); \
    VRD(3); SBAR(); \
    GAPA(C0=MFMA_(kf[3],qr0[3],C0),   s1+=P1[11];s1+=P1[12];s1+=P1[13];s1+=P1[14];PIN(s1), pw11[0]=PKW(P1,8), pw11[1]=PKW(P1,10), pw11); \
    GAPA(C1=MFMA_(kf[3],qr1[3],C1),   s1+=P1[15];PIN(s1),                                  pw11[2]=PKW(P1,12),pw11[3]=PKW(P1,14), pw11); \
    l0+=s0; l1+=s1; \
    SBAR(); \
    KRD(GL,0); GAPB(o00=MFMA_(PAF(00),VFR(0),o00), C0,0); \
    KRD(GL,1); GAPB(o10=MFMA_(PAF(10),VFR(0),o10), C0,4); \
    KRD(GL,2); GAPB(o01=MFMA_(PAF(00),VFR(2),o01), C0,8); \
    KRD(GL,3); GAPB(o11=MFMA_(PAF(10),VFR(2),o11), C0,12); \
    GAPB(o00=MFMA_(PAF(01),VFR(1),o00), C1,0); \
    GAPB(o10=MFMA_(PAF(11),VFR(1),o10), C1,4); \
    GAPB(o01=MFMA_(PAF(01),VFR(3),o01), C1,8); \
    GAPB(o11=MFMA_(PAF(11),VFR(3),o11), C1,12); \
    }while(0)
  STEP(pB0,pB1,pA0,pA1,0,SLOTB,true); WAIT_BARC();
  for(int t=1;t<NT-1;++t){
    const int sc_=(t&3)*SLOTB, sp_=((t-1)&3)*SLOTB, sn_=((t+1)&3)*SLOTB;
    STEP(pA0,pA1,pB0,pB1,sp_+2048,sc_+512,true);
    STEP(pB0,pB1,pA0,pA1,sc_,sn_,true);
    WAIT_BARC();
  }
  { const int sc_=((NT-1)&3)*SLOTB, sp_=((NT-2)&3)*SLOTB;
    STEP(pA0,pA1,pB0,pB1,sp_+2048,sc_+512,true);
    STEP(pB0,pB1,pA0,pA1,sc_,0,false);
    WAIT_BARC();
    float s0=pB0[0]+pB0[1],s1=pB1[0]+pB1[1]; _Pragma("unroll") for(int r=2;r<16;++r){s0+=pB0[r];s1+=pB1[r];} l0+=s0; l1+=s1;
    pw00=(u32x4){PKW(pB0,0),PKW(pB0,2),PKW(pB0,4),PKW(pB0,6)};pw01=(u32x4){PKW(pB0,8),PKW(pB0,10),PKW(pB0,12),PKW(pB0,14)};pw10=(u32x4){PKW(pB1,0),PKW(pB1,2),PKW(pB1,4),PKW(pB1,6)};pw11=(u32x4){PKW(pB1,8),PKW(pB1,10),PKW(pB1,12),PKW(pB1,14)};
    SBAR(); const lds_cptr vp_=vp0+sc_+2048; VRD(0);VRD(1);VRD(2);VRD(3);
    o00=MFMA_(PAF(00),VFR(0),o00); o10=MFMA_(PAF(10),VFR(0),o10); o01=MFMA_(PAF(00),VFR(2),o01); o11=MFMA_(PAF(10),VFR(2),o11);
    o00=MFMA_(PAF(01),VFR(1),o00); o10=MFMA_(PAF(11),VFR(1),o10); o01=MFMA_(PAF(01),VFR(3),o01); o11=MFMA_(PAF(11),VFR(3),o11); }
  #undef PKW
  #undef PAF
  #undef VFR
  #undef PIN
  #undef GAPA
  #undef GAPB
  #undef EX
  #undef VRD
  #undef KRD
  #undef STEP
  {auto rr=__builtin_amdgcn_permlane32_swap(__float_as_uint(l0),__float_as_uint(l0),false,false);l0=__uint_as_float(rr[0])+__uint_as_float(rr[1]);}
  {auto rr=__builtin_amdgcn_permlane32_swap(__float_as_uint(l1),__float_as_uint(l1),false,false);l1=__uint_as_float(rr[0])+__uint_as_float(rr[1]);}
  if(hi==0){wsf[r32]=l0;wsf[32+r32]=l1;} asm volatile("s_waitcnt lgkmcnt(0)":::"memory");
  bf16*Ow=O+(rowbase+q0+wq*64)*OP+512+hh*D; bf16*stg=(bf16*)(shm+LDS_OST)+wid*4096;
  #define FINAL(OA,OB,LOFF,ROFF) do{ _Pragma("unroll") for(int r=0;r<16;++r){ const int orow=crow(r,hi); const float rl=__builtin_amdgcn_rcpf(wsf[(LOFF)+orow]); \
      stg[((ROFF)+orow)*64+r32]=(bf16)f2bf(OA[r]*rl); stg[((ROFF)+orow)*64+32+r32]=(bf16)f2bf(OB[r]*rl);} }while(0)
  FINAL(o00,o01,0,0); FINAL(o10,o11,32,32);
  #undef FINAL
  if(nxt>=0){ qfetch(qr0,qr1,AQ,nxt>>16,(nxt>>8)&255,nxt&255); } else { _Pragma("unroll") for(int i=0;i<4;++i){qr0[i]=bf16x8{};qr1[i]=bf16x8{};} }
  asm volatile("s_waitcnt lgkmcnt(0)":::"memory");
  #pragma unroll
  for(int i=0;i<8;++i){const int row=i*8+(lane>>3),ch=lane&7; const u32x4 v=*(const u32x4*)(stg+row*64+ch*8); ATTN_STORE16(Ow+(long)row*OP+ch*8,v);}
  asm volatile("s_waitcnt lgkmcnt(0)":::"memory");
  #undef MFMA_
  #undef KLD
  #undef WAIT_BARC
}
constexpr int ATTN_LDS_BYTES=LDS_BYTES;
#undef SBAR
#undef WAIT_BAR
}

__device__ __forceinline__ void ph_attn_mfma(const P& p, int l, unsigned char* smem) {
    const int G = gridDim.x, bx = blockIdx.x;
    const attn_body::bf16* AQ = (const attn_body::bf16*)(p.ws + WS_AQKV); attn_body::bf16* O = (attn_body::bf16*)(p.ws + WS_R1);
    const int vcu = (bx % 8) * (G / 8) + bx / 8;
    float sref;
    { const int lane = ltid() & 63; float mq = fabsf(pin(p, 7)[l * 64 + lane]), mk = fabsf(pin(p, 8)[l * 64 + lane]);
#define AMX(M_) mq = fmaxf(mq, shx<M_>(mq)); mk = fmaxf(mk, shx<M_>(mk));
      AMX(1) AMX(2) AMX(4) AMX(8) AMX(16) AMX(32)
#undef AMX
      sref = 8.0f * 1.4426950408889634f * mq * mk * 1.002f; sref = __uint_as_float((unsigned)__builtin_amdgcn_readfirstlane((int)__float_as_uint(sref))); }
#define ATTN_UNIT_L(i) ((G == 256) ? ((i) < 4 ? (((vcu >> 5) << 7) | ((i) << 5) | (vcu & 31)) : -1) : ((i) * G + bx < 1024 ? (i) * G + bx : -1))
#define ATTN_DESC(L) ((((L) >> 7) >> 1) << 16 | (4 * (((L) >> 7) & 1) + (((L) >> 5) & 3)) << 8 | ((L) & 31))
    attn_body::bf16x8 qr0[4], qr1[4];
    BgJob jb; jb.stride = G * 4; { const int w_ = __builtin_amdgcn_readfirstlane(ltid() >> 6); jb.next = (w_ >= 4) ? bx * 4 + w_ - 4 : BG_TOTAL; }
    int L = ATTN_UNIT_L(0);
    if (L >= 0 && (ltid() >> 6) < 4) { const int d = ATTN_DESC(L); attn_body::qfetch(qr0, qr1, AQ, d >> 16, (d >> 8) & 255, d & 255); }
    for (int i = 0; L >= 0; ++i) {
        const int Ln = ATTN_UNIT_L(i + 1);
        const int pair = L >> 7, h4 = (L >> 5) & 3, qb = L & 31;
        attn_body::attn_unit<8>(pair >> 1, 4 * (pair & 1) + h4, pair & 1, qb, AQ, O, (char*)smem, sref, pin(p, 7) + l * 64, (const float*)(p.ws + WS_ROPE), qr0, qr1, Ln >= 0 ? ATTN_DESC(Ln) : -1, p, l, jb);
        L = Ln;
    }
#undef ATTN_UNIT_L
#undef ATTN_DESC
    { const int w_ = __builtin_amdgcn_readfirstlane(ltid() >> 6) & 3; const unsigned bgl = (unsigned)(uintptr_t)smem + attn_body::LDS_BYTES + w_ * 8192; const float* bgt = (const float*)(smem + attn_body::LDS_BYTES + w_ * 8192);
      while (jb.next < BG_TOTAL) { bg_dma(p, l, jb.next, bgl); asm volatile("s_waitcnt vmcnt(0)" ::: "memory"); bg_finish(p, jb.next, bgt); jb.next += jb.stride; } }
}

constexpr int R2_GAIN = 147456, R2_SCR = R2_GAIN + 4096, R2_BIAS = R2_SCR + 8 * 8 * 36 * 4, R2_CNT = R2_BIAS + 256, R2_RN = R2_CNT + 128;
__device__ __forceinline__ void ph_row2_mfma(const P& p, int l, unsigned char* smem, bool real) {
    typedef short bf16x8_t __attribute__((ext_vector_type(8)));
    typedef float f32x4_t __attribute__((ext_vector_type(4)));
    const int tid = ltid(), lane = tid & 63, r = lane & 15, kq = lane >> 4; const int wid = __builtin_amdgcn_readfirstlane(tid >> 6);
    const bf16_t* XB = (const bf16_t*)(p.ws + WS_XB); bf16_t* XN = (bf16_t*)(p.ws + WS_XN);
    const unsigned lds0 = (unsigned)(uintptr_t)smem;
    float* gainl = (float*)(smem + R2_GAIN); float* scr = (float*)(smem + R2_SCR) + wid * 8 * 36; float* biasl = (float*)(smem + R2_BIAS); unsigned* lcnt = (unsigned*)(smem + R2_CNT); float* rnb = (float*)(smem + R2_RN) + wid * 16;
    const int NG = M / 16; int g = blockIdx.x * 8 + wid;
    bf16x8_t xa[32];
    if (g < NG) {
#pragma unroll
        for (int ks = 0; ks < 32; ++ks) xa[ks] = *(const bf16x8_t*)(XB + (size_t)(g * 16 + r) * 1024 + 32 * ks + 8 * kq);
    }
    { const unsigned char* img = p.ws + WS_RIMG + (size_t)l * 2 * RIMG_PART * 2;
      for (int pc = wid; pc < 144; pc += 8) attn_body::glds16(img + (size_t)pc * 1024 + lane * 16, (unsigned)__builtin_amdgcn_readfirstlane(lds0 + pc * 1024)); }
    if (tid < 256) ((float4*)gainl)[tid] = ((const float4*)(pin(p, 10) + l * 1024))[tid];
    if (tid < 32) { lcnt[tid] = 0u; biasl[tid] = pin(p, 14)[l * 32 + tid]; }
    if (tid >= 64 && tid < 68) biasl[32 + tid - 64] = pin(p, 12)[l * 4 + tid - 64];
    asm volatile("s_waitcnt vmcnt(0)" ::: "memory");
    __syncthreads();
    const __attribute__((address_space(3))) unsigned char* wl = (const __attribute__((address_space(3))) unsigned char*)smem;
    for (; g < NG; g += gridDim.x * 8) {
        const int row0 = g * 16;
        f32x4_t d0 = {0.f, 0.f, 0.f, 0.f}, d1 = d0, d2 = d0, dss = d0;
#pragma unroll
        for (int ks = 0; ks < 32; ++ks) {
            const bf16x8_t b0h = *(const __attribute__((address_space(3))) bf16x8_t*)(wl + ((0 * 32 + ks) * 64 + lane) * 16), b1h = *(const __attribute__((address_space(3))) bf16x8_t*)(wl + ((1 * 32 + ks) * 64 + lane) * 16);
            const bf16x8_t b2h = *(const __attribute__((address_space(3))) bf16x8_t*)(wl + 65536 + ((ks * 4 + kq) * 4 + (r & 3)) * 16);
            const bf16x8_t b0l = *(const __attribute__((address_space(3))) bf16x8_t*)(wl + RIMG_PART * 2 + ((0 * 32 + ks) * 64 + lane) * 16), b1l = *(const __attribute__((address_space(3))) bf16x8_t*)(wl + RIMG_PART * 2 + ((1 * 32 + ks) * 64 + lane) * 16);
            const bf16x8_t b2l = *(const __attribute__((address_space(3))) bf16x8_t*)(wl + RIMG_PART * 2 + 65536 + ((ks * 4 + kq) * 4 + (r & 3)) * 16);
            d0 = __builtin_amdgcn_mfma_f32_16x16x32_bf16(xa[ks], b0h, d0, 0, 0, 0); d1 = __builtin_amdgcn_mfma_f32_16x16x32_bf16(xa[ks], b1h, d1, 0, 0, 0); d2 = __builtin_amdgcn_mfma_f32_16x16x32_bf16(xa[ks], b2h, d2, 0, 0, 0);
            d0 = __builtin_amdgcn_mfma_f32_16x16x32_bf16(xa[ks], b0l, d0, 0, 0, 0); d1 = __builtin_amdgcn_mfma_f32_16x16x32_bf16(xa[ks], b1l, d1, 0, 0, 0); d2 = __builtin_amdgcn_mfma_f32_16x16x32_bf16(xa[ks], b2l, d2, 0, 0, 0);
            dss = __builtin_amdgcn_mfma_f32_16x16x32_bf16(xa[ks], xa[ks], dss, 0, 0, 0);
        }
        { const int i = r & 3; const float dg = (i == 0) ? dss[0] : (i == 1) ? dss[1] : (i == 2) ? dss[2] : dss[3];
          if ((r >> 2) == kq) rnb[r] = 1.0f / sqrtf(dg * (1.0f / 1024.0f) + EPS); }
        asm volatile("s_waitcnt lgkmcnt(0)" ::: "memory");
        const float rnr = rnb[r];
        const f32x4_t rnd = *(const f32x4_t*)(rnb + 4 * kq);
#pragma unroll
        for (int ks = 0; ks < 32; ++ks) {
            const float4 ga = *(const float4*)(gainl + 32 * ks + 8 * kq), gb = *(const float4*)(gainl + 32 * ks + 8 * kq + 4);
            const u32x4 x = __builtin_bit_cast(u32x4, xa[ks]); u32x4 w;
            w.x = pk2(bf2f(x.x & 0xffffu) * rnr * ga.x, bf2f(x.x >> 16) * rnr * ga.y); w.y = pk2(bf2f(x.y & 0xffffu) * rnr * ga.z, bf2f(x.y >> 16) * rnr * ga.w);
            w.z = pk2(bf2f(x.z & 0xffffu) * rnr * gb.x, bf2f(x.z >> 16) * rnr * gb.y); w.w = pk2(bf2f(x.w & 0xffffu) * rnr * gb.z, bf2f(x.w >> 16) * rnr * gb.w);
            *(u32x4*)(XN + (size_t)(row0 + r) * 1024 + 32 * ks + 8 * kq) = w;
        }
        const int gn = g + gridDim.x * 8;
        if (gn < NG) {
#pragma unroll
            for (int ks = 0; ks < 32; ++ks) xa[ks] = *(const bf16x8_t*)(XB + (size_t)(gn * 16 + r) * 1024 + 32 * ks + 8 * kq);
        }
#pragma unroll
        for (int half = 0; half < 2; ++half) {
            if ((kq >> 1) == half) {
#pragma unroll
                for (int i = 0; i < 4; ++i) { const int rl = 4 * (kq & 1) + i; const float rv = rnd[i];
                    scr[rl * 36 + r] = d0[i] * rv; scr[rl * 36 + 16 + r] = d1[i] * rv; if (r < 4) scr[rl * 36 + 32 + r] = d2[i] * rv; }
            }
            asm volatile("s_waitcnt lgkmcnt(0)" ::: "memory");
            if (lane < 8) {
                const float* lg = scr + lane * 36; const int m = row0 + 8 * half + lane;
                int gix = 0; float gm = lg[32] + biasl[32]; float gl[4]; gl[0] = gm;
#pragma unroll
                for (int q = 1; q < 4; ++q) { gl[q] = lg[32 + q] + biasl[32 + q]; if (gl[q] > gm) { gm = gl[q]; gix = q; } }
                float gs = 0.f;
#pragma unroll
                for (int q = 0; q < 4; ++q) gs += __expf(gl[q] - gm);
                const float gval = 1.0f / gs;
                float sel[8];
#pragma unroll
                for (int i = 0; i < 8; ++i) sel[i] = lg[8 * gix + i] + biasl[8 * gix + i];
                int i0 = 0; float v0 = sel[0];
#pragma unroll
                for (int i = 1; i < 8; ++i) if (sel[i] > v0) { v0 = sel[i]; i0 = i; }
                int i1 = -1; float v1 = -INFINITY;
#pragma unroll
                for (int i = 0; i < 8; ++i) if (i != i0 && sel[i] > v1) { v1 = sel[i]; i1 = i; }
                const float e1 = __expf(v1 - v0); const float w0 = gval / (1.f + e1), w1 = gval * e1 / (1.f + e1);
                const int ea_ = gix * 8 + i0, eb_ = gix * 8 + i1;
                ((int*)(p.ws + WS_TOPE))[2 * m] = ea_; ((int*)(p.ws + WS_TOPE))[2 * m + 1] = eb_;
                ((float*)(p.ws + WS_TOPW))[2 * m] = w0; ((float*)(p.ws + WS_TOPW))[2 * m + 1] = w1;
                atomicAdd(&lcnt[ea_], 1u); atomicAdd(&lcnt[eb_], 1u);
            }
            asm volatile("s_waitcnt lgkmcnt(0)" ::: "memory");
        }
    }
    __syncthreads();
    if (real && tid < 32 && lcnt[tid]) atomicAdd((unsigned*)(p.ws + WS_CTL) + CW_CNT + l * 32 + tid, lcnt[tid]);
}

namespace ml {
using attn_body::bf16x8; using attn_body::s16x4; using attn_body::f32x16; using attn_body::lds_cptr; using attn_body::vtr; using attn_body::glds16; using attn_body::crow;
constexpr size_t WS_NST = WS_CST + 64 * MiB;
constexpr size_t WS_NPV = WS_NST + 1 * MiB;
constexpr size_t WS_CPV = WS_XN;
constexpr size_t WS_MST = 17 * MiB + 65536;
constexpr float L2E = 1.4426950408889634f;
constexpr float QK_SCALE = 0.08838834764831845f;
#define ML_MFMA(a, b, c) __builtin_amdgcn_mfma_f32_32x32x16_bf16(a, b, c, 0, 0, 0)
__device__ __forceinline__ void chunk_scalars(const float* GA, int row0, int h, float* sc, float* tmp, int tid) {
    const int lane = tid & 63, wave = tid >> 6, dir = tid >> 7, jj = tid & 127, j = dir ? 127 - jj : jj;
    float x = 0.f, ig = 0.f;
    if (tid < 256) { const size_t m = (size_t)(row0 + j); ig = GA[m * 16 + 8 * dir + h]; x = GA[m * 16 + 8 * dir + 4 + h]; }
#pragma unroll
    for (int o = 1; o < 64; o <<= 1) { const float y = __uint_as_float((unsigned)__builtin_amdgcn_ds_bpermute((lane >= o ? lane - o : lane) << 2, (int)__float_as_uint(x))); if (lane >= o) x += y; }
    if (lane == 63 && tid < 256) tmp[wave] = x;
    __syncthreads();
    if (tid < 256 && (wave & 1)) x += tmp[wave - 1];
    const float u = ig - x;
    float pm = u;
#pragma unroll
    for (int o = 1; o < 64; o <<= 1) { const float y = __uint_as_float((unsigned)__builtin_amdgcn_ds_bpermute((lane >= o ? lane - o : lane) << 2, (int)__float_as_uint(pm))); if (lane >= o) pm = fmaxf(pm, y); }
    if (lane == 63 && tid < 256) tmp[8 + wave] = pm;
    __syncthreads();
    if (tid < 256) { if (wave & 1) pm = fmaxf(pm, tmp[8 + wave - 1]); sc[dir * 384 + j] = x; sc[dir * 384 + 128 + j] = u; sc[dir * 384 + 256 + j] = pm; }
}
__device__ __forceinline__ bf16x8 trfrag(lds_cptr p) { const s16x4 lo = vtr(p), hi = vtr(p + 512); return (bf16x8){lo[0], lo[1], lo[2], lo[3], hi[0], hi[1], hi[2], hi[3]}; }
__device__ __forceinline__ bf16x8 scale8(bf16x8 f, const float4 wa, const float4 wb) {
    const u32x4 x = __builtin_bit_cast(u32x4, f); u32x4 o;
    o.x = pk2(bf2f(x.x & 0xffffu) * wa.x, bf2f(x.x >> 16) * wa.y); o.y = pk2(bf2f(x.y & 0xffffu) * wa.z, bf2f(x.y >> 16) * wa.w);
    o.z = pk2(bf2f(x.z & 0xffffu) * wb.x, bf2f(x.z >> 16) * wb.y); o.w = pk2(bf2f(x.w & 0xffffu) * wb.z, bf2f(x.w >> 16) * wb.w);
    return __builtin_bit_cast(bf16x8, o);
}
__device__ __forceinline__ void dma_vlayout(const bf16_t* src  , unsigned dst, int wid, int lane) {
#pragma unroll
    for (int q = 0; q < 4; ++q) { const int pc = wid * 4 + q, db = pc >> 3, kg = pc & 7;
        glds16(src + (size_t)(16 * kg + (lane >> 2)) * 1024 + 32 * db + 8 * (lane & 3), (unsigned)__builtin_amdgcn_readfirstlane(dst + db * 8192 + kg * 1024)); }
}
__device__ __forceinline__ void dma_klayout(const bf16_t* src, unsigned dst, int wid, int lane) {
#pragma unroll
    for (int q = 0; q < 4; ++q) { const int pc = wid * 4 + q, ch = pc >> 1, hf = pc & 1;
        glds16(src + (size_t)(64 * hf + lane) * 1024 + 8 * ch, (unsigned)__builtin_amdgcn_readfirstlane(dst + ch * 2048 + hf * 1024)); }
}
__device__ __forceinline__ void dma_linear32k(const unsigned char* src, unsigned dst, int wid, int lane) {
#pragma unroll
    for (int q = 0; q < 4; ++q) { const int pc = wid * 4 + q; glds16(src + pc * 1024 + lane * 16, (unsigned)__builtin_amdgcn_readfirstlane(dst + pc * 1024)); }
}

__device__ __forceinline__ void m1_chunk(const P& p, int l, unsigned char* smem, int rc) {
    const int tid = ltid(), lane = tid & 63, r32 = lane & 31, hi = lane >> 5; const int wid = __builtin_amdgcn_readfirstlane(tid >> 6);
    const bf16_t* QKC = (const bf16_t*)(p.ws + WS_QKC); const bf16_t* MVO = (const bf16_t*)(p.ws + WS_MVO); const float* GA = (const float*)(p.ws + WS_GATES);
    unsigned char* CST = p.ws + WS_CST; float* NST = (float*)(p.ws + WS_NST); float* MST = (float*)(p.ws + WS_MST);
    const unsigned lds0 = (unsigned)(uintptr_t)smem;
    float* sc = (float*)(smem + LDS_RING + 256); float* wts = sc + 768; float* tmp = wts + 256;
    const int laddr = ((lane >> 4) & 1) * 32 + (lane & 3) * 8 + (4 * hi + ((lane & 15) >> 2)) * 64;
    const int b = rc >> 6, c = rc & 63, row0 = b * SEQ + c * 128;
    dma_vlayout(QKC + (size_t)row0 * 1024 + 512, lds0, wid, lane);
    dma_vlayout(MVO + (size_t)row0 * 1024, lds0 + 32768, wid, lane);
    for (int h = 0; h < 4; ++h) {
        const int unit = (b * 4 + h) * 64 + c;
        const unsigned boff = (unsigned)(h & 1) * 65536u;
        const lds_cptr s3 = (lds_cptr)smem + boff;
        __syncthreads();
        chunk_scalars(GA, row0, h, sc, tmp, tid);
        __syncthreads();
        if (tid < 256) { const int dir = tid >> 7, j = tid & 127; const float umax = sc[dir * 384 + 256 + (dir ? 0 : 127)]; wts[dir * 128 + j] = __expf(sc[dir * 384 + 128 + j] - umax);
            if (j == 0) { const float blast = sc[dir * 384 + (dir ? 0 : 127)]; MST[(unit * 2 + dir) * 4] = blast + umax; MST[(unit * 2 + dir) * 4 + 1] = blast; } }
        if (h < 3) { dma_vlayout(QKC + (size_t)row0 * 1024 + 512 + 128 * (h + 1), lds0 + (65536u - boff), wid, lane);
                     dma_vlayout(MVO + (size_t)row0 * 1024 + 128 * (h + 1), lds0 + (65536u - boff) + 32768, wid, lane);
                     asm volatile("s_waitcnt vmcnt(8)" ::: "memory"); }
        else asm volatile("s_waitcnt vmcnt(0)" ::: "memory");
        __syncthreads();
        const int vb = wid & 3, kb0 = 2 * (wid >> 2), kbn = wid & 3, dirn = wid >> 2;
        f32x16 a00 = {}, a01 = {}, a10 = {}, a11 = {}, an = {};
#pragma unroll 2
        for (int ks = 0; ks < 8; ++ks) {
            const bf16x8 vf = trfrag(s3 + 32768 + vb * 8192 + ks * 1024 + laddr);
            const bf16x8 k0 = trfrag(s3 + kb0 * 8192 + ks * 1024 + laddr), k1 = trfrag(s3 + (kb0 + 1) * 8192 + ks * 1024 + laddr), kn = trfrag(s3 + kbn * 8192 + ks * 1024 + laddr);
            const float4 wfa = *(const float4*)(wts + 16 * ks + 4 * hi), wfb = *(const float4*)(wts + 16 * ks + 8 + 4 * hi);
            const float4 wba = *(const float4*)(wts + 128 + 16 * ks + 4 * hi), wbb = *(const float4*)(wts + 128 + 16 * ks + 8 + 4 * hi);
            const bf16x8 vff = scale8(vf, wfa, wfb), vfb = scale8(vf, wba, wbb);
            a00 = ML_MFMA(k0, vff, a00); a01 = ML_MFMA(k1, vff, a01); a10 = ML_MFMA(k0, vfb, a10); a11 = ML_MFMA(k1, vfb, a11);
            const float4 wna = dirn ? wba : wfa, wnb = dirn ? wbb : wfb;
            u32x4 wn; wn.x = pk2(wna.x, wna.y); wn.y = pk2(wna.z, wna.w); wn.z = pk2(wnb.x, wnb.y); wn.w = pk2(wnb.z, wnb.w);
            if (r32 != 0) wn = (u32x4){0u, 0u, 0u, 0u};
            an = ML_MFMA(kn, __builtin_bit_cast(bf16x8, wn), an);
        }
#pragma unroll
        for (int dir = 0; dir < 2; ++dir)
#pragma unroll
            for (int kk = 0; kk < 2; ++kk) { const f32x16& a = dir ? (kk ? a11 : a10) : (kk ? a01 : a00); unsigned char* img = CST + (size_t)(unit * 2 + dir) * 32768;
#pragma unroll
                for (int g = 0; g < 4; ++g) { u32x2 w; w.x = pk2(a[4 * g], a[4 * g + 1]); w.y = pk2(a[4 * g + 2], a[4 * g + 3]);
                    *(u32x2*)(img + (4 * (kb0 + kk) + g) * 2048 + (32 * vb + r32) * 16 + 8 * hi) = w; } }
        if (r32 == 0) {
#pragma unroll
            for (int r = 0; r < 16; ++r) NST[(size_t)(unit * 2 + dirn) * 128 + 32 * kbn + crow(r, hi)] = an[r]; }
    }
}

__device__ __forceinline__ void ph_m2(const P& p, int l, unsigned char* smem) {
    const int tid = ltid();
    unsigned char* CST = p.ws + WS_CST; float* NST = (float*)(p.ws + WS_NST); float* MST = (float*)(p.ws + WS_MST);
    unsigned char* CPV = p.ws + WS_CPV; float* NPV = (float*)(p.ws + WS_NPV);
    float* dold = (float*)smem; float* dnew = dold + 64; float* mpv = dnew + 64; float* ml = mpv + 64; float* bl = ml + 64;
    for (int item = blockIdx.x; item < 256; item += gridDim.x) {
        const int chain = item >> 3, slice = item & 7, bh = chain >> 1, dir = chain & 1;
        __syncthreads();
        if (tid < 64) { const int unit = bh * 64 + tid; ml[tid] = MST[(unit * 2 + dir) * 4]; bl[tid] = MST[(unit * 2 + dir) * 4 + 1]; }
        __syncthreads();
        if (tid < 64) {
            const int c = dir ? 63 - tid : tid; const float b = bl[c], mlv = ml[c];
            float Bi = b;
#pragma unroll
            for (int o = 1; o < 64; o <<= 1) { const float y = __uint_as_float((unsigned)__builtin_amdgcn_ds_bpermute((tid >= o ? tid - o : tid) << 2, (int)__float_as_uint(Bi))); if (tid >= o) Bi += y; }
            float rm = mlv - Bi;
#pragma unroll
            for (int o = 1; o < 64; o <<= 1) { const float y = __uint_as_float((unsigned)__builtin_amdgcn_ds_bpermute((tid >= o ? tid - o : tid) << 2, (int)__float_as_uint(rm))); if (tid >= o) rm = fmaxf(rm, y); }
            const float mn = Bi + fmaxf(0.f, rm);
            float m = __uint_as_float((unsigned)__builtin_amdgcn_ds_bpermute((tid >= 1 ? tid - 1 : tid) << 2, (int)__float_as_uint(mn))); if (tid == 0) m = 0.f;
            mpv[c] = m; dold[c] = __expf(b + m - mn); dnew[c] = __expf(mlv - mn); }
        __syncthreads();
        float c0 = 0.f, c1 = 0.f, c2 = 0.f, c3 = 0.f, nn = 0.f;
        const size_t eoff = (size_t)slice * 4096 + (size_t)tid * 8;
        const bool nrow = (slice == 0 && tid < 128);
        u32x2 vn[8]; float nvn[8];
#pragma unroll
        for (int k = 0; k < 8; ++k) { const int c = dir ? 63 - k : k; const int unit = bh * 64 + c; vn[k] = *(const u32x2*)(CST + (size_t)(unit * 2 + dir) * 32768 + eoff); nvn[k] = nrow ? NST[(size_t)(unit * 2 + dir) * 128 + tid] : 0.f; }
        for (int s0 = 0; s0 < 64; s0 += 8) {
            u32x2 v[8]; float nv[8];
#pragma unroll
            for (int k = 0; k < 8; ++k) { v[k] = vn[k]; nv[k] = nvn[k]; }
            if (s0 + 8 < 64) {
#pragma unroll
                for (int k = 0; k < 8; ++k) { const int s = s0 + 8 + k; const int c = dir ? 63 - s : s; const int unit = bh * 64 + c; vn[k] = *(const u32x2*)(CST + (size_t)(unit * 2 + dir) * 32768 + eoff); nvn[k] = nrow ? NST[(size_t)(unit * 2 + dir) * 128 + tid] : 0.f; }
            }
#pragma unroll
            for (int k = 0; k < 8; ++k) {
                const int s = s0 + k; const int c = dir ? 63 - s : s; const int unit = bh * 64 + c; const float fo = dold[c], fn = dnew[c];
                u32x2 o; o.x = pk2(c0, c1); o.y = pk2(c2, c3); *(u32x2*)(CPV + (size_t)(unit * 2 + dir) * 32768 + eoff) = o;
                c0 = c0 * fo + bf2f(v[k].x & 0xffffu) * fn; c1 = c1 * fo + bf2f(v[k].x >> 16) * fn; c2 = c2 * fo + bf2f(v[k].y & 0xffffu) * fn; c3 = c3 * fo + bf2f(v[k].y >> 16) * fn;
                if (nrow) { NPV[(size_t)(unit * 2 + dir) * 128 + tid] = nn; nn = nn * fo + nv[k] * fn; }
            }
        }
        if (slice == 0 && tid < 64) MST[((bh * 64 + tid) * 2 + dir) * 4 + 2] = mpv[tid];
    }
}

__device__ __forceinline__ void ph_m3(const P& p, int l, unsigned char* smem) {
    const int tid = ltid(), lane = tid & 63, r32 = lane & 31, hi = lane >> 5; const int wid = __builtin_amdgcn_readfirstlane(tid >> 6);
    const int rb = wid >> 1, vh = wid & 1;
    const bf16_t* QKC = (const bf16_t*)(p.ws + WS_QKC); const bf16_t* MVO = (const bf16_t*)(p.ws + WS_MVO); const float* GA = (const float*)(p.ws + WS_GATES);
    const unsigned char* CST = p.ws + WS_CPV; const float* NST = (const float*)(p.ws + WS_NPV); const float* MST = (const float*)(p.ws + WS_MST);
    bf16_t* HM = (bf16_t*)(p.ws + WS_R1); const float* mg = pin(p, 6) + l * 512;
    const unsigned lds0 = (unsigned)(uintptr_t)smem;
    float* sc = (float*)(smem + LDS_RING + 256); float* Mi = sc + 768; float* ew = Mi + 256; float* npv = ew + 256; float* tmp = npv + 256; float* wsf = tmp + 16 + wid * 64;
    float* Aw = tmp + 16 + 512; float* Bw = Aw + 256;
    float* stg = (float*)smem;
    const lds_cptr s3 = (lds_cptr)smem;
    const int laddr = ((lane >> 4) & 1) * 32 + (lane & 3) * 8 + (4 * hi + ((lane & 15) >> 2)) * 64;
    for (int unit = blockIdx.x; unit < 1024; unit += gridDim.x) {
        const int b = unit >> 8, h = (unit >> 6) & 3, c = unit & 63, row0 = b * SEQ + c * 128;
        __syncthreads();
        dma_klayout(QKC + (size_t)row0 * 1024 + 512 + 128 * h, lds0, wid, lane);
        dma_vlayout(MVO + (size_t)row0 * 1024 + 128 * h, lds0 + 32768, wid, lane);
        dma_linear32k(CST + (size_t)(unit * 2) * 32768, lds0 + 65536, wid, lane);
        dma_linear32k(CST + (size_t)(unit * 2 + 1) * 32768, lds0 + 98304, wid, lane);
        bf16x8 qr[8];
#pragma unroll
        for (int ks = 0; ks < 8; ++ks) qr[ks] = *(const bf16x8*)(QKC + (size_t)(row0 + 32 * rb + r32) * 1024 + 128 * h + 16 * ks + 8 * hi);
        chunk_scalars(GA, row0, h, sc, tmp, tid);
        __syncthreads();
        if (tid < 256) { const int dir = tid >> 7, j = tid & 127; const float mp = MST[(unit * 2 + dir) * 4 + 2]; const float Mx = fmaxf(sc[dir * 384 + 256 + j], mp);
            Mi[dir * 128 + j] = Mx; ew[dir * 128 + j] = __expf(mp - Mx) * QK_SCALE; npv[dir * 128 + j] = NST[(size_t)(unit * 2 + dir) * 128 + j];
            const float umax = sc[dir * 384 + 256 + (dir ? 0 : 127)];
            Aw[dir * 128 + j] = __expf(sc[dir * 384 + 128 + j] - umax);
            Bw[dir * 128 + j] = __expf(fminf(umax - Mx, 80.f)) * QK_SCALE; }
        asm volatile("s_waitcnt vmcnt(0)" ::: "memory");
        __syncthreads();
        f32x16 hacc[2]; hacc[0] = f32x16{}; hacc[1] = f32x16{};
#pragma unroll 1
        for (int dir = 0; dir < 2; ++dir) {
            const lds_cptr Cimg = s3 + 65536 + dir * 32768;
            f32x16 o[2]; o[0] = f32x16{}; o[1] = f32x16{};
#pragma unroll
            for (int kb = 0; kb < 8; kb += 4) {
                bf16x8 cf[4][2];
#pragma unroll
                for (int k2 = 0; k2 < 4; ++k2)
#pragma unroll
                    for (int blk = 0; blk < 2; ++blk) cf[k2][blk] = *(const __attribute__((address_space(3))) bf16x8*)(Cimg + (2 * (kb + k2) + hi) * 2048 + (32 * (2 * vh + blk) + r32) * 16);
#pragma unroll
                for (int k2 = 0; k2 < 4; ++k2)
#pragma unroll
                    for (int blk = 0; blk < 2; ++blk) o[blk] = ML_MFMA(qr[kb + k2], cf[k2][blk], o[blk]);
                asm volatile("" ::: "memory");
            }
#pragma unroll
            for (int g = 0; g < 4; ++g) { const float4 e4 = *(const float4*)(ew + dir * 128 + 32 * rb + 8 * g + 4 * hi);
#pragma unroll
                for (int blk = 0; blk < 2; ++blk) { o[blk][4 * g] *= e4.x; o[blk][4 * g + 1] *= e4.y; o[blk][4 * g + 2] *= e4.z; o[blk][4 * g + 3] *= e4.w; } }
            float dq = 0.f;
#pragma unroll
            for (int ks = 0; ks < 8; ++ks) { const u32x4 x = __builtin_bit_cast(u32x4, qr[ks]); const float4 na = *(const float4*)(npv + dir * 128 + 16 * ks + 8 * hi), nb2 = *(const float4*)(npv + dir * 128 + 16 * ks + 8 * hi + 4);
                dq += bf2f(x.x & 0xffffu) * na.x + bf2f(x.x >> 16) * na.y + bf2f(x.y & 0xffffu) * na.z + bf2f(x.y >> 16) * na.w + bf2f(x.z & 0xffffu) * nb2.x + bf2f(x.z >> 16) * nb2.y + bf2f(x.w & 0xffffu) * nb2.z + bf2f(x.w >> 16) * nb2.w; }
            dq += shx<32>(dq);
            const float Mrow = Mi[dir * 128 + 32 * rb + r32]; const float Brow = Bw[dir * 128 + 32 * rb + r32];
            float dsum = 0.f;
            const int jt0 = dir ? rb : 0, jt1 = dir ? 3 : rb;
            for (int jt = jt0; jt <= jt1; ++jt) {
                f32x16 pt = f32x16{};
                bf16x8 kf[8], vfr[2][2];
#pragma unroll
                for (int ks = 0; ks < 8; ++ks) kf[ks] = *(const __attribute__((address_space(3))) bf16x8*)(s3 + (2 * ks + hi) * 2048 + (32 * jt + r32) * 16);
#pragma unroll
                for (int blk = 0; blk < 2; ++blk) { vfr[blk][0] = trfrag(s3 + 32768 + (2 * vh + blk) * 8192 + (2 * jt) * 1024 + laddr); vfr[blk][1] = trfrag(s3 + 32768 + (2 * vh + blk) * 8192 + (2 * jt + 1) * 1024 + laddr); }
#pragma unroll
                for (int ks = 0; ks < 8; ++ks) pt = ML_MFMA(kf[ks], qr[ks], pt);
                const bool diag = (jt == rb);
#pragma unroll
                for (int g = 0; g < 4; ++g) { const float4 a4 = *(const float4*)(Aw + dir * 128 + 32 * jt + 8 * g + 4 * hi);
#pragma unroll
                    for (int i = 0; i < 4; ++i) { const int kl = 8 * g + 4 * hi + i; const float aa = (i == 0) ? a4.x : (i == 1) ? a4.y : (i == 2) ? a4.z : a4.w;
                        const bool ok = !diag || (dir ? (kl >= r32) : (kl <= r32));
                        const float pv = ok ? pt[4 * g + i] * (aa * Brow) : 0.f; pt[4 * g + i] = pv; dsum += pv; } }
                u32x4 pw0, pw1;
                pw0.x = pk2(pt[0], pt[1]); pw0.y = pk2(pt[2], pt[3]); pw0.z = pk2(pt[4], pt[5]); pw0.w = pk2(pt[6], pt[7]);
                pw1.x = pk2(pt[8], pt[9]); pw1.y = pk2(pt[10], pt[11]); pw1.z = pk2(pt[12], pt[13]); pw1.w = pk2(pt[14], pt[15]);
#pragma unroll
                for (int blk = 0; blk < 2; ++blk) { o[blk] = ML_MFMA(__builtin_bit_cast(bf16x8, pw0), vfr[blk][0], o[blk]); o[blk] = ML_MFMA(__builtin_bit_cast(bf16x8, pw1), vfr[blk][1], o[blk]); }
            }
            dsum += shx<32>(dsum);
            const float den = dsum + dq * ew[dir * 128 + 32 * rb + r32];
            const float mrow = sc[dir * 384 + 32 * rb + r32] + Mrow;
            const float rinv = 1.0f / fmaxf(fabsf(den), __expf(-mrow));
            asm volatile("s_waitcnt lgkmcnt(0)" ::: "memory");
            if (hi == 0) wsf[r32] = rinv;
            asm volatile("s_waitcnt lgkmcnt(0)" ::: "memory");
#pragma unroll
            for (int r = 0; r < 16; ++r) { const float rv = wsf[crow(r, hi)]; hacc[0][r] += o[0][r] * rv; hacc[1][r] += o[1][r] * rv; }
            asm volatile("s_waitcnt lgkmcnt(0)" ::: "memory");
        }
        __syncthreads();
#pragma unroll
        for (int blk = 0; blk < 2; ++blk)
#pragma unroll
            for (int r = 0; r < 16; ++r) stg[(32 * rb + crow(r, hi)) * 132 + 64 * vh + 32 * blk + r32] = hacc[blk][r];
        __syncthreads();
        { const int row = tid >> 2, q4 = tid & 3; float v[32];
#pragma unroll
          for (int q = 0; q < 8; ++q) { const float4 t = *(const float4*)(stg + row * 132 + 32 * q4 + 4 * q); v[4 * q] = t.x; v[4 * q + 1] = t.y; v[4 * q + 2] = t.z; v[4 * q + 3] = t.w; }
          float ss = 0.f;
#pragma unroll
          for (int q = 0; q < 32; ++q) ss += v[q] * v[q];
          ss += shx<1>(ss); ss += shx<2>(ss);
          const float rn = 1.0f / sqrtf(ss * (1.0f / 128.0f) + EPS);
          const bf16_t* mo = MVO + (size_t)(row0 + row) * 1024 + 512 + 128 * h + 32 * q4; bf16_t* op = HM + (size_t)(row0 + row) * 1024 + 128 * h + 32 * q4; const float* gp = mg + 128 * h + 32 * q4;
#pragma unroll
          for (int q = 0; q < 4; ++q) { float f[8]; unpack8(*(const u32x4*)(mo + 8 * q), f); u32x4 w;
              w.x = pk2(v[8 * q] * rn * gp[8 * q] * sigmoid_f(f[0]), v[8 * q + 1] * rn * gp[8 * q + 1] * sigmoid_f(f[1]));
              w.y = pk2(v[8 * q + 2] * rn * gp[8 * q + 2] * sigmoid_f(f[2]), v[8 * q + 3] * rn * gp[8 * q + 3] * sigmoid_f(f[3]));
              w.z = pk2(v[8 * q + 4] * rn * gp[8 * q + 4] * sigmoid_f(f[4]), v[8 * q + 5] * rn * gp[8 * q + 5] * sigmoid_f(f[5]));
              w.w = pk2(v[8 * q + 6] * rn * gp[8 * q + 6] * sigmoid_f(f[6]), v[8 * q + 7] * rn * gp[8 * q + 7] * sigmoid_f(f[7]));
              *(u32x4*)(op + 8 * q) = w; } }
    }
}
#undef ML_MFMA
}

__device__ __forceinline__ void ph_prep(const P& p, int l, unsigned char* smem) {
    const int tid = ltid();
    const bf16_t* R1 = (const bf16_t*)(p.ws + WS_R1); bf16_t* QKC = (bf16_t*)(p.ws + WS_QKC);
    bf16_t* AQ = (bf16_t*)(p.ws + WS_AQKV);
    const int tq0 = blockIdx.x * 512 + tid, tqs = gridDim.x * 512;
    u32x4 pre_a[2], pre_b[2];
#pragma unroll
    for (int i = 0; i < 2; ++i) { const int tq = tq0 + i * tqs; pre_a[i] = (u32x4){0u, 0u, 0u, 0u}; pre_b[i] = pre_a[i];
        if (tq < M * 2 * 4) { const int task = tq >> 2, q = tq & 3, m = task >> 1, hh = 8 + (task & 1); const bf16_t* ptr = AQ + (size_t)m * 768 + 64 * hh + 16 * q; pre_a[i] = *(const u32x4*)ptr; pre_b[i] = *(const u32x4*)(ptr + 8); } }
    {
        const int c8 = (tid & 127) * 8, rg = tid >> 7;
        const float* cw = pin(p, 3) + (size_t)l * 3 * 1024 + c8; const float* cb = pin(p, 4) + (size_t)l * 1024 + c8;
        float w0[8], w1[8], w2[8], bb[8];
#pragma unroll
        for (int q = 0; q < 8; ++q) { w0[q] = cw[q]; w1[q] = cw[1024 + q]; w2[q] = cw[2048 + q]; bb[q] = cb[q]; }
        for (int rc = blockIdx.x; rc < M / 128; rc += gridDim.x) {
            const int m0 = rc * 128 + rg * 32;
            float xm[8], xc[8], xp[8];
            if ((m0 & (SEQ - 1)) > 0) unpack8(*(const u32x4*)(R1 + (size_t)(m0 - 1) * 1024 + c8), xm); else {
#pragma unroll
                for (int q = 0; q < 8; ++q) xm[q] = 0.f; }
            unpack8(*(const u32x4*)(R1 + (size_t)m0 * 1024 + c8), xc);
            u32x4 qn[4];
#pragma unroll
            for (int u = 0; u < 4; ++u) { const int mm = m0 + 1 + u; qn[u] = ((mm & (SEQ - 1)) != 0) ? *(const u32x4*)(R1 + (size_t)mm * 1024 + c8) : (u32x4){0u, 0u, 0u, 0u}; }
            for (int i = 0; i < 32; i += 4) {
#pragma unroll
                for (int u = 0; u < 4; ++u) {
                    const int m = m0 + i + u;
                    unpack8(qn[u], xp);
                    { const int mm = m + 5; qn[u] = (i + u + 5 <= 32 && (mm & (SEQ - 1)) != 0) ? *(const u32x4*)(R1 + (size_t)mm * 1024 + c8) : (u32x4){0u, 0u, 0u, 0u}; }
                    float o[8];
#pragma unroll
                    for (int q = 0; q < 8; ++q) o[q] = silu_f(w0[q] * xm[q] + w1[q] * xc[q] + w2[q] * xp[q] + bb[q]);
                    u32x4 w; w.x = pk2(o[0], o[1]); w.y = pk2(o[2], o[3]); w.z = pk2(o[4], o[5]); w.w = pk2(o[6], o[7]);
                    *(u32x4*)(QKC + (size_t)m * 1024 + c8) = w;
#pragma unroll
                    for (int q = 0; q < 8; ++q) { xm[q] = xc[q]; xc[q] = xp[q]; }
                }
            }
            asm volatile("s_waitcnt vmcnt(0)" ::: "memory");
            __syncthreads();
            ml::m1_chunk(p, l, smem, rc);
        }
    }
    const float* rope = (const float*)(p.ws + WS_ROPE);
    const float* kg = pin(p, 8) + l * 64;
    int it = 0;
    for (int tq = tq0; tq < M * 2 * 4; tq += tqs, ++it) {
        const int task = tq >> 2, q = tq & 3, m = task >> 1, hh = 8 + (task & 1);
        bf16_t* ptr = AQ + (size_t)m * 768 + 64 * hh + 16 * q;
        float v[16];
        if (it == 0) { unpack8(pre_a[0], v); unpack8(pre_b[0], v + 8); } else if (it == 1) { unpack8(pre_a[1], v); unpack8(pre_b[1], v + 8); }
        else { unpack8(*(const u32x4*)ptr, v); unpack8(*(const u32x4*)(ptr + 8), v + 8); }
        float ss = 0.f;
#pragma unroll
        for (int d = 0; d < 16; ++d) ss += v[d] * v[d];
        ss += shx<1>(ss); ss += shx<2>(ss);
        const float r = 1.0f / sqrtf(ss * (1.0f / 64.0f) + EPS);
        const int t = m & (SEQ - 1), pos = (q >> 1) ? (t & 63) : (t >> 6);
        const float2* rp = (const float2*)rope + pos * 16;
        const bool up = (q & 1) != 0;
#pragma unroll
        for (int d = 0; d < 16; ++d) { const float x = v[d] * r * kg[16 * q + d]; const float o = shx<1>(x); const float2 cs = rp[d]; v[d] = x * cs.x + (up ? o : -o) * cs.y; }
        u32x4 w0, w1;
        w0.x = pk2(v[0], v[1]); w0.y = pk2(v[2], v[3]); w0.z = pk2(v[4], v[5]); w0.w = pk2(v[6], v[7]);
        w1.x = pk2(v[8], v[9]); w1.y = pk2(v[10], v[11]); w1.z = pk2(v[12], v[13]); w1.w = pk2(v[14], v[15]);
        *(u32x4*)ptr = w0; *(u32x4*)(ptr + 8) = w1;
    }
}

namespace pg8 {
#define PG8_LAS __attribute__((address_space(3)))
typedef short bf16x8 __attribute__((ext_vector_type(8)));
typedef float f32x4 __attribute__((ext_vector_type(4)));
constexpr int BM = 256, BK = 64, HALF = 128, HTB = HALF * BK * 2, STAGE_BYTES = 8 * HTB, NXCD = 8, WGM = 8;
__host__ __device__ __forceinline__ int lds_byte(int r, int c) { const int st = (r >> 4) * 2 + (c >> 5), rr = r & 15, cc = c & 31, ob = rr * 64 + cc * 2; return st * 1024 + (ob ^ (((ob >> 9) & 1) << 5)); }
__host__ __device__ __forceinline__ void stage_rc(int b, int& R, int& C) { const int st = b / 1024, sb = b % 1024, swz = sb ^ (((sb >> 9) & 1) << 5); R = (st >> 1) * 16 + swz / 64; C = (st & 1) * 32 + (swz % 64) / 2; }
__host__ __device__ __forceinline__ int perm32(int rho) { const int n = rho >> 4, i = rho & 15; return 8 * (i >> 2) + 4 * n + (i & 3); }
struct Unit { int pm, pn, e; };
struct Gemm { const bf16_t* A; const bf16_t* Bt; int K; size_t bstride; const int* rowtok; };
struct StaticOrder {
    int nM, nN, nwg, G, c;
    __device__ void init(int M_, int N_, int G_, int c_) { nM = M_ / BM; nN = N_ / BM; nwg = nM * nN; G = G_; c = c_; }
    __device__ bool next(int i, Unit& u) const {
        const long L = (long)i * G + c; if (L >= nwg) return false;
        int wgid = (int)L; { const int q = nwg / NXCD, r = nwg % NXCD, xcd = wgid % NXCD, off = wgid / NXCD; wgid = (xcd < r ? xcd * (q + 1) : r * (q + 1) + (xcd - r) * q) + off; }
        const int nig = WGM * nN, gid = wgid / nig, fm = gid * WGM, gsz = (nM - fm) < WGM ? (nM - fm) : WGM;
        u.pm = fm + ((wgid % nig) % gsz); u.pn = (wgid % nig) / gsz; u.e = 0; return true;
    }
};
struct MoeOrder {
    const PG8_LAS int* ps; int G, c;
    __device__ bool next(int i, Unit& u) const {
        const int L = i * G + c, mt = L >> 2, s0 = mt * 256;
        const int total = __builtin_amdgcn_readfirstlane(ps[32]);
        if (s0 >= total) return false;
        int e = 0;
#pragma unroll
        for (int q = 1; q < 32; ++q) e += (s0 >= ps[q]) ? 1 : 0;
        u.pm = mt; u.pn = L & 3; u.e = __builtin_amdgcn_readfirstlane(e); return true;
    }
};
__device__ __forceinline__ unsigned cvt_pk_bf16(float lo, float hi) { unsigned r; asm volatile("v_cvt_pk_bf16_f32 %0, %1, %2" : "=v"(r) : "v"(lo), "v"(hi)); return r; }

struct EpiInproj {
    static constexpr bool PERM = true;
    bf16_t* R1; bf16_t* MVO; bf16_t* AQKV;
    __device__ __forceinline__ void operator()(const f32x4 (&acc)[2][2][4][2], const Unit& u, int wr, int wc, int fr, int fq) const {
        bf16_t* base; int ldc, colt;
        if (u.pn < 4) { base = R1; ldc = 1024; colt = u.pn * 256; } else if (u.pn < 8) { base = MVO; ldc = 1024; colt = (u.pn - 4) * 256; } else { base = AQKV; ldc = 768; colt = (u.pn - 8) * 256; }
        const int row0 = u.pm * BM + wr * 64 + fr, col0 = colt + wc * 32 + 8 * fq;
#pragma unroll
        for (int ai = 0; ai < 2; ++ai)
#pragma unroll
            for (int m = 0; m < 4; ++m) { bf16_t* rowp = base + (size_t)(row0 + ai * HALF + m * 16) * ldc + col0;
#pragma unroll
                for (int bj = 0; bj < 2; ++bj) { const f32x4 v0 = acc[ai][bj][m][0], v1 = acc[ai][bj][m][1];
                    u32x4 w; w.x = cvt_pk_bf16(v0[0], v0[1]); w.y = cvt_pk_bf16(v0[2], v0[3]); w.z = cvt_pk_bf16(v1[0], v1[1]); w.w = cvt_pk_bf16(v1[2], v1[3]);
                    *(u32x4*)(rowp + bj * HALF) = w; } }
    }
};
struct EpiOutproj {
    static constexpr bool PERM = true;
    const bf16_t* xres; bf16_t* out;
    __device__ __forceinline__ void operator()(const f32x4 (&acc)[2][2][4][2], const Unit& u, int wr, int wc, int fr, int fq) const {
        const int row0 = u.pm * BM + wr * 64 + fr, col0 = u.pn * BM + wc * 32 + 8 * fq;
        u32x4 rb[2][4][2];
#pragma unroll
        for (int ai = 0; ai < 2; ++ai)
#pragma unroll
            for (int m = 0; m < 4; ++m) { const size_t off = (size_t)(row0 + ai * HALF + m * 16) * 1024 + col0;
#pragma unroll
                for (int bj = 0; bj < 2; ++bj) rb[ai][m][bj] = *(const u32x4*)(xres + off + bj * HALF); }
        asm volatile("" ::: "memory");
#pragma unroll
        for (int ai = 0; ai < 2; ++ai)
#pragma unroll
            for (int m = 0; m < 4; ++m) { const size_t off = (size_t)(row0 + ai * HALF + m * 16) * 1024 + col0;
#pragma unroll
                for (int bj = 0; bj < 2; ++bj) { const f32x4 v0 = acc[ai][bj][m][0], v1 = acc[ai][bj][m][1]; const u32x4 r = rb[ai][m][bj];
                    u32x4 w; w.x = cvt_pk_bf16(v0[0] + __uint_as_float(r.x << 16), v0[1] + __uint_as_float(r.x & 0xffff0000u)); w.y = cvt_pk_bf16(v0[2] + __uint_as_float(r.y << 16), v0[3] + __uint_as_float(r.y & 0xffff0000u));
                    w.z = cvt_pk_bf16(v1[0] + __uint_as_float(r.z << 16), v1[1] + __uint_as_float(r.z & 0xffff0000u)); w.w = cvt_pk_bf16(v1[2] + __uint_as_float(r.w << 16), v1[3] + __uint_as_float(r.w & 0xffff0000u));
                    *(u32x4*)(out + off + bj * HALF) = w; } }
    }
};
struct EpiMoe1 {
    static constexpr bool PERM = true;
    bf16_t* HID;
    __device__ __forceinline__ void operator()(const f32x4 (&acc)[2][2][4][2], const Unit& u, int wr, int wc, int fr, int fq) const {
        const int row0 = u.pm * BM + wr * 64 + fr, hc0 = (u.pn * BM + wc * 32 + 8 * fq) >> 1;
#pragma unroll
        for (int ai = 0; ai < 2; ++ai)
#pragma unroll
            for (int m = 0; m < 4; ++m) { bf16_t* rowp = HID + (size_t)(row0 + ai * HALF + m * 16) * 512 + hc0;
#pragma unroll
                for (int bj = 0; bj < 2; ++bj) { const f32x4 a = acc[ai][bj][m][0], b = acc[ai][bj][m][1];
                    u32x2 w; w.x = cvt_pk_bf16(silu_f(a[0]) * b[0], silu_f(a[1]) * b[1]); w.y = cvt_pk_bf16(silu_f(a[2]) * b[2], silu_f(a[3]) * b[3]);
                    *(u32x2*)(rowp + bj * 64) = w; } }
    }
};
struct EpiMoe2 {
    static constexpr bool PERM = true;
    bf16_t* Y; const int* slot_tok; const float* slot_w;
    __device__ __forceinline__ void operator()(const f32x4 (&acc)[2][2][4][2], const Unit& u, int wr, int wc, int fr, int fq) const {
        const int row0 = u.pm * BM + wr * 64 + fr, col0 = u.pn * BM + wc * 32 + 8 * fq;
        int aid[8]; float tw[8];
#pragma unroll
        for (int q = 0; q < 8; ++q) aid[q] = slot_tok[row0 + (q >> 2) * HALF + (q & 3) * 16];
#pragma unroll
        for (int q = 0; q < 8; ++q) tw[q] = slot_w[row0 + (q >> 2) * HALF + (q & 3) * 16];
#pragma unroll
        for (int ai = 0; ai < 2; ++ai)
#pragma unroll
            for (int m = 0; m < 4; ++m) { const int a = aid[ai * 4 + m];
                if (a >= 0) { const float t = tw[ai * 4 + m]; bf16_t* rowp = Y + (size_t)a * 1024 + col0;
#pragma unroll
                    for (int bj = 0; bj < 2; ++bj) { const f32x4 v0 = acc[ai][bj][m][0] * t, v1 = acc[ai][bj][m][1] * t;
                        u32x4 w; w.x = cvt_pk_bf16(v0[0], v0[1]); w.y = cvt_pk_bf16(v0[2], v0[3]); w.z = cvt_pk_bf16(v1[0], v1[1]); w.w = cvt_pk_bf16(v1[2], v1[3]);
                        *(u32x4*)(rowp + bj * HALF) = w; } } }
    }
};

template <class Epi, class Sched, bool GATHER>
__device__ __forceinline__ void gemm_phase(PG8_LAS unsigned char* lds, const Gemm g, const Sched& S, const Epi& E) {
    const int tid = ltid(), wid = __builtin_amdgcn_readfirstlane(tid >> 6), lane = tid & 63, wr = wid >> 2, wc = wid & 3, fr = lane & 15, fq = lane >> 4;
    const int K = g.K, nt = K / BK;
    unsigned voffA[2], voffB[2]; int RA[2]; unsigned CA2[2];
#pragma unroll
    for (int i = 0; i < 2; ++i) { int R, C; stage_rc(tid * 16 + i * 8192, R, C); const int Rb = Epi::PERM ? ((R & ~31) + perm32(R & 31)) : R;
        voffA[i] = (unsigned)(R * K + C) * 2u; voffB[i] = (unsigned)(Rb * K + C) * 2u; RA[i] = R; CA2[i] = (unsigned)C * 2u; }
    const size_t kstep = (size_t)(BK * 2);
    const size_t hstep = (size_t)HALF * K * 2;
    const size_t tstep = 2 * hstep;
    const unsigned ldsw = (unsigned)wid * 1024u;
    const int aoff = lds_byte(wr * 64 + fr, fq * 8), boff = lds_byte(wc * 32 + fr, fq * 8);
#define PG8_SA(b, h) (((b) * 2 + (h)) * HTB)
#define PG8_SB(b, h) ((4 + (b) * 2 + (h)) * HTB)
#define PG8_STAGE(bufoff, gbase, voff) do { _Pragma("unroll") for (int _i = 0; _i < 2; ++_i) \
        __builtin_amdgcn_global_load_lds((const unsigned*)((const char*)(gbase) + (voff)[_i]), (PG8_LAS unsigned*)(lds + (bufoff) + ldsw + _i * 8192), 16, 0, 0); } while (0)
#define PG8_STAGE_A(bufoff, ptr, h, V0, V1) do { if constexpr (GATHER) { if (h) PG8_STAGE(bufoff, ptr, V1); else PG8_STAGE(bufoff, ptr, V0); } else { PG8_STAGE(bufoff, (ptr) + (h) * hstep, voffA); } } while (0)
#define PG8_LDA(dst, b, h) do { _Pragma("unroll") for (int m = 0; m < 4; ++m) _Pragma("unroll") for (int k = 0; k < 2; ++k) dst[m][k] = *(const PG8_LAS bf16x8*)(lds + PG8_SA(b, h) + aoff + m * 2048 + k * 1024); } while (0)
#define PG8_LDB(dst, b, h) do { _Pragma("unroll") for (int n = 0; n < 2; ++n) _Pragma("unroll") for (int k = 0; k < 2; ++k) dst[n][k] = *(const PG8_LAS bf16x8*)(lds + PG8_SB(b, h) + boff + n * 2048 + k * 1024); } while (0)
#define PG8_MMA(ai, bj, At, Bt) do { __builtin_amdgcn_s_setprio(1); _Pragma("unroll") for (int m = 0; m < 4; ++m) _Pragma("unroll") for (int n = 0; n < 2; ++n) _Pragma("unroll") for (int k = 0; k < 2; ++k) \
        acc[ai][bj][m][n] = __builtin_amdgcn_mfma_f32_16x16x32_bf16(Bt[n][k], At[m][k], acc[ai][bj][m][n], 0, 0, 0); __builtin_amdgcn_s_setprio(0); } while (0)
#define PG8_WAIT_V(n) asm volatile("s_waitcnt vmcnt(" #n ")" ::: "memory")
#define PG8_WAIT_L(n) asm volatile("s_waitcnt lgkmcnt(" #n ")" ::: "memory")
#define PG8_BAR __builtin_amdgcn_s_barrier()
#define PG8_SCHED __builtin_amdgcn_sched_barrier(0)
#define PG8_GOFF(D0, D1, U) do { _Pragma("unroll") for (int _i = 0; _i < 2; ++_i) { const int _s = (U).pm * BM + RA[_i]; const int _a0 = g.rowtok[_s], _a1 = g.rowtok[_s + HALF]; \
        D0[_i] = (unsigned)((_a0 >= 0 ? (_a0 >> 1) : 0) * K) * 2u + CA2[_i]; D1[_i] = (unsigned)((_a1 >= 0 ? (_a1 >> 1) : 0) * K) * 2u + CA2[_i]; } } while (0)
    Unit cur, nxt; int ui = 0;
    if (!S.next(0, cur)) return;
    unsigned vc0[2] = {0u, 0u}, vc1[2] = {0u, 0u}, vn0[2] = {0u, 0u}, vn1[2] = {0u, 0u};
    if constexpr (GATHER) PG8_GOFF(vc0, vc1, cur);
    f32x4 acc[2][2][4][2];
#pragma unroll
    for (int a = 0; a < 2; ++a)
#pragma unroll
        for (int b = 0; b < 2; ++b)
#pragma unroll
            for (int m = 0; m < 4; ++m)
#pragma unroll
                for (int n = 0; n < 2; ++n) acc[a][b][m][n] = (f32x4){0.f, 0.f, 0.f, 0.f};
    bf16x8 At[4][2], B0[2][2], B1[2][2];
    const char* cA = GATHER ? (const char*)g.A : (const char*)g.A + (size_t)cur.pm * tstep;
    const char* cB = (const char*)g.Bt + (size_t)cur.e * g.bstride + (size_t)cur.pn * tstep;
    PG8_STAGE(PG8_SB(0, 0), cB, voffB); PG8_STAGE(PG8_SB(0, 1), cB + hstep, voffB); PG8_STAGE_A(PG8_SA(0, 0), cA, 0, vc0, vc1); PG8_STAGE_A(PG8_SA(0, 1), cA, 1, vc0, vc1);
    if (wr == 1) PG8_BAR;
    PG8_WAIT_V(2); PG8_BAR;
    PG8_STAGE(PG8_SB(1, 0), cB + kstep, voffB); PG8_STAGE_A(PG8_SA(1, 0), cA + kstep, 0, vc0, vc1); PG8_STAGE(PG8_SB(1, 1), cB + hstep + kstep, voffB);
    PG8_WAIT_V(6); PG8_BAR;
    for (;;) {
        const bool has_next = S.next(ui + 1, nxt);
        if constexpr (GATHER) { if (has_next) PG8_GOFF(vn0, vn1, nxt); else { vn0[0] = vc0[0]; vn0[1] = vc0[1]; vn1[0] = vc1[0]; vn1[1] = vc1[1]; } }
        const char* nA = GATHER ? (const char*)g.A : (has_next ? (const char*)g.A + (size_t)nxt.pm * tstep : cA);
        const char* nB = has_next ? (const char*)g.Bt + (size_t)nxt.e * g.bstride + (size_t)nxt.pn * tstep : cB;
        for (int t = 0; t < nt; t += 2) {
            const bool last = (t == nt - 2);
            const char* a1 = cA + (size_t)(t + 1) * kstep;
            const char* a2 = last ? nA : cA + (size_t)(t + 2) * kstep; const char* b2 = last ? nB : cB + (size_t)(t + 2) * kstep;
            const char* a3 = a2 + kstep; const char* b3 = b2 + kstep;
            unsigned w0[2], w1[2];
            w0[0] = vc0[0]; w0[1] = vc0[1]; w1[0] = vc1[0]; w1[1] = vc1[1];
            if constexpr (GATHER) { if (last) {
                asm volatile("" : "+v"(vn0[0]), "+v"(vn0[1]), "+v"(vn1[0]), "+v"(vn1[1]));
                w0[0] = vn0[0]; w0[1] = vn0[1]; w1[0] = vn1[0]; w1[1] = vn1[1]; } }
            PG8_LDB(B0, 0, 0); PG8_LDB(B1, 0, 1); PG8_SCHED; PG8_LDA(At, 0, 0); PG8_STAGE_A(PG8_SA(1, 1), a1, 1, vc0, vc1);
            PG8_WAIT_V(8); PG8_WAIT_L(0); PG8_BAR; PG8_MMA(0, 0, At, B0); PG8_MMA(0, 1, At, B1); PG8_BAR; PG8_SCHED;
            PG8_LDA(At, 0, 1); PG8_STAGE(PG8_SB(0, 0), b2, voffB); PG8_STAGE(PG8_SB(0, 1), b2 + hstep, voffB); PG8_STAGE_A(PG8_SA(0, 0), a2, 0, w0, w1);
            PG8_WAIT_V(8); PG8_WAIT_L(0); PG8_BAR; PG8_MMA(1, 0, At, B0); PG8_MMA(1, 1, At, B1); PG8_BAR; PG8_SCHED;
            PG8_LDB(B0, 1, 0); PG8_LDB(B1, 1, 1); PG8_SCHED; PG8_LDA(At, 1, 0); PG8_STAGE_A(PG8_SA(0, 1), a2, 1, w0, w1);
            PG8_WAIT_V(8); PG8_WAIT_L(0); PG8_BAR; PG8_MMA(0, 0, At, B0); PG8_MMA(0, 1, At, B1); PG8_BAR; PG8_SCHED;
            PG8_LDA(At, 1, 1); PG8_STAGE(PG8_SB(1, 0), b3, voffB); PG8_STAGE(PG8_SB(1, 1), b3 + hstep, voffB); PG8_STAGE_A(PG8_SA(1, 0), a3, 0, w0, w1);
            PG8_WAIT_V(8); PG8_WAIT_L(0); PG8_BAR; PG8_MMA(1, 0, At, B0); PG8_MMA(1, 1, At, B1); PG8_BAR; PG8_SCHED;
        }
        if (wr == 0) PG8_BAR;
        E(acc, cur, wr, wc, fr, fq);
        if (!has_next) break;
#pragma unroll
        for (int a = 0; a < 2; ++a)
#pragma unroll
            for (int b = 0; b < 2; ++b)
#pragma unroll
                for (int m = 0; m < 4; ++m)
#pragma unroll
                    for (int n = 0; n < 2; ++n) acc[a][b][m][n] = (f32x4){0.f, 0.f, 0.f, 0.f};
        cur = nxt; cA = nA; cB = nB; ++ui;
        if constexpr (GATHER) { vc0[0] = vn0[0]; vc0[1] = vn0[1]; vc1[0] = vn1[0]; vc1[1] = vn1[1]; }
        if (wr == 1) PG8_BAR;
    }
    PG8_WAIT_V(0);
    PG8_BAR;
#undef PG8_SA
#undef PG8_SB
#undef PG8_STAGE
#undef PG8_STAGE_A
#undef PG8_LDA
#undef PG8_LDB
#undef PG8_MMA
#undef PG8_WAIT_V
#undef PG8_WAIT_L
#undef PG8_BAR
#undef PG8_SCHED
#undef PG8_GOFF
}
}

template <int EPI> __device__ __forceinline__ void ph_gemm_mfma(const P& p, int l, unsigned char* smem) {
    PG8_LAS unsigned char* lds = (PG8_LAS unsigned char*)smem;
    const int G = gridDim.x, bx = blockIdx.x;
    if (EPI == EPI_INPROJ) {
        pg8::Gemm g{(const bf16_t*)(p.ws + WS_XN), (const bf16_t*)(p.ws + WS_WIN) + (size_t)l * NWIN * 1024, 1024, 0, nullptr};
        pg8::StaticOrder S; S.init(M, NWIN, G, bx);
        pg8::EpiInproj E{(bf16_t*)(p.ws + WS_R1), (bf16_t*)(p.ws + WS_MVO), (bf16_t*)(p.ws + WS_AQKV)};
        pg8::gemm_phase<pg8::EpiInproj, pg8::StaticOrder, false>(lds, g, S, E);
    } else if (EPI == EPI_OUTPROJ) {
        pg8::Gemm g{(const bf16_t*)(p.ws + WS_R1), (const bf16_t*)(p.ws + WS_WOUT) + (size_t)l * 1024 * 1024, 1024, 0, nullptr};
        pg8::StaticOrder S; S.init(M, 1024, G, bx);
        pg8::EpiOutproj E{(const bf16_t*)p.out, (bf16_t*)(p.ws + WS_XB)};
        pg8::gemm_phase<pg8::EpiOutproj, pg8::StaticOrder, false>(lds, g, S, E);
    } else {
        PG8_LAS int* ps = (PG8_LAS int*)(lds + LDS_MISC);
        if (ltid() == 0) { const unsigned* cnt = (const unsigned*)(p.ws + WS_CTL) + CW_CNT + l * 32; int acc = 0; for (int e = 0; e < 32; ++e) { ps[e] = acc; acc += ((int)cnt[e] + 255) & ~255; } ps[32] = acc; }
        __syncthreads();
        const int vcu = (G % 8 == 0) ? (bx % 8) * (G / 8) + bx / 8 : bx;
        pg8::MoeOrder S{ps, G, vcu};
        if (EPI == EPI_MOE1) {
            pg8::Gemm g{(const bf16_t*)(p.ws + WS_XN), (const bf16_t*)(p.ws + WS_W13), 1024, (size_t)1024 * 1024 * 2, (const int*)(p.ws + WS_SLOT)};
            pg8::EpiMoe1 E{(bf16_t*)(p.ws + WS_HID)};
            pg8::gemm_phase<pg8::EpiMoe1, pg8::MoeOrder, true>(lds, g, S, E);
        } else {
            pg8::Gemm g{(const bf16_t*)(p.ws + WS_HID), (const bf16_t*)(p.ws + WS_W2), 512, (size_t)1024 * 512 * 2, nullptr};
            pg8::EpiMoe2 E{(bf16_t*)(p.ws + WS_Y), (const int*)(p.ws + WS_SLOT), (const float*)(p.ws + WS_SLOTW)};
            pg8::gemm_phase<pg8::EpiMoe2, pg8::MoeOrder, false>(lds, g, S, E);
        }
    }
}


#define LAS __attribute__((address_space(3)))
constexpr int CW_BAR = 4096;
#define XB_TMO      128
#define XB_XCNT(j)  (256  + 64 * (j))
#define XB_XSUB(j)  (1280 + 64 * (j))
#define XB_XGEN(j)  (2304 + 64 * (j))
#define XB_TOP      3328
#define XB_TOPGEN   3392
#define XCD_BAR_WORDS 3456
#define XB_SPIN_CAP (1u << 18)

__device__ __forceinline__ unsigned xb_ld(unsigned* p)              { return __hip_atomic_load(p, __ATOMIC_RELAXED, __HIP_MEMORY_SCOPE_AGENT); }
__device__ __forceinline__ unsigned xb_add(unsigned* p, unsigned v) { return __hip_atomic_fetch_add(p, v, __ATOMIC_RELAXED, __HIP_MEMORY_SCOPE_AGENT); }
__device__ __forceinline__ unsigned xb_xcc_id() { return (unsigned)__builtin_amdgcn_s_getreg((3 << 11) | 20) & 0xFu; }
#define XB_SPIN(cond, bar) do { unsigned _sp = 0; while (cond) { __builtin_amdgcn_s_sleep(1); \
    if ((++_sp & 255u) == 0u) { if (xb_ld(&(bar)[XB_TMO])) break; if (_sp > XB_SPIN_CAP) { atomicAdd(&(bar)[XB_TMO], 1u); break; } } } } while (0)

struct XcdBarrier {
    unsigned* bar; unsigned x;
    volatile LAS unsigned* st;
};

__device__ __forceinline__ XcdBarrier xcd_barrier_post(unsigned* bar, volatile LAS unsigned* st) {
    XcdBarrier b; b.bar = bar; b.x = xb_xcc_id(); b.st = st;
    if (threadIdx.x == 0) (void)xb_add(&bar[XB_XCNT(b.x)], 1u);
    return b;
}
__device__ __forceinline__ void xcd_barrier_complete(unsigned* bar, unsigned x, unsigned& nloc, unsigned& nx) {
    const unsigned G = gridDim.x * gridDim.y * gridDim.z;
    unsigned sum, cnt, mine, sp = 0u;
    for (;;) {
        sum = 0u; cnt = 0u; mine = 0u;
#pragma unroll
        for (unsigned j = 0; j < 16; ++j) { const unsigned c = xb_ld(&bar[XB_XCNT(j)]); sum += c; cnt += (c > 0u) ? 1u : 0u; mine = (j == x) ? c : mine; }
        if (sum == G) break;
        __builtin_amdgcn_s_sleep(1);
        if ((++sp & 255u) == 0u) { if (xb_ld(&bar[XB_TMO])) break; if (sp > XB_SPIN_CAP) { atomicAdd(&bar[XB_TMO], 1u); break; } }
    }
    nloc = mine > 0u ? mine : 1u; nx = cnt > 0u ? cnt : 1u;
}

__device__ __forceinline__ void xcd_barrier(const XcdBarrier& b) {
    asm volatile("s_waitcnt vmcnt(0)" ::: "memory");
    __syncthreads();
    if (threadIdx.x == 0) {
        unsigned* bar = b.bar;
        __builtin_amdgcn_s_waitcnt(0);
        unsigned nloc = b.st[0], nx = b.st[1];
        if (nloc == 0u) { xcd_barrier_complete(bar, b.x, nloc, nx); b.st[0] = nloc; b.st[1] = nx; }
        const unsigned old = xb_add(&bar[XB_XSUB(b.x)], 1u);
        const unsigned gen = old / nloc;
        if (old + 1u == (gen + 1u) * nloc) {
            __builtin_amdgcn_fence(__ATOMIC_RELEASE, "agent");
            asm volatile("s_waitcnt vmcnt(0)" ::: "memory");
            const unsigned og = xb_add(&bar[XB_TOP], 1u);
            const unsigned tg = og / nx;
            if (og + 1u == (tg + 1u) * nx) xb_add(&bar[XB_TOPGEN], 1u);
            else XB_SPIN(xb_ld(&bar[XB_TOPGEN]) == tg, bar);
            __builtin_amdgcn_fence(__ATOMIC_ACQUIRE, "agent");
            xb_add(&bar[XB_XGEN(b.x)], 1u);
            asm volatile("s_waitcnt vmcnt(0)" ::: "memory");
        } else {
            XB_SPIN(xb_ld(&bar[XB_XGEN(b.x)]) == gen, bar);
            __builtin_amdgcn_fence(__ATOMIC_ACQUIRE, "agent");
            asm volatile("s_waitcnt vmcnt(0)" ::: "memory");
        }
    }
    __syncthreads();
}

namespace cg = cooperative_groups;
#ifndef REP_KIND
#define REP_KIND -1
#define REP_L 0
#define REP_N 0
#endif
#ifndef MFMA_MLSTM
#define MFMA_MLSTM 1
#endif
#ifndef MFMA_ATTN
#define MFMA_ATTN 1
#endif
#ifndef MFMA_INPROJ
#define MFMA_INPROJ 1
#endif
#ifndef MFMA_OUTPROJ
#define MFMA_OUTPROJ 1
#endif
#ifndef MFMA_MOE1
#define MFMA_MOE1 1
#endif
#ifndef MFMA_MOE2
#define MFMA_MOE2 1
#endif
constexpr int LDS_BYTES = 163840;
enum { PH_ROW1 = 0, PH_INPROJ, PH_PREP, PH_M2, PH_MIX, PH_OUTPROJ, PH_ROW2, PH_SCATTER, PH_MOE1, PH_MOE2, PH_ROW3 };
constexpr int NPL = 10, NPHASE = 2 * NPL + 1;
__device__ __forceinline__ void phase_decode(int ph, int& kind, int& l) {
    if (ph == NPHASE - 1) { kind = PH_ROW3; l = 0; } else { l = ph / NPL; kind = ph % NPL; }
}
struct Args { const float* in[19]; float* out; unsigned char* ws; int ph_lo, ph_hi; };
__global__ void __launch_bounds__(512) k_mega(Args a) {
    extern __shared__ __attribute__((aligned(16))) unsigned char smem[];
    cg::grid_group grid = cg::this_grid();
    volatile LAS unsigned* xst = (volatile LAS unsigned*)((LAS unsigned char*)smem + LDS_BYTES - 64);
    if (threadIdx.x < 2) xst[threadIdx.x] = 0u;
    if (threadIdx.x == 0) {
#pragma unroll
        for (int i = 0; i < 19; ++i) ((unsigned long long*)(smem + LDS_PTAB))[i] = (unsigned long long)a.in[i];
    }
    __syncthreads();
    if (blockIdx.x == 0) { unsigned* c = (unsigned*)(a.ws + WS_CTL);
#pragma unroll 4
        for (int i = threadIdx.x; i < 16384; i += 512) c[i] = 0u; }
    XcdBarrier xbar; xbar.bar = nullptr; xbar.x = 0u; xbar.st = xst;
    for (int ph = a.ph_lo; ph < a.ph_hi; ++ph) {
        int kind, l; phase_decode(ph, kind, l);
        int nrep = (kind == REP_KIND && l == REP_L) ? 1 + REP_N : 1;
        for (int rep = 0; rep < nrep; ++rep) {
        unsigned z; asm volatile("s_mov_b32 %0, 0" : "=s"(z));
        P p; p.out = a.out + z; p.ws = a.ws + z; p.tab = smem + LDS_PTAB;
        switch (kind) {
        case PH_ROW1:
            if (l == 0) {
                ph_prep_small(p); ph_router_image(p);
                for (int ll = 0; ll < 2; ++ll) { ph_transpose<0>(p, ll, smem); ph_transpose<1>(p, ll, smem); }
                __syncthreads();
                rowpass<1, false>(p, l, gridDim.x, blockIdx.x, smem);
            } else { rowpass<1, true>(p, l, gridDim.x, blockIdx.x, smem, rep + 1 == nrep); }
            break;
        case PH_INPROJ: ph_gemm_mfma<EPI_INPROJ>(p, l, smem); break;
        case PH_PREP: ph_prep(p, l, smem); break;
        case PH_M2: ml::ph_m2(p, l, smem); break;
        case PH_MIX: ml::ph_m3(p, l, smem); __syncthreads(); ph_attn_mfma(p, l, smem); break;
        case PH_OUTPROJ: ph_gemm_mfma<EPI_OUTPROJ>(p, l, smem); break;
        case PH_ROW2: ph_row2_mfma(p, l, smem, rep + 1 == nrep); break;
        case PH_SCATTER: ph_scatter(p, l, smem); break;
        case PH_MOE1: ph_gemm_mfma<EPI_MOE1>(p, l, smem); break;
        case PH_MOE2: ph_gemm_mfma<EPI_MOE2>(p, l, smem); break;
        case PH_ROW3: rowpass<3, true>(p, l, gridDim.x, blockIdx.x, smem, rep + 1 == nrep); break;
        }
        if (rep + 1 < nrep) __syncthreads();
        }
        if (ph + 1 < a.ph_hi) { if (ph == a.ph_lo) { grid.sync(); xbar = xcd_barrier_post((unsigned*)(a.ws + WS_CTL) + CW_BAR, xst); } else xcd_barrier(xbar); }
    }
}

extern "C" void kernel_launch(void* const* d_in, const int* in_sizes, int n_in, void* d_out, int out_size, void* d_ws, size_t ws_size, hipStream_t stream) {
    static int grid = 0;
    if (grid == 0) {
        if (n_in != 19 || ws_size < WS_END) { fprintf(stderr, "kernel_launch: unexpected n_in %d / ws_size %zu\n", n_in, ws_size); grid = -1; return; }
        int dev = 0, cus = 0, per_cu = 0;
        (void)hipGetDevice(&dev); (void)hipDeviceGetAttribute(&cus, hipDeviceAttributeMultiprocessorCount, dev);
        if (hipFuncSetAttribute((const void*)k_mega, hipFuncAttributeMaxDynamicSharedMemorySize, LDS_BYTES) != hipSuccess) { fprintf(stderr, "kernel_launch: hipFuncSetAttribute failed\n"); grid = -1; return; }
        if (hipOccupancyMaxActiveBlocksPerMultiprocessor(&per_cu, (const void*)k_mega, 512, LDS_BYTES) != hipSuccess || per_cu < 1) { fprintf(stderr, "kernel_launch: occupancy query failed (%d)\n", per_cu); grid = -1; return; }
        grid = cus * per_cu;
        fprintf(stderr, "kernel_launch: cus %d per_cu %d grid %d ws %zu\n", cus, per_cu, grid, ws_size);
    }
    if (grid < 0) return;
    Args a{};
    for (int i = 0; i < 19; ++i) a.in[i] = (const float*)d_in[i];
    a.out = (float*)d_out; a.ws = (unsigned char*)d_ws;
    a.ph_lo = 0; a.ph_hi = NPHASE;
    void* args[] = {&a};
    hipError_t e = hipLaunchCooperativeKernel((const void*)k_mega, dim3(grid), dim3(512), args, LDS_BYTES, stream);
    if (e != hipSuccess) fprintf(stderr, "kernel_launch: cooperative launch failed: %s (grid %d)\n", hipGetErrorString(e), grid);
}
```

```cpp
#include <hip/hip_runtime.h>
#include <hip/hip_cooperative_groups.h>
#include <cstdint>
#include <cstdio>

typedef unsigned short bf16_t;
typedef unsigned u32x4 __attribute__((ext_vector_type(4)));
typedef unsigned u32x2 __attribute__((ext_vector_type(2)));

constexpr int NB = 4, SEQ = 8192, M = NB * SEQ, D = 1024;
constexpr int NWIN = 2816;
constexpr int PIN_ = 2832;
constexpr int NSLOT = 2 * M + 32 * 256;
constexpr float EPS = 1e-6f;
constexpr float QSCALE = 0.125f * 1.4426950408889634f;

constexpr size_t MiB = 1u << 20;
constexpr size_t WS_CTL = 0;
constexpr size_t WS_WIN = 1 * MiB;
constexpr size_t WS_WOUT = 12 * MiB;
constexpr size_t WS_ROPE = 17 * MiB;
constexpr size_t WS_GATES = 18 * MiB;
constexpr size_t WS_TOPE = 20 * MiB;
constexpr size_t WS_TOPW = 20 * MiB + 256 * 1024;
constexpr size_t WS_SLOT = 20 * MiB + 512 * 1024;
constexpr size_t WS_SLOTW = 21 * MiB;
constexpr size_t WS_W13 = 22 * MiB;
constexpr size_t WS_W2 = 86 * MiB;
constexpr size_t WS_XN = 118 * MiB;
constexpr size_t WS_R1 = 182 * MiB;
constexpr size_t WS_QKC = 246 * MiB;
constexpr size_t WS_MVO = 310 * MiB;
constexpr size_t WS_AQKV = 374 * MiB;
constexpr size_t WS_CST = 422 * MiB;
constexpr size_t WS_HID = 246 * MiB;
constexpr size_t WS_Y = 318 * MiB;
constexpr size_t WS_XB = 446 * MiB;
constexpr size_t WS_RIMG = 510 * MiB;
constexpr size_t WS_END = 511 * MiB;
constexpr int CW_CNT = 1024;
constexpr int CW_FILL = 1024 + 64;

struct P {
    float* out;
    unsigned char* ws;
    const unsigned char* tab;
};
__device__ __forceinline__ const float* pin(const P& p, int k) {
    const u32x2 v = *(const u32x2*)(p.tab + 8 * k);
    const unsigned lo = (unsigned)__builtin_amdgcn_readfirstlane((int)v.x), hi = (unsigned)__builtin_amdgcn_readfirstlane((int)v.y);
    return (const float*)(((unsigned long long)hi << 32) | lo);
}

typedef float f4g_t __attribute__((ext_vector_type(4)));
__device__ __forceinline__ float4 gld4(const float* p) { const f4g_t t = *(const __attribute__((address_space(1))) f4g_t*)p; return float4{t[0], t[1], t[2], t[3]}; }
__device__ __forceinline__ float gld1(const float* p) { return *(const __attribute__((address_space(1))) float*)p; }

__device__ __forceinline__ int ltid() { int t = threadIdx.x; asm volatile("" : "+v"(t)); return t; }
__device__ __forceinline__ float bf2f(unsigned v) { return __uint_as_float(v << 16); }
__device__ __forceinline__ unsigned f2bf(float f) { unsigned u = __float_as_uint(f); return (u + 0x7fffu + ((u >> 16) & 1u)) >> 16; }
typedef float pk_f32x2 __attribute__((ext_vector_type(2))); typedef __bf16 pk_bf16x2 __attribute__((ext_vector_type(2)));
__device__ __forceinline__ unsigned pk2(float lo, float hi) { const pk_f32x2 v = {lo, hi}; return __builtin_bit_cast(unsigned, __builtin_convertvector(v, pk_bf16x2)); }
template <int MASK> __device__ __forceinline__ float shx(float x) {
    if constexpr (MASK == 32) { const auto rr = __builtin_amdgcn_permlane32_swap(__float_as_uint(x), __float_as_uint(x), false, false);
        const unsigned a = rr[0], b = rr[1]; return __uint_as_float(a ^ b ^ __float_as_uint(x)); }
    else if constexpr (MASK == 1) return __uint_as_float((unsigned)__builtin_amdgcn_mov_dpp((int)__float_as_uint(x), 0xB1, 0xF, 0xF, true));
    else if constexpr (MASK == 2) return __uint_as_float((unsigned)__builtin_amdgcn_mov_dpp((int)__float_as_uint(x), 0x4E, 0xF, 0xF, true));
    else return __uint_as_float((unsigned)__builtin_amdgcn_ds_swizzle((int)__float_as_uint(x), (MASK << 10) | 0x1f));
}
__device__ __forceinline__ float wave_sum(float v) {
    v += shx<1>(v); v += shx<2>(v); v += shx<4>(v); v += shx<8>(v); v += shx<16>(v); v += shx<32>(v);
    return v;
}
__device__ __forceinline__ float lane_bcast(float v, int srclane  ) { return __uint_as_float((unsigned)__builtin_amdgcn_readlane((int)__float_as_uint(v), srclane)); }
__device__ __forceinline__ float silu_f(float x) { return x * __builtin_amdgcn_rcpf(1.f + __expf(-x)); }
__device__ __forceinline__ float sigmoid_f(float x) { return __builtin_amdgcn_rcpf(1.f + __expf(-x)); }
__device__ __forceinline__ float logsigmoid_f(float x) { const float y = __expf(-fabsf(x));
    const float l1p = (y < 0.0625f) ? y * (1.f - y * (0.5f - y * (0.33333334f - 0.25f * y))) : __logf(1.f + y); return fminf(x, 0.f) - l1p; }
__device__ __forceinline__ void unpack8(u32x4 w, float* f) {
    f[0] = bf2f(w.x & 0xffffu); f[1] = bf2f(w.x >> 16); f[2] = bf2f(w.y & 0xffffu); f[3] = bf2f(w.y >> 16);
    f[4] = bf2f(w.z & 0xffffu); f[5] = bf2f(w.z >> 16); f[6] = bf2f(w.w & 0xffffu); f[7] = bf2f(w.w >> 16);
}

__device__ __forceinline__ void ph_prep_small(const P& p) {
    float* rope = (float*)(p.ws + WS_ROPE);
    const int gt = blockIdx.x * 512 + ltid();
    if (gt < 2048) {
        const double C1[16] = {0.54030230586813977, 0.84600910641876459, 0.95041528091621519, 0.98423023475537852, 0.99500416512926237, 0.99841927779381845, 0.99950004171911222, 0.99984189027985781, 0.99995000041890036, 0.99998418865337735, 0.99999500000426333, 0.99999841886154905, 0.99999949999999416, 0.99999984188613433, 0.99999995000000319, 0.99999998418861191};
        const double S1[16] = {0.8414709848078965, 0.53316844604357783, 0.31098359088696603, 0.17689218465882672, 0.099833418129499904, 0.056204499194192764, 0.031617504700607077, 0.017781857090886144, 0.0099998331106604232, 0.0056233836119069999, 0.0031622723591389961, 0.0017782784939288374, 0.00099999988083076933, 0.00056234127206397698, 0.00031622775186866914, 0.00017782793926880789};
        double c1 = 0.0, s1 = 0.0;
        const int fq = gt & 15, pos = gt >> 4;
#pragma unroll
        for (int f = 0; f < 16; ++f) { c1 = (fq == f) ? C1[f] : c1; s1 = (fq == f) ? S1[f] : s1; }
        double c = 1.0, sn = 0.0;
#pragma unroll
        for (int bit = 0; bit < 7; ++bit) {
            if ((pos >> bit) & 1) { const double cn = c * c1 - sn * s1; sn = sn * c1 + c * s1; c = cn; }
            const double c2 = c1 * c1 - s1 * s1; s1 = 2.0 * c1 * s1; c1 = c2; }
        rope[2 * gt] = (float)c; rope[2 * gt + 1] = (float)sn;
    }
}

constexpr int RIMG_PART = (2 * 32 * 64 + 32 * 16) * 8;
__device__ __forceinline__ void ph_router_image(const P& p) {
    bf16_t* img = (bf16_t*)(p.ws + WS_RIMG);
    for (int idx = blockIdx.x * 512 + ltid(); idx < 2 * 36 * 1024; idx += gridDim.x * 512) {
        const int l = idx / 36864, r = idx % 36864, k = r / 36, col = r % 36;
        const float w = pin(p, 10)[l * 1024 + k] * (col < 32 ? pin(p, 13)[(size_t)l * 32768 + k * 32 + col] : pin(p, 11)[l * 4096 + k * 4 + (col - 32)]);
        const unsigned h = f2bf(w); const unsigned lo = f2bf(w - bf2f(h));
        const int ks = k >> 5, kq = (k >> 3) & 3, j = k & 7;
        const int off = (col < 32) ? (((col >> 4) * 32 + ks) * 64 + kq * 16 + (col & 15)) * 8 + j : 32768 + ((ks * 4 + kq) * 4 + (col - 32)) * 8 + j;
        bf16_t* base = img + (size_t)l * 2 * RIMG_PART;
        base[off] = (bf16_t)h; base[RIMG_PART + off] = (bf16_t)lo;
    }
}

template <int MODE> __device__ __forceinline__ int transpose_nitems() { return MODE == 0 ? 16 * 44 : MODE == 1 ? 16 * 16 : MODE == 2 ? 32 * 16 * 16 : 32 * 8 * 16; }
template <int MODE> __device__ __forceinline__ void transpose_load(const P& p, int l, int item, float4 (&v)[2]) {
    constexpr int K = (MODE == 3) ? 512 : 1024, NT = (MODE == 0) ? 44 : 16, KT = K / 64;
    const int tid = ltid();
    const int e = item / (KT * NT), r = item % (KT * NT), kt = r / NT, nt = r % NT, k0 = kt * 64, n0 = nt * 64;
#pragma unroll
    for (int i = 0; i < 2; ++i) {
        const int idx = tid + 512 * i, kk = idx >> 4, j = idx & 15;
        const float* src;
        if (MODE == 0) { const int sc = (n0 < 2048 ? n0 : n0 + 16) + 4 * j; src = pin(p, 2) + ((size_t)l * 1024 + k0 + kk) * PIN_ + sc; }
        else if (MODE == 1) { src = pin(p, 9) + ((size_t)l * 1024 + k0 + kk) * 1024 + n0 + 4 * j; }
        else if (MODE == 2) { const int g = (n0 >> 3) + (j >> 1); const float* base = (j & 1) ? pin(p, 16) : pin(p, 15);
            src = base + (((size_t)l * 32 + e) * 1024 + k0 + kk) * 512 + 4 * g; }
        else { src = pin(p, 17) + (((size_t)l * 32 + e) * 512 + k0 + kk) * 1024 + n0 + 4 * j; }
        v[i] = gld4(src);
    }
}
template <int MODE> __device__ __forceinline__ void transpose_to_lds(const float4 (&v)[2], float* tile) {
    const int tid = ltid();
#pragma unroll
    for (int i = 0; i < 2; ++i) {
        const int idx = tid + 512 * i, kk = idx >> 4, j = idx & 15;
        const int dcol = (MODE == 2) ? 8 * (j >> 1) + 4 * (j & 1) : 4 * j;
        float* t = tile + kk * 65 + dcol; t[0] = v[i].x; t[1] = v[i].y; t[2] = v[i].z; t[3] = v[i].w;
    }
}
template <int MODE> __device__ __forceinline__ void transpose_from_lds(const P& p, int l, int item, const float* tile) {
    constexpr int K = (MODE == 3) ? 512 : 1024, NT = (MODE == 0) ? 44 : 16, KT = K / 64;
    const int tid = ltid();
    const int e = item / (KT * NT), r = item % (KT * NT), kt = r / NT, nt = r % NT, k0 = kt * 64, n0 = nt * 64;
    const int n = tid >> 3, c = tid & 7; const float* s = tile + (8 * c) * 65 + n;
    u32x4 o; o.x = pk2(s[0], s[65]); o.y = pk2(s[2 * 65], s[3 * 65]); o.z = pk2(s[4 * 65], s[5 * 65]); o.w = pk2(s[6 * 65], s[7 * 65]);
    bf16_t* dst;
    if (MODE == 0) dst = (bf16_t*)(p.ws + WS_WIN) + (size_t)l * NWIN * 1024;
    else if (MODE == 1) dst = (bf16_t*)(p.ws + WS_WOUT) + (size_t)l * 1024 * 1024;
    else if (MODE == 2) dst = (bf16_t*)(p.ws + WS_W13) + (size_t)e * 1024 * 1024;
    else dst = (bf16_t*)(p.ws + WS_W2) + (size_t)e * 1024 * 512;
    *(u32x4*)(dst + (size_t)(n0 + n) * K + k0 + 8 * c) = o;
}
template <int MODE> __device__ __forceinline__ void ph_transpose(const P& p, int l, unsigned char* smem, int it0 = 0, int it1 = -1, int vb = -1, int vg = 0) {
    float* tile0 = (float*)smem; float* tile1 = tile0 + 64 * 65 + 32;
    const int n = (it1 < 0) ? transpose_nitems<MODE>() : it1, G = (vb < 0) ? (int)gridDim.x : vg;
    int it = it0 + ((vb < 0) ? (int)blockIdx.x : vb);
    float4 na[2], nb[2];
    if (it < n) transpose_load<MODE>(p, l, it, na);
    if (it + G < n) transpose_load<MODE>(p, l, it + G, nb);
    for (; it < n; it += 2 * G) {
        const bool hb = it + G < n;
        float4 ca[2], cb[2]; ca[0] = na[0]; ca[1] = na[1]; cb[0] = nb[0]; cb[1] = nb[1];
        if (it + 2 * G < n) transpose_load<MODE>(p, l, it + 2 * G, na);
        if (it + 3 * G < n) transpose_load<MODE>(p, l, it + 3 * G, nb);
        transpose_to_lds<MODE>(ca, tile0); if (hb) transpose_to_lds<MODE>(cb, tile1);
        __syncthreads();
        transpose_from_lds<MODE>(p, l, it, tile0); if (hb) transpose_from_lds<MODE>(p, l, it + G, tile1);
        __syncthreads();
    }
}

constexpr int BG_HALF2 = 2 * 8192, BG_TOTAL = BG_HALF2 + 2 * 4096;
struct BgJob { int next, stride; };
__device__ __forceinline__ void bg_decode(int hid, bool& m2, int& e, int& k0, int& n0) {
    m2 = hid < BG_HALF2; const int item = (m2 ? hid : hid - BG_HALF2) >> 1, half = hid & 1;
    const int sh = m2 ? 8 : 7;
    e = item >> sh; const int r = item & ((1 << sh) - 1), kt = r >> 4, nt = r & 15; k0 = kt * 64 + 32 * half; n0 = nt * 64;
}
__device__ __forceinline__ void bg_glds16(const void* gsrc, unsigned lds_dst) { unsigned keep;
    asm volatile("s_mov_b32 %0, m0\n\ts_mov_b32 m0, %2\n\ts_nop 0\n\tglobal_load_lds_dwordx4 %1, off\n\ts_mov_b32 m0, %0" : "=&s"(keep) : "v"(gsrc), "s"(lds_dst) : "memory"); }
__device__ __forceinline__ void bg_dma(const P& p, int l, int hid, unsigned tile_lds) {
    const int lane = ltid() & 63; bool m2; int e, k0, n0; bg_decode(hid, m2, e, k0, n0);
    const int kk = lane >> 4, j = lane & 15;
    const float* w1 = pin(p, 15); const float* w3 = pin(p, 16); const float* w2 = pin(p, 17);
    const float* src = m2 ? ((j & 1) ? w3 : w1) + (((size_t)l * 32 + e) * 1024 + k0 + kk) * 512 + 4 * ((n0 >> 3) + (j >> 1))
                          : w2 + (((size_t)l * 32 + e) * 512 + k0 + kk) * 1024 + n0 + 4 * j;
    const size_t step = m2 ? 4 * 512 : 4 * 1024;
#pragma unroll
    for (int i = 0; i < 8; ++i) bg_glds16(src + (size_t)i * step, (unsigned)__builtin_amdgcn_readfirstlane(tile_lds + i * 1024));
}
__device__ __forceinline__ void bg_finish(const P& p, int hid, const float* tile  ) {
    const int lane = ltid() & 63; bool m2; int e, k0, n0; bg_decode(hid, m2, e, k0, n0);
    const int ng = lane & 15, kg = lane >> 4;
    float4 tv[8];
#pragma unroll
    for (int i = 0; i < 8; ++i) tv[i] = *(const float4*)(tile + (8 * kg + i) * 64 + 4 * ng);
    bf16_t* dst = m2 ? (bf16_t*)(p.ws + WS_W13) + (size_t)e * 1024 * 1024 + (size_t)(n0 + 4 * ng) * 1024 + k0 + 8 * kg : (bf16_t*)(p.ws + WS_W2) + (size_t)e * 1024 * 512 + (size_t)(n0 + 4 * ng) * 512 + k0 + 8 * kg;
    const int K = m2 ? 1024 : 512;
    { u32x4 o; o.x = pk2(tv[0].x, tv[1].x); o.y = pk2(tv[2].x, tv[3].x); o.z = pk2(tv[4].x, tv[5].x); o.w = pk2(tv[6].x, tv[7].x); *(u32x4*)(dst) = o; }
    { u32x4 o; o.x = pk2(tv[0].y, tv[1].y); o.y = pk2(tv[2].y, tv[3].y); o.z = pk2(tv[4].y, tv[5].y); o.w = pk2(tv[6].y, tv[7].y); *(u32x4*)(dst + K) = o; }
    { u32x4 o; o.x = pk2(tv[0].z, tv[1].z); o.y = pk2(tv[2].z, tv[3].z); o.z = pk2(tv[4].z, tv[5].z); o.w = pk2(tv[6].z, tv[7].z); *(u32x4*)(dst + 2 * K) = o; }
    { u32x4 o; o.x = pk2(tv[0].w, tv[1].w); o.y = pk2(tv[2].w, tv[3].w); o.z = pk2(tv[4].w, tv[5].w); o.w = pk2(tv[6].w, tv[7].w); *(u32x4*)(dst + 3 * K) = o; }
    asm volatile("s_waitcnt lgkmcnt(0)" ::: "memory");
}

constexpr int LDS_RING = 131072;
constexpr int LDS_MISC = LDS_RING;
constexpr int LDS_LCNT = 148480;
constexpr int LDS_BIAS = 148032;
constexpr int WROW = 1028;
constexpr int LDS_PTAB = 163840 - 512;
__device__ __forceinline__ float dot4(const float4 a, const float4 b) { return (a.x * b.x + a.y * b.y) + (a.z * b.z + a.w * b.w); }
__device__ __forceinline__ void dot4acc(pk_f32x2& acc, const float4 a, const float4 b) {
    acc = __builtin_elementwise_fma((pk_f32x2){a.x, a.y}, (pk_f32x2){b.x, b.y}, acc); acc = __builtin_elementwise_fma((pk_f32x2){a.z, a.w}, (pk_f32x2){b.z, b.w}, acc); }
template <int NH, int MASK, int N> __device__ __forceinline__ void tree_step(float (&v)[N], int lane) {
    const bool up = (lane & MASK) != 0;
#pragma unroll
    for (int i = 0; i < NH; ++i) { const float send = up ? v[i] : v[i + NH], keep = up ? v[i + NH] : v[i]; v[i] = keep + shx<MASK>(send); }
}
template <int N> __device__ __forceinline__ float tree_reduce(float (&v)[N], int lane) {
    static_assert(N == 4 || N == 8 || N == 16, "tree_reduce: N");
    if constexpr (N == 16) { tree_step<8, 32>(v, lane); tree_step<4, 16>(v, lane); tree_step<2, 8>(v, lane); tree_step<1, 4>(v, lane); float r = v[0]; r += shx<2>(r); r += shx<1>(r); return r; }
    else if constexpr (N == 8) { tree_step<4, 32>(v, lane); tree_step<2, 16>(v, lane); tree_step<1, 8>(v, lane); float r = v[0]; r += shx<4>(r); r += shx<2>(r); r += shx<1>(r); return r; }
    else { tree_step<2, 32>(v, lane); tree_step<1, 16>(v, lane); float r = v[0]; r += shx<8>(r); r += shx<4>(r); r += shx<2>(r); r += shx<1>(r); return r; }
}
template <int MODE, bool COMB> __device__ __forceinline__ void rowpass(const P& p, int l, int nblk, int bid, unsigned char* smem, bool real = true) {
    float* const outp = real ? p.out : (float*)(p.ws + WS_R1);
    constexpr bool XBF = !(MODE == 1 && !COMB);
    const int tid = ltid(), lane = tid & 63, wave = tid >> 6;
    const int gw = bid * 8 + wave, NGW = nblk * 8;
    float* W = (float*)smem; unsigned* lcnt = (unsigned*)(smem + LDS_LCNT);
    if (MODE == 1) { const float* src = pin(p, 2) + (size_t)l * 1024 * PIN_ + 2048;
        float4 gw[8];
#pragma unroll
        for (int q = 0; q < 8; ++q) { const int t = tid + 512 * q; gw[q] = gld4(src + (size_t)(t >> 2) * PIN_ + (t & 3) * 4); }
#pragma unroll
        for (int q = 0; q < 8; ++q) { const int t = tid + 512 * q, k = t >> 2, c4 = (t & 3) * 4; W[(c4 + 0) * WROW + k] = gw[q].x; W[(c4 + 1) * WROW + k] = gw[q].y; W[(c4 + 2) * WROW + k] = gw[q].z; W[(c4 + 3) * WROW + k] = gw[q].w; } }
    if (MODE == 2) { const float* sg = pin(p, 11) + (size_t)l * 4096; const float* se = pin(p, 13) + (size_t)l * 32768;
#pragma unroll 8
        for (int i = tid; i < 4096; i += 512) W[(i & 3) * WROW + (i >> 2)] = sg[i];
#pragma unroll 16
        for (int i = tid; i < 32768; i += 512) W[(4 + (i & 31)) * WROW + (i >> 5)] = se[i];
        if (tid < 32) lcnt[tid] = 0u;
        if (tid < 4) ((float*)(smem + LDS_BIAS))[tid] = pin(p, 12)[l * 4 + tid];
        if (tid >= 64 && tid < 96) ((float*)(smem + LDS_BIAS))[4 + tid - 64] = pin(p, 14)[l * 32 + tid - 64]; }
    if (MODE == 1) { if (tid < 16) ((float*)(smem + LDS_BIAS))[tid] = pin(p, 5)[l * 16 + tid]; }
    const float* biasl = (const float*)(smem + LDS_BIAS);
    if (MODE != 3) __syncthreads();
    const float* gain = (MODE == 1) ? pin(p, 1) + l * 1024 : (MODE == 2) ? pin(p, 10) + l * 1024 : pin(p, 18);
    float4 g4[4];
#pragma unroll
    for (int j = 0; j < 4; ++j) g4[j] = ((const float4*)gain)[lane + 64 * j];
    bf16_t* XN = (bf16_t*)(p.ws + WS_XN);
    const bf16_t* Y = (const bf16_t*)(p.ws + WS_Y);
    const float* xbase = pin(p, 0); const bf16_t* xbb = (const bf16_t*)(p.ws + WS_XB);
    constexpr int R = 2;
    float4 nv[R][4]; u32x2 nx[R][4], na[R][4], nb[R][4];
#define ROW_LOAD(r, mm) do { _Pragma("unroll") for (int j = 0; j < 4; ++j) { if (XBF) nx[r][j] = ((const u32x2*)(xbb + (size_t)(mm) * 1024))[lane + 64 * j]; else nv[r][j] = gld4(xbase + (size_t)(mm) * 1024 + 4 * (lane + 64 * j)); \
        if (COMB) { na[r][j] = ((const u32x2*)(Y + (size_t)(2 * (mm)) * 1024))[lane + 64 * j]; nb[r][j] = ((const u32x2*)(Y + (size_t)(2 * (mm) + 1) * 1024))[lane + 64 * j]; } } } while (0)
#pragma unroll
    for (int r = 0; r < R; ++r) if (gw + r * NGW < M) ROW_LOAD(r, gw + r * NGW);
    for (int m0 = gw; m0 < M; m0 += R * NGW) {
        float4 v[R][4]; int mr[R]; bool ok[R];
#pragma unroll
        for (int r = 0; r < R; ++r) { mr[r] = m0 + r * NGW; ok[r] = mr[r] < M;
#pragma unroll
            for (int j = 0; j < 4; ++j) { if (XBF) { v[r][j].x = bf2f(nx[r][j].x & 0xffffu); v[r][j].y = bf2f(nx[r][j].x >> 16); v[r][j].z = bf2f(nx[r][j].y & 0xffffu); v[r][j].w = bf2f(nx[r][j].y >> 16); } else v[r][j] = nv[r][j];
                if (COMB) { v[r][j].x += bf2f(na[r][j].x & 0xffffu) + bf2f(nb[r][j].x & 0xffffu); v[r][j].y += bf2f(na[r][j].x >> 16) + bf2f(nb[r][j].x >> 16);
                            v[r][j].z += bf2f(na[r][j].y & 0xffffu) + bf2f(nb[r][j].y & 0xffffu); v[r][j].w += bf2f(na[r][j].y >> 16) + bf2f(nb[r][j].y >> 16); } } }
#pragma unroll
        for (int r = 0; r < R; ++r) if (m0 + (R + r) * NGW < M) ROW_LOAD(r, m0 + (R + r) * NGW);
        if (MODE == 1) {
#pragma unroll
            for (int r = 0; r < R; ++r) if (ok[r]) {
#pragma unroll
                for (int j = 0; j < 4; ++j) { u32x2 o; o.x = pk2(v[r][j].x, v[r][j].y); o.y = pk2(v[r][j].z, v[r][j].w); ((u32x2*)((bf16_t*)outp + (size_t)mr[r] * 1024))[lane + 64 * j] = o; } }
        }
        float ss[R];
#pragma unroll
        for (int r = 0; r < R; ++r) { ss[r] = 0.f;
#pragma unroll
            for (int j = 0; j < 4; ++j) ss[r] += dot4(v[r][j], v[r][j]); }
#pragma unroll
        for (int r = 0; r < R; ++r) ss[r] = wave_sum(ss[r]);
#pragma unroll
        for (int r = 0; r < R; ++r) { const float rn = 1.0f / sqrtf(ss[r] * (1.0f / 1024.0f) + EPS);
#pragma unroll
            for (int j = 0; j < 4; ++j) { v[r][j].x *= rn * g4[j].x; v[r][j].y *= rn * g4[j].y; v[r][j].z *= rn * g4[j].z; v[r][j].w *= rn * g4[j].w; } }
        if (MODE == 3) {
#pragma unroll
            for (int r = 0; r < R; ++r) if (ok[r]) {
#pragma unroll
                for (int j = 0; j < 4; ++j) ((float4*)(outp + (size_t)mr[r] * 1024))[lane + 64 * j] = v[r][j]; }
            continue;
        }
#pragma unroll
        for (int r = 0; r < R; ++r) if (ok[r]) {
#pragma unroll
            for (int j = 0; j < 4; ++j) { u32x2 o; o.x = pk2(v[r][j].x, v[r][j].y); o.y = pk2(v[r][j].z, v[r][j].w); ((u32x2*)(XN + (size_t)mr[r] * 1024))[lane + 64 * j] = o; } }
        if (MODE == 1) {
            float acc[R][16];
#pragma unroll
            for (int g = 0; g < 16; ++g) { pk_f32x2 s0 = {0.f, 0.f}, s1 = {0.f, 0.f};
#pragma unroll
                for (int j = 0; j < 4; ++j) { const float4 w = ((const float4*)(W + g * WROW))[lane + 64 * j]; dot4acc(s0, v[0][j], w); dot4acc(s1, v[1][j], w); }
                acc[0][g] = s0.x + s0.y; acc[1][g] = s1.x + s1.y; if ((g & 3) == 3) asm volatile("" ::: "memory"); }
            float val[R];
#pragma unroll
            for (int r = 0; r < R; ++r) val[r] = tree_reduce<16>(acc[r], lane);
            if ((lane & 3) == 0) { const int o = ((lane >> 5) & 1) * 8 + ((lane >> 4) & 1) * 4 + ((lane >> 3) & 1) * 2 + ((lane >> 2) & 1); const float gb = biasl[o];
#pragma unroll
                for (int r = 0; r < R; ++r) if (ok[r]) { float pre = val[r] + gb; if ((o >> 2) & 1) pre = logsigmoid_f(pre); ((float*)(p.ws + WS_GATES))[(size_t)mr[r] * 16 + o] = pre; } }
        } else {
            float ga[R][4];
#pragma unroll
            for (int g = 0; g < 4; ++g) { pk_f32x2 s0 = {0.f, 0.f}, s1 = {0.f, 0.f};
#pragma unroll
                for (int j = 0; j < 4; ++j) { const float4 w = ((const float4*)(W + g * WROW))[lane + 64 * j]; dot4acc(s0, v[0][j], w); dot4acc(s1, v[1][j], w); }
                ga[0][g] = s0.x + s0.y; ga[1][g] = s1.x + s1.y; }
            float gv[R];
#pragma unroll
            for (int r = 0; r < R; ++r) gv[r] = tree_reduce<4>(ga[r], lane);
            const float* bg = biasl; const float* be = biasl + 4;
            int gi[R]; float gval[R];
#pragma unroll
            for (int r = 0; r < R; ++r) { float gl[4];
#pragma unroll
                for (int g = 0; g < 4; ++g) gl[g] = lane_bcast(gv[r], 16 * g) + bg[g];
                int gix = 0; float gm = gl[0];
#pragma unroll
                for (int g = 1; g < 4; ++g) if (gl[g] > gm) { gm = gl[g]; gix = g; }
                float gs = 0.f;
#pragma unroll
                for (int g = 0; g < 4; ++g) gs += __expf(gl[g] - gm);
                gval[r] = 1.0f / gs; gi[r] = __builtin_amdgcn_readfirstlane(gix); }
            float ea[R][8];
#pragma unroll
            for (int i = 0; i < 8; ++i) {
#pragma unroll
                for (int r = 0; r < R; ++r) { const float* We = W + (4 + 8 * gi[r] + i) * WROW; pk_f32x2 sacc = {0.f, 0.f};
#pragma unroll
                    for (int j = 0; j < 4; ++j) dot4acc(sacc, v[r][j], ((const float4*)We)[lane + 64 * j]);
                    ea[r][i] = sacc.x + sacc.y; }
                if (i & 1) asm volatile("" ::: "memory"); }
            float ev[R];
#pragma unroll
            for (int r = 0; r < R; ++r) ev[r] = tree_reduce<8>(ea[r], lane);
#pragma unroll
            for (int r = 0; r < R; ++r) {
                float sel[8];
#pragma unroll
                for (int i = 0; i < 8; ++i) sel[i] = lane_bcast(ev[r], 32 * ((i >> 2) & 1) + 16 * ((i >> 1) & 1) + 8 * (i & 1)) + be[8 * gi[r] + i];
                int i0 = 0; float v0 = sel[0];
#pragma unroll
                for (int i = 1; i < 8; ++i) if (sel[i] > v0) { v0 = sel[i]; i0 = i; }
                int i1 = -1; float v1 = -INFINITY;
#pragma unroll
                for (int i = 0; i < 8; ++i) if (i != i0 && sel[i] > v1) { v1 = sel[i]; i1 = i; }
                const float e1 = __expf(v1 - v0); const float w0 = gval[r] / (1.f + e1), w1 = gval[r] * e1 / (1.f + e1);
                if (lane == 0 && ok[r]) {
                    const int m = mr[r], ea_ = gi[r] * 8 + i0, eb_ = gi[r] * 8 + i1;
                    ((int*)(p.ws + WS_TOPE))[2 * m] = ea_; ((int*)(p.ws + WS_TOPE))[2 * m + 1] = eb_;
                    ((float*)(p.ws + WS_TOPW))[2 * m] = w0; ((float*)(p.ws + WS_TOPW))[2 * m + 1] = w1;
                    atomicAdd(&lcnt[ea_], 1u); atomicAdd(&lcnt[eb_], 1u);
                }
            }
        }
    }
#undef ROW_LOAD
    if (MODE == 2) { __syncthreads(); if (real && tid < 32 && lcnt[tid]) atomicAdd((unsigned*)(p.ws + WS_CTL) + CW_CNT + l * 32 + tid, lcnt[tid]); }
}

__device__ __forceinline__ void moe_pad_start(const unsigned* cnt, int* ps  ) {
    int acc = 0;
#pragma unroll
    for (int e = 0; e < 32; ++e) { ps[e] = acc; acc += ((int)cnt[e] + 255) & ~255; }
    ps[32] = acc;
}
__device__ __forceinline__ void ph_scatter(const P& p, int l, unsigned char* smem) {
    unsigned* lcnt = (unsigned*)smem; unsigned* lbase = lcnt + 32; int* lps = (int*)(lbase + 32);
    const int tid = ltid();
    const unsigned* cnt = (const unsigned*)(p.ws + WS_CTL) + CW_CNT + l * 32;
    unsigned* fill = (unsigned*)(p.ws + WS_CTL) + CW_FILL + l * 32;
    int* slot_tok = (int*)(p.ws + WS_SLOT); float* slot_w = (float*)(p.ws + WS_SLOTW); const float* topw = (const float*)(p.ws + WS_TOPW);
    const int* tope = (const int*)(p.ws + WS_TOPE);
    if (tid == 0) { int acc = 0; for (int e = 0; e < 32; ++e) { lps[e] = acc; acc += ((int)cnt[e] + 255) & ~255; } lps[32] = acc; }
    __syncthreads();
    for (int e = blockIdx.x; e < 32; e += gridDim.x) for (int s = lps[e] + (int)cnt[e] + tid; s < lps[e + 1]; s += 512) slot_tok[s] = -1;
    for (int t0 = blockIdx.x * 128; t0 < M; t0 += gridDim.x * 128) {
        if (tid < 32) lcnt[tid] = 0u;
        __syncthreads();
        const bool act = tid < 128; const int m = t0 + (tid & 127);
        int ea = 0, eb = 0; unsigned ia = 0u, ib = 0u; float wa = 0.f, wb = 0.f;
        if (act) { ea = tope[2 * m]; eb = tope[2 * m + 1]; wa = topw[2 * m]; wb = topw[2 * m + 1]; ia = atomicAdd(&lcnt[ea], 1u); ib = atomicAdd(&lcnt[eb], 1u); }
        __syncthreads();
        if (tid < 32) lbase[tid] = lcnt[tid] ? atomicAdd(&fill[tid], lcnt[tid]) : 0u;
        __syncthreads();
        if (act) { const int sa = lps[ea] + (int)(lbase[ea] + ia), sb = lps[eb] + (int)(lbase[eb] + ib); slot_tok[sa] = 2 * m; slot_tok[sb] = 2 * m + 1; slot_w[sa] = wa; slot_w[sb] = wb; }
        __syncthreads();
    }
}

enum { EPI_INPROJ = 0, EPI_OUTPROJ = 1, EPI_MOE1 = 2, EPI_MOE2 = 3 };
#ifndef NTAIL2
#define NTAIL2 2048
#endif
__device__ __forceinline__ int tail_items() { return gridDim.x == 256 ? NTAIL2 : 0; }
namespace attn_body {
using bf16=unsigned short;
using bf16x8=__attribute__((ext_vector_type(8)))short;
using s16x4=__attribute__((ext_vector_type(4)))short;
using f32x16=__attribute__((ext_vector_type(16)))float;
using u32x4=__attribute__((ext_vector_type(4)))unsigned;
constexpr int SEQ=8192,D=64,QP=768,OP=1024;
constexpr int NW=8,QBLK=32,QB=QBLK*NW,KVBLK=64,NQB=SEQ/QB;
constexpr int ATTN_UNIT_ROWS=QB;
__device__ __forceinline__ int crow(int r,int hi){return (r&3)+8*(r>>2)+4*hi;}
#define SBAR() __builtin_amdgcn_sched_barrier(0)
__device__ __forceinline__ void cmask(f32x16&p0,f32x16&p1,int jb,int qrel,int hi){
  const float NEG=-INFINITY; int kb=64*jb+4*hi;
  #pragma unroll
  for(int r=0;r<16;++r){int kv=kb+(r&3)+8*(r>>2); if(kv>qrel)p0[r]=NEG; if(kv+32>qrel)p1[r]=NEG;}
}

constexpr int NSLOT=4, SLOTB=8192;
constexpr int LDS_K=0, LDS_V=NSLOT*SLOTB, LDS_WS=2*NSLOT*SLOTB, LDS_OST=LDS_WS+NW*64*4, LDS_BYTES=LDS_OST+NW*4096;
constexpr float C2=0.125f*1.4426950408889634f;
__device__ __forceinline__ void glds16(const void*gsrc,unsigned lds_dst){unsigned keep;
  asm volatile("s_mov_b32 %0, m0\n\ts_mov_b32 m0, %2\n\ts_nop 0\n\tglobal_load_lds_dwordx4 %1, off\n\ts_mov_b32 m0, %0":"=&s"(keep):"v"(gsrc),"s"(lds_dst):"memory");}
__device__ __forceinline__ float max3f(float a,float b,float c){float r;asm("v_max3_f32 %0, %1, %2, %3":"=v"(r):"v"(a),"v"(b),"v"(c));return r;}
__device__ __forceinline__ float max2f(float a,float b){float r;asm("v_max_f32_e32 %0, %1, %2":"=v"(r):"v"(a),"v"(b));return r;}
__device__ __forceinline__ float fadd_s(float a,float b){float r;asm("v_add_f32_e32 %0, %1, %2":"=v"(r):"v"(a),"v"(b));return r;}
__device__ __forceinline__ float fsub_s(float a,float b){float r;asm("v_sub_f32_e32 %0, %1, %2":"=v"(r):"v"(a),"v"(b));return r;}
typedef float f32x2_t __attribute__((ext_vector_type(2))); typedef __bf16 bf16x2_t __attribute__((ext_vector_type(2)));
__device__ __forceinline__ unsigned cvtpk_s(float lo,float hi){f32x2_t v={lo,hi};bf16x2_t b=__builtin_convertvector(v,bf16x2_t);return __builtin_bit_cast(unsigned,b);}
#define WAIT_BAR(N) asm volatile("s_waitcnt vmcnt(" #N ") lgkmcnt(0)\n\ts_barrier":::"memory")

__device__ __forceinline__ void qkt(f32x16&p0,f32x16&p1,const char*Kslot,const bf16x8*qr,const f32x16&negm,int r32,int hi){
  const char*kb=Kslot+hi*1024+r32*16;
  #pragma unroll
  for(int d0=0;d0<4;++d0){
    const bf16x8 b0=*reinterpret_cast<const bf16x8*>(kb+d0*2048);
    const bf16x8 b1=*reinterpret_cast<const bf16x8*>(kb+d0*2048+512);
    if(d0==0){p0=__builtin_amdgcn_mfma_f32_32x32x16_bf16(b0,qr[0],negm,0,0,0);p1=__builtin_amdgcn_mfma_f32_32x32x16_bf16(b1,qr[0],negm,0,0,0);}
    else{p0=__builtin_amdgcn_mfma_f32_32x32x16_bf16(b0,qr[d0],p0,0,0,0);p1=__builtin_amdgcn_mfma_f32_32x32x16_bf16(b1,qr[d0],p1,0,0,0);}}
}
typedef __attribute__((address_space(3))) const char* lds_cptr;
typedef short v4i16_t __attribute__((ext_vector_type(4)));
__device__ __forceinline__ void kload8(bf16x8*kf,lds_cptr kp){
  kf[0]=*(const __attribute__((address_space(3))) bf16x8*)(kp);      kf[1]=*(const __attribute__((address_space(3))) bf16x8*)(kp+512);
  kf[2]=*(const __attribute__((address_space(3))) bf16x8*)(kp+2048); kf[3]=*(const __attribute__((address_space(3))) bf16x8*)(kp+2560);
  kf[4]=*(const __attribute__((address_space(3))) bf16x8*)(kp+4096); kf[5]=*(const __attribute__((address_space(3))) bf16x8*)(kp+4608);
  kf[6]=*(const __attribute__((address_space(3))) bf16x8*)(kp+6144); kf[7]=*(const __attribute__((address_space(3))) bf16x8*)(kp+6656);
}
__device__ __forceinline__ void kload2(bf16x8*kf,lds_cptr kp,int j){ kf[2*j]=*(const __attribute__((address_space(3))) bf16x8*)(kp+j*2048); kf[2*j+1]=*(const __attribute__((address_space(3))) bf16x8*)(kp+j*2048+512); }
__device__ __forceinline__ s16x4 vtr(lds_cptr p){ return __builtin_bit_cast(s16x4,__builtin_amdgcn_ds_read_tr16_b64_v4i16((__attribute__((address_space(3))) v4i16_t*)p)); }
__device__ __forceinline__ float rowmax(const f32x16&p0,const f32x16&p1){
  float a=max3f(p0[0],p0[1],p1[0]),b=max3f(p0[2],p0[3],p1[1]);a=max3f(a,p1[2],p1[3]);
  #pragma unroll
  for(int r=4;r<16;r+=4){a=max3f(a,p0[r],p0[r+1]);b=max3f(b,p0[r+2],p0[r+3]);a=max3f(a,p1[r],p1[r+1]);b=max3f(b,p1[r+2],p1[r+3]);}
  const float m=max2f(a,b);
  auto rr=__builtin_amdgcn_permlane32_swap(__float_as_uint(m),__float_as_uint(m),false,false);
  return max2f(__uint_as_float(rr[0]),__uint_as_float(rr[1]));
}
__device__ __forceinline__ void pv(f32x16*o,int vb,bf16x8 pa0,bf16x8 pa1,bf16x8 pa2,bf16x8 pa3){
  #pragma unroll
  for(int d0=0;d0<2;++d0){s16x4 lo[4],hi[4];
    #pragma unroll
    for(int ks=0;ks<4;++ks){
      asm volatile("ds_read_b64_tr_b16 %0,%1 offset:%c2":"=&v"(lo[ks]):"v"(vb),"i"(d0*4096+ks*1024):"memory");
      asm volatile("ds_read_b64_tr_b16 %0,%1 offset:%c2":"=&v"(hi[ks]):"v"(vb),"i"(d0*4096+ks*1024+512):"memory");}
    asm volatile("s_waitcnt lgkmcnt(0)":::"memory");SBAR();
    #define PK(k) (bf16x8){lo[k][0],lo[k][1],lo[k][2],lo[k][3],hi[k][0],hi[k][1],hi[k][2],hi[k][3]}
    o[d0]=__builtin_amdgcn_mfma_f32_32x32x16_bf16(pa0,PK(0),o[d0],0,0,0);
    o[d0]=__builtin_amdgcn_mfma_f32_32x32x16_bf16(pa1,PK(1),o[d0],0,0,0);
    o[d0]=__builtin_amdgcn_mfma_f32_32x32x16_bf16(pa2,PK(2),o[d0],0,0,0);
    o[d0]=__builtin_amdgcn_mfma_f32_32x32x16_bf16(pa3,PK(3),o[d0],0,0,0);
    #undef PK
  }
}

#ifndef ATTN_STORE16
#define ATTN_STORE16(p,v) (*(u32x4*)(p)=(v))
#endif
typedef float f32x4v __attribute__((ext_vector_type(4)));
__device__ __forceinline__ void qload(bf16x8 (&qr)[4],const bf16*Qrow,int hi){
  #pragma unroll
  for(int d0=0;d0<4;++d0)qr[d0]=*reinterpret_cast<const bf16x8*>(&Qrow[d0*16+hi*8]);
}
__device__ __forceinline__ void qfetch(bf16x8 (&qr0)[4],bf16x8 (&qr1)[4],const bf16*AQ,int b,int hh,int qb){
  const int tid=ltid(),lane=tid&63,r32=lane&31,hi=lane>>5,wq=(tid>>6)&3;
  const bf16*Qw=AQ+((long)b*SEQ+qb*QB+wq*64)*QP+hh*D;
  qload(qr0,Qw+(long)r32*QP,hi); qload(qr1,Qw+(long)(32+r32)*QP,hi);
}
__device__ __forceinline__ void qprep(bf16x8 (&qr)[4],int tpos,int hi,const float*qgain,const float*rope){
  float qv[4][8]; float ss=0.f;
  #pragma unroll
  for(int d0=0;d0<4;++d0){ const u32x4 x=__builtin_bit_cast(u32x4,qr[d0]);
    qv[d0][0]=__uint_as_float(x.x<<16);qv[d0][1]=__uint_as_float(x.x&0xffff0000u);qv[d0][2]=__uint_as_float(x.y<<16);qv[d0][3]=__uint_as_float(x.y&0xffff0000u);
    qv[d0][4]=__uint_as_float(x.z<<16);qv[d0][5]=__uint_as_float(x.z&0xffff0000u);qv[d0][6]=__uint_as_float(x.w<<16);qv[d0][7]=__uint_as_float(x.w&0xffff0000u);
    #pragma unroll
    for(int j=0;j<8;++j)ss+=qv[d0][j]*qv[d0][j]; }
  { auto rr=__builtin_amdgcn_permlane32_swap(__float_as_uint(ss),__float_as_uint(ss),false,false); ss=__uint_as_float(rr[0])+__uint_as_float(rr[1]); }
  const float rn=(1.0f/sqrtf(ss*(1.0f/64.0f)+1e-6f))*C2;
  #pragma unroll
  for(int d0=0;d0<4;++d0){ const float4 g0=*reinterpret_cast<const float4*>(qgain+16*d0+8*hi), g1=*reinterpret_cast<const float4*>(qgain+16*d0+8*hi+4);
    qv[d0][0]*=rn*g0.x;qv[d0][1]*=rn*g0.y;qv[d0][2]*=rn*g0.z;qv[d0][3]*=rn*g0.w;qv[d0][4]*=rn*g1.x;qv[d0][5]*=rn*g1.y;qv[d0][6]*=rn*g1.z;qv[d0][7]*=rn*g1.w; }
  #pragma unroll
  for(int a=0;a<2;++a){ const int pos=a?(tpos&63):(tpos>>6); const float4*rp=reinterpret_cast<const float4*>(rope+2*(pos*16+8*hi));
    #pragma unroll
    for(int j2=0;j2<4;++j2){ const float4 cs=rp[j2];
      { const float x0=qv[2*a][2*j2],x1=qv[2*a+1][2*j2]; qv[2*a][2*j2]=x0*cs.x-x1*cs.y; qv[2*a+1][2*j2]=x1*cs.x+x0*cs.y; }
      { const float x0=qv[2*a][2*j2+1],x1=qv[2*a+1][2*j2+1]; qv[2*a][2*j2+1]=x0*cs.z-x1*cs.w; qv[2*a+1][2*j2+1]=x1*cs.z+x0*cs.w; } } }
  #pragma unroll
  for(int d0=0;d0<4;++d0){ u32x4 w; w.x=cvtpk_s(qv[d0][0],qv[d0][1]);w.y=cvtpk_s(qv[d0][2],qv[d0][3]);w.z=cvtpk_s(qv[d0][4],qv[d0][5]);w.w=cvtpk_s(qv[d0][6],qv[d0][7]); qr[d0]=__builtin_bit_cast(bf16x8,w); }
}
template<int THRL> __device__ __forceinline__ void attn_unit(int b,int hh,int kvh,int qb,const bf16*AQ,bf16*O,char*shm,float sref,const float*qgain,const float*rope,bf16x8 (&qr0)[4],bf16x8 (&qr1)[4],int nxt,const P&pp,int layer,BgJob&jb){
  const int tid=ltid(),lane=tid&63,r32=lane&31,hi=lane>>5; const int wid=__builtin_amdgcn_readfirstlane(tid>>6);
  const long rowbase=(long)b*SEQ; const int q0=qb*QB;
  const bf16*Kh=AQ+rowbase*QP+512+kvh*D,*Vh=AQ+rowbase*QP+640+kvh*D;
  const unsigned lds0=(unsigned)(uintptr_t)shm;
  const int NT=SEQ/KVBLK;
  if(wid>=4){
    const int lw=wid-4;
    const bf16*ksrc=Kh+(long)lane*QP+(2*lw)*8;
    const bf16*vsrc=Vh+(long)(16*((2*lw)&3)+(lane>>2))*QP+((2*lw)>>2)*32+(lane&3)*8;
    const unsigned kdst=lds0+LDS_K+(2*lw)*1024, vdst=lds0+LDS_V+(2*lw)*1024;
    #define LD_K(t) do{ const unsigned d_=(unsigned)__builtin_amdgcn_readfirstlane(kdst+((t)&3)*SLOTB); glds16(ksrc+(long)(t)*KVBLK*QP,d_); glds16(ksrc+(long)(t)*KVBLK*QP+8,d_+1024); }while(0)
    #define LD_V(t) do{ const unsigned d_=(unsigned)__builtin_amdgcn_readfirstlane(vdst+((t)&3)*SLOTB); glds16(vsrc+(long)(t)*KVBLK*QP,d_); glds16(vsrc+((long)(t)*KVBLK+16)*QP,d_+1024); }while(0)
    LD_K(0);LD_V(0);LD_K(1);LD_K(2);LD_V(1);
    asm volatile("s_waitcnt vmcnt(4)\n\ts_barrier":::"memory");
    bool active=false; const unsigned bgl=lds0+LDS_BYTES+lw*8192; const float*bgt=(const float*)(shm+LDS_BYTES+lw*8192);
    for(int t=-1;t<NT-1;++t){
      const int ph=(t+1+lw)&3;
      if(ph==0)active=(jb.next<BG_TOTAL)&&(t+8<NT);
      if(t+4<NT){
        if(active&&ph==0){ bg_dma(pp,layer,jb.next,bgl); LD_K(t+4); LD_V(t+3); asm volatile("s_waitcnt vmcnt(12)\n\ts_barrier":::"memory"); }
        else if(active&&ph==2){ LD_K(t+4); LD_V(t+3); bg_finish(pp,jb.next,bgt); asm volatile("s_waitcnt vmcnt(8)\n\ts_barrier":::"memory"); }
        else { LD_K(t+4); LD_V(t+3); asm volatile("s_waitcnt vmcnt(4)\n\ts_barrier":::"memory"); if(active&&ph==3){active=false;jb.next+=jb.stride;} }
      }
      else { if(t+3<NT)LD_V(t+3); asm volatile("s_waitcnt vmcnt(0)\n\ts_barrier":::"memory"); }
    }
    #undef LD_K
    #undef LD_V
    _Pragma("unroll") for(int i=0;i<4;++i){qr0[i]=bf16x8{};qr1[i]=bf16x8{};}
    return;
  }
  const int wq=wid;
  float*wsf=(float*)(shm+LDS_WS)+wid*64;
  bf16x8 kf[4];
  const lds_cptr shm3=(lds_cptr)shm; const lds_cptr kp0=shm3+LDS_K+hi*1024+r32*16; const lds_cptr vp0=shm3+LDS_V+((lane>>4)&1)*32+(lane&3)*8+(4*hi+((lane&15)>>2))*64;
  { const int tpos=(q0+wq*64+r32)&(SEQ-1);
    qprep(qr0,tpos,hi,qgain,rope); qprep(qr1,tpos+32,hi,qgain,rope); }
  float l0=0.f,l1=0.f; f32x16 o00=f32x16{},o01=f32x16{},o10=f32x16{},o11=f32x16{}; f32x16 negm;
  float nsref=-sref; asm volatile("":"+v"(nsref),"+v"(qr1[3]));
  _Pragma("unroll") for(int r=0;r<16;++r)negm[r]=nsref;
  asm volatile("":"+v"(negm));
  f32x16 pA0,pA1,pB0,pB1;
  #define MFMA_(a,b,c) __builtin_amdgcn_mfma_f32_32x32x16_bf16(a,b,c,0,0,0)
  #define KLD(j,base) (*(const __attribute__((address_space(3))) bf16x8*)((base)+(j)*2048))
  #define WAIT_BARC() asm volatile("s_waitcnt lgkmcnt(0)\n\ts_barrier":::"memory")
  WAIT_BARC();
  { _Pragma("unroll") for(int d0=0;d0<4;++d0){ const bf16x8 kk=KLD(d0,kp0);
      if(d0==0){pA0=MFMA_(kk,qr0[0],negm);pA1=MFMA_(kk,qr1[0],negm);} else {pA0=MFMA_(kk,qr0[d0],pA0);pA1=MFMA_(kk,qr1[d0],pA1);} } }
  asm volatile("s_nop 15\n\ts_nop 7":"+v"(pA0),"+v"(pA1));
  _Pragma("unroll") for(int r=0;r<16;++r)pA0[r]=__builtin_amdgcn_exp2f(pA0[r]);
  _Pragma("unroll") for(int r=0;r<16;++r)pA1[r]=__builtin_amdgcn_exp2f(pA1[r]);
  { _Pragma("unroll") for(int j=0;j<4;++j)kf[j]=KLD(j,kp0+512); }
  s16x4 vlo[4],vhi[4]; u32x4 pw00,pw01,pw10,pw11;
  #define PKW(P,B) cvtpk_s(P[B],P[B+1])
  #define PAF(k) __builtin_bit_cast(bf16x8,pw##k)
  #define VFR(i) (bf16x8){vlo[i][0],vlo[i][1],vlo[i][2],vlo[i][3],vhi[i][0],vhi[i][1],vhi[i][2],vhi[i][3]}
  #define PIN(x) asm volatile("":"+v"(x))
  #define GAPA(MF,ADDS,W0,W1,PW) do{ MF; ADDS; W0; W1; PIN(PW); SBAR(); }while(0)
  #define EX(v) __builtin_amdgcn_exp2f(v)
  #define GAPB(MF,X,B) do{ MF; X[B]=EX(X[B]); X[B+1]=EX(X[B+1]); X[B+2]=EX(X[B+2]); X[B+3]=EX(X[B+3]); PIN(X); SBAR(); }while(0)
  #define VRD(i) do{ vlo[i]=vtr(vp_+(((i)>>1)*4096+((i)&1)*1024)); vhi[i]=vtr(vp_+(((i)>>1)*4096+((i)&1)*1024+512)); }while(0)
  #define KRD(G,j) do{ if(G){ kf[j]=KLD(j,kp_); SBAR(); } }while(0)
  #define STEP(C0,C1,P0,P1,VOFF,KOFF,GL) do{ SBAR(); \
    const lds_cptr vp_=vp0+(VOFF); const lds_cptr kp_=kp0+(KOFF); \
    VRD(0); SBAR(); float s0=(P0[0]+P0[1]); float s1; \
    GAPA(C0=MFMA_(kf[0],qr0[0],negm), s0+=P0[2];s0+=P0[3];s0+=P0[4];s0+=P0[5];PIN(s0),     pw00[0]=PKW(P0,0), pw00[1]=PKW(P0,2), pw00); \
    GAPA(C1=MFMA_(kf[0],qr1[0],negm), s0+=P0[6];s0+=P0[7];s0+=P0[8];s0+=P0[9];PIN(s0),     pw00[2]=PKW(P0,4), pw00[3]=PKW(P0,6), pw00); \
    VRD(2); SBAR(); \
    GAPA(C0=MFMA_(kf[1],qr0[1],C0),   s0+=P0[10];s0+=P0[11];s0+=P0[12];s0+=P0[13];PIN(s0), pw10[0]=PKW(P1,0), pw10[1]=PKW(P1,2), pw10); \
    GAPA(C1=MFMA_(kf[1],qr1[1],C1),   s0+=P0[14];s0+=P0[15];s1=(P1[0]+P1[1]);s1+=P1[2];PIN(s0);PIN(s1), pw10[2]=PKW(P1,4), pw10[3]=PKW(P1,6), pw10); \
    VRD(1); SBAR(); \
    GAPA(C0=MFMA_(kf[2],qr0[2],C0),   s1+=P1[3];s1+=P1[4];s1+=P1[5];s1+=P1[6];PIN(s1),     pw01[0]=PKW(P0,8), pw01[1]=PKW(P0,10), pw01); \
    GAPA(C1=MFMA_(kf[2],qr1[2],C1),   s1+=P1[7];s1+=P1[8];s1+=P1[9];s1+=P1[10];PIN(s1),    pw01[2]=PKW(P0,12),pw01[3]=PKW(P0,14), pw01); \
    VRD(3); SBAR(); \
    GAPA(C0=MFMA_(kf[3],qr0[3],C0),   s1+=P1[11];s1+=P1[12];s1+=P1[13];s1+=P1[14];PIN(s1), pw11[0]=PKW(P1,8), pw11[1]=PKW(P1,10), pw11); \
    GAPA(C1=MFMA_(kf[3],qr1[3],C1),   s1+=P1[15];PIN(s1),                                  pw11[2]=PKW(P1,12),pw11[3]=PKW(P1,14), pw11); \
    l0+=s0; l1+=s1; \
    SBAR(); \
    KRD(GL,0); GAPB(o00=MFMA_(PAF(00),VFR(0),o00), C0,0); \
    KRD(GL,1); GAPB(o10=MFMA_(PAF(10),VFR(0),o10), C0,4); \
    KRD(GL,2); GAPB(o01=MFMA_(PAF(00),VFR(2),o01), C0,8); \
    KRD(GL,3); GAPB(o11=MFMA_(PAF(10),VFR(2),o11), C0,12); \
    GAPB(o00=MFMA_(PAF(01),VFR(1),o00), C1,0); \
    GAPB(o10=MFMA_(PAF(11),VFR(1),o10), C1,4); \
    GAPB(o01=MFMA_(PAF(01),VFR(3),o01), C1,8); \
    GAPB(o11=MFMA_(PAF(11),VFR(3),o11), C1,12); \
    }while(0)
  STEP(pB0,pB1,pA0,pA1,0,SLOTB,true); WAIT_BARC();
  for(int t=1;t<NT-1;++t){
    const int sc_=(t&3)*SLOTB, sp_=((t-1)&3)*SLOTB, sn_=((t+1)&3)*SLOTB;
    STEP(pA0,pA1,pB0,pB1,sp_+2048,sc_+512,true);
    STEP(pB0,pB1,pA0,pA1,sc_,sn_,true);
    WAIT_BARC();
  }
  { const int sc_=((NT-1)&3)*SLOTB, sp_=((NT-2)&3)*SLOTB;
    STEP(pA0,pA1,pB0,pB1,sp_+2048,sc_+512,true);
    STEP(pB0,pB1,pA0,pA1,sc_,0,false);
    WAIT_BARC();
    float s0=pB0[0]+pB0[1],s1=pB1[0]+pB1[1]; _Pragma("unroll") for(int r=2;r<16;++r){s0+=pB0[r];s1+=pB1[r];} l0+=s0; l1+=s1;
    pw00=(u32x4){PKW(pB0,0),PKW(pB0,2),PKW(pB0,4),PKW(pB0,6)};pw01=(u32x4){PKW(pB0,8),PKW(pB0,10),PKW(pB0,12),PKW(pB0,14)};pw10=(u32x4){PKW(pB1,0),PKW(pB1,2),PKW(pB1,4),PKW(pB1,6)};pw11=(u32x4){PKW(pB1,8),PKW(pB1,10),PKW(pB1,12),PKW(pB1,14)};
    SBAR(); const lds_cptr vp_=vp0+sc_+2048; VRD(0);VRD(1);VRD(2);VRD(3);
    o00=MFMA_(PAF(00),VFR(0),o00); o10=MFMA_(PAF(10),VFR(0),o10); o01=MFMA_(PAF(00),VFR(2),o01); o11=MFMA_(PAF(10),VFR(2),o11);
    o00=MFMA_(PAF(01),VFR(1),o00); o10=MFMA_(PAF(11),VFR(1),o10); o01=MFMA_(PAF(01),VFR(3),o01); o11=MFMA_(PAF(11),VFR(3),o11); }
  #undef PKW
  #undef PAF
  #undef VFR
  #undef PIN
  #undef GAPA
  #undef GAPB
  #undef EX
  #undef VRD
  #undef KRD
  #undef STEP
  {auto rr=__builtin_amdgcn_permlane32_swap(__float_as_uint(l0),__float_as_uint(l0),false,false);l0=__uint_as_float(rr[0])+__uint_as_float(rr[1]);}
  {auto rr=__builtin_amdgcn_permlane32_swap(__float_as_uint(l1),__float_as_uint(l1),false,false);l1=__uint_as_float(rr[0])+__uint_as_float(rr[1]);}
  if(hi==0){wsf[r32]=l0;wsf[32+r32]=l1;} asm volatile("s_waitcnt lgkmcnt(0)":::"memory");
  bf16*Ow=O+(rowbase+q0+wq*64)*OP+512+hh*D; bf16*stg=(bf16*)(shm+LDS_OST)+wid*4096;
  #define FINAL(OA,OB,LOFF,ROFF) do{ _Pragma("unroll") for(int r=0;r<16;++r){ const int orow=crow(r,hi); const float rl=__builtin_amdgcn_rcpf(wsf[(LOFF)+orow]); \
      stg[((ROFF)+orow)*64+r32]=(bf16)f2bf(OA[r]*rl); stg[((ROFF)+orow)*64+32+r32]=(bf16)f2bf(OB[r]*rl);} }while(0)
  FINAL(o00,o01,0,0); FINAL(o10,o11,32,32);
  #undef FINAL
  if(nxt>=0){ qfetch(qr0,qr1,AQ,nxt>>16,(nxt>>8)&255,nxt&255); } else { _Pragma("unroll") for(int i=0;i<4;++i){qr0[i]=bf16x8{};qr1[i]=bf16x8{};} }
  asm volatile("s_waitcnt lgkmcnt(0)":::"memory");
  #pragma unroll
  for(int i=0;i<8;++i){const int row=i*8+(lane>>3),ch=lane&7; const u32x4 v=*(const u32x4*)(stg+row*64+ch*8); ATTN_STORE16(Ow+(long)row*OP+ch*8,v);}
  asm volatile("s_waitcnt lgkmcnt(0)":::"memory");
  #undef MFMA_
  #undef KLD
  #undef WAIT_BARC
}
constexpr int ATTN_LDS_BYTES=LDS_BYTES;
#undef SBAR
#undef WAIT_BAR
}

__device__ __forceinline__ void ph_attn_mfma(const P& p, int l, unsigned char* smem) {
    const int G = gridDim.x, bx = blockIdx.x;
    const attn_body::bf16* AQ = (const attn_body::bf16*)(p.ws + WS_AQKV); attn_body::bf16* O = (attn_body::bf16*)(p.ws + WS_R1);
    const int vcu = (bx % 8) * (G / 8) + bx / 8;
    float sref;
    { const int lane = ltid() & 63; float mq = fabsf(pin(p, 7)[l * 64 + lane]), mk = fabsf(pin(p, 8)[l * 64 + lane]);
#define AMX(M_) mq = fmaxf(mq, shx<M_>(mq)); mk = fmaxf(mk, shx<M_>(mk));
      AMX(1) AMX(2) AMX(4) AMX(8) AMX(16) AMX(32)
#undef AMX
      sref = 8.0f * 1.4426950408889634f * mq * mk * 1.002f; sref = __uint_as_float((unsigned)__builtin_amdgcn_readfirstlane((int)__float_as_uint(sref))); }
#define ATTN_UNIT_L(i) ((G == 256) ? ((i) < 4 ? (((vcu >> 5) << 7) | ((i) << 5) | (vcu & 31)) : -1) : ((i) * G + bx < 1024 ? (i) * G + bx : -1))
#define ATTN_DESC(L) ((((L) >> 7) >> 1) << 16 | (4 * (((L) >> 7) & 1) + (((L) >> 5) & 3)) << 8 | ((L) & 31))
    attn_body::bf16x8 qr0[4], qr1[4];
    BgJob jb; jb.stride = G * 4; { const int w_ = __builtin_amdgcn_readfirstlane(ltid() >> 6); jb.next = (w_ >= 4) ? bx * 4 + w_ - 4 : BG_TOTAL; }
    int L = ATTN_UNIT_L(0);
    if (L >= 0 && (ltid() >> 6) < 4) { const int d = ATTN_DESC(L); attn_body::qfetch(qr0, qr1, AQ, d >> 16, (d >> 8) & 255, d & 255); }
    for (int i = 0; L >= 0; ++i) {
        const int Ln = ATTN_UNIT_L(i + 1);
        const int pair = L >> 7, h4 = (L >> 5) & 3, qb = L & 31;
        attn_body::attn_unit<8>(pair >> 1, 4 * (pair & 1) + h4, pair & 1, qb, AQ, O, (char*)smem, sref, pin(p, 7) + l * 64, (const float*)(p.ws + WS_ROPE), qr0, qr1, Ln >= 0 ? ATTN_DESC(Ln) : -1, p, l, jb);
        L = Ln;
    }
#undef ATTN_UNIT_L
#undef ATTN_DESC
    { const int w_ = __builtin_amdgcn_readfirstlane(ltid() >> 6) & 3; const unsigned bgl = (unsigned)(uintptr_t)smem + attn_body::LDS_BYTES + w_ * 8192; const float* bgt = (const float*)(smem + attn_body::LDS_BYTES + w_ * 8192);
      while (jb.next < BG_TOTAL) { bg_dma(p, l, jb.next, bgl); asm volatile("s_waitcnt vmcnt(0)" ::: "memory"); bg_finish(p, jb.next, bgt); jb.next += jb.stride; } }
}

constexpr int R2_GAIN = 147456, R2_SCR = R2_GAIN + 4096, R2_BIAS = R2_SCR + 8 * 8 * 36 * 4, R2_CNT = R2_BIAS + 256, R2_RN = R2_CNT + 128;
__device__ __forceinline__ void ph_row2_mfma(const P& p, int l, unsigned char* smem, bool real) {
    typedef short bf16x8_t __attribute__((ext_vector_type(8)));
    typedef float f32x4_t __attribute__((ext_vector_type(4)));
    const int tid = ltid(), lane = tid & 63, r = lane & 15, kq = lane >> 4; const int wid = __builtin_amdgcn_readfirstlane(tid >> 6);
    const bf16_t* XB = (const bf16_t*)(p.ws + WS_XB); bf16_t* XN = (bf16_t*)(p.ws + WS_XN);
    const unsigned lds0 = (unsigned)(uintptr_t)smem;
    float* gainl = (float*)(smem + R2_GAIN); float* scr = (float*)(smem + R2_SCR) + wid * 8 * 36; float* biasl = (float*)(smem + R2_BIAS); unsigned* lcnt = (unsigned*)(smem + R2_CNT); float* rnb = (float*)(smem + R2_RN) + wid * 16;
    const int NG = M / 16; int g = blockIdx.x * 8 + wid;
    bf16x8_t xa[32];
    if (g < NG) {
#pragma unroll
        for (int ks = 0; ks < 32; ++ks) xa[ks] = *(const bf16x8_t*)(XB + (size_t)(g * 16 + r) * 1024 + 32 * ks + 8 * kq);
    }
    { const unsigned char* img = p.ws + WS_RIMG + (size_t)l * 2 * RIMG_PART * 2;
      for (int pc = wid; pc < 144; pc += 8) attn_body::glds16(img + (size_t)pc * 1024 + lane * 16, (unsigned)__builtin_amdgcn_readfirstlane(lds0 + pc * 1024)); }
    if (tid < 256) ((float4*)gainl)[tid] = ((const float4*)(pin(p, 10) + l * 1024))[tid];
    if (tid < 32) { lcnt[tid] = 0u; biasl[tid] = pin(p, 14)[l * 32 + tid]; }
    if (tid >= 64 && tid < 68) biasl[32 + tid - 64] = pin(p, 12)[l * 4 + tid - 64];
    asm volatile("s_waitcnt vmcnt(0)" ::: "memory");
    __syncthreads();
    const __attribute__((address_space(3))) unsigned char* wl = (const __attribute__((address_space(3))) unsigned char*)smem;
    for (; g < NG; g += gridDim.x * 8) {
        const int row0 = g * 16;
        f32x4_t d0 = {0.f, 0.f, 0.f, 0.f}, d1 = d0, d2 = d0, dss = d0;
#pragma unroll
        for (int ks = 0; ks < 32; ++ks) {
            const bf16x8_t b0h = *(const __attribute__((address_space(3))) bf16x8_t*)(wl + ((0 * 32 + ks) * 64 + lane) * 16), b1h = *(const __attribute__((address_space(3))) bf16x8_t*)(wl + ((1 * 32 + ks) * 64 + lane) * 16);
            const bf16x8_t b2h = *(const __attribute__((address_space(3))) bf16x8_t*)(wl + 65536 + ((ks * 4 + kq) * 4 + (r & 3)) * 16);
            const bf16x8_t b0l = *(const __attribute__((address_space(3))) bf16x8_t*)(wl + RIMG_PART * 2 + ((0 * 32 + ks) * 64 + lane) * 16), b1l = *(const __attribute__((address_space(3))) bf16x8_t*)(wl + RIMG_PART * 2 + ((1 * 32 + ks) * 64 + lane) * 16);
            const bf16x8_t b2l = *(const __attribute__((address_space(3))) bf16x8_t*)(wl + RIMG_PART * 2 + 65536 + ((ks * 4 + kq) * 4 + (r & 3)) * 16);
            d0 = __builtin_amdgcn_mfma_f32_16x16x32_bf16(xa[ks], b0h, d0, 0, 0, 0); d1 = __builtin_amdgcn_mfma_f32_16x16x32_bf16(xa[ks], b1h, d1, 0, 0, 0); d2 = __builtin_amdgcn_mfma_f32_16x16x32_bf16(xa[ks], b2h, d2, 0, 0, 0);
            d0 = __builtin_amdgcn_mfma_f32_16x16x32_bf16(xa[ks], b0l, d0, 0, 0, 0); d1 = __builtin_amdgcn_mfma_f32_16x16x32_bf16(xa[ks], b1l, d1, 0, 0, 0); d2 = __builtin_amdgcn_mfma_f32_16x16x32_bf16(xa[ks], b2l, d2, 0, 0, 0);
            dss = __builtin_amdgcn_mfma_f32_16x16x32_bf16(xa[ks], xa[ks], dss, 0, 0, 0);
        }
        { const int i = r & 3; const float dg = (i == 0) ? dss[0] : (i == 1) ? dss[1] : (i == 2) ? dss[2] : dss[3];
          if ((r >> 2) == kq) rnb[r] = 1.0f / sqrtf(dg * (1.0f / 1024.0f) + EPS); }
        asm volatile("s_waitcnt lgkmcnt(0)" ::: "memory");
        const float rnr = rnb[r];
        const f32x4_t rnd = *(const f32x4_t*)(rnb + 4 * kq);
#pragma unroll
        for (int ks = 0; ks < 32; ++ks) {
            const float4 ga = *(const float4*)(gainl + 32 * ks + 8 * kq), gb = *(const float4*)(gainl + 32 * ks + 8 * kq + 4);
            const u32x4 x = __builtin_bit_cast(u32x4, xa[ks]); u32x4 w;
            w.x = pk2(bf2f(x.x & 0xffffu) * rnr * ga.x, bf2f(x.x >> 16) * rnr * ga.y); w.y = pk2(bf2f(x.y & 0xffffu) * rnr * ga.z, bf2f(x.y >> 16) * rnr * ga.w);
            w.z = pk2(bf2f(x.z & 0xffffu) * rnr * gb.x, bf2f(x.z >> 16) * rnr * gb.y); w.w = pk2(bf2f(x.w & 0xffffu) * rnr * gb.z, bf2f(x.w >> 16) * rnr * gb.w);
            *(u32x4*)(XN + (size_t)(row0 + r) * 1024 + 32 * ks + 8 * kq) = w;
        }
        const int gn = g + gridDim.x * 8;
        if (gn < NG) {
#pragma unroll
            for (int ks = 0; ks < 32; ++ks) xa[ks] = *(const bf16x8_t*)(XB + (size_t)(gn * 16 + r) * 1024 + 32 * ks + 8 * kq);
        }
#pragma unroll
        for (int half = 0; half < 2; ++half) {
            if ((kq >> 1) == half) {
#pragma unroll
                for (int i = 0; i < 4; ++i) { const int rl = 4 * (kq & 1) + i; const float rv = rnd[i];
                    scr[rl * 36 + r] = d0[i] * rv; scr[rl * 36 + 16 + r] = d1[i] * rv; if (r < 4) scr[rl * 36 + 32 + r] = d2[i] * rv; }
            }
            asm volatile("s_waitcnt lgkmcnt(0)" ::: "memory");
            if (lane < 8) {
                const float* lg = scr + lane * 36; const int m = row0 + 8 * half + lane;
                int gix = 0; float gm = lg[32] + biasl[32]; float gl[4]; gl[0] = gm;
#pragma unroll
                for (int q = 1; q < 4; ++q) { gl[q] = lg[32 + q] + biasl[32 + q]; if (gl[q] > gm) { gm = gl[q]; gix = q; } }
                float gs = 0.f;
#pragma unroll
                for (int q = 0; q < 4; ++q) gs += __expf(gl[q] - gm);
                const float gval = 1.0f / gs;
                float sel[8];
#pragma unroll
                for (int i = 0; i < 8; ++i) sel[i] = lg[8 * gix + i] + biasl[8 * gix + i];
                int i0 = 0; float v0 = sel[0];
#pragma unroll
                for (int i = 1; i < 8; ++i) if (sel[i] > v0) { v0 = sel[i]; i0 = i; }
                int i1 = -1; float v1 = -INFINITY;
#pragma unroll
                for (int i = 0; i < 8; ++i) if (i != i0 && sel[i] > v1) { v1 = sel[i]; i1 = i; }
                const float e1 = __expf(v1 - v0); const float w0 = gval / (1.f + e1), w1 = gval * e1 / (1.f + e1);
                const int ea_ = gix * 8 + i0, eb_ = gix * 8 + i1;
                ((int*)(p.ws + WS_TOPE))[2 * m] = ea_; ((int*)(p.ws + WS_TOPE))[2 * m + 1] = eb_;
                ((float*)(p.ws + WS_TOPW))[2 * m] = w0; ((float*)(p.ws + WS_TOPW))[2 * m + 1] = w1;
                atomicAdd(&lcnt[ea_], 1u); atomicAdd(&lcnt[eb_], 1u);
            }
            asm volatile("s_waitcnt lgkmcnt(0)" ::: "memory");
        }
    }
    __syncthreads();
    if (real && tid < 32 && lcnt[tid]) atomicAdd((unsigned*)(p.ws + WS_CTL) + CW_CNT + l * 32 + tid, lcnt[tid]);
}

namespace ml {
using attn_body::bf16x8; using attn_body::s16x4; using attn_body::f32x16; using attn_body::lds_cptr; using attn_body::vtr; using attn_body::glds16; using attn_body::crow;
constexpr size_t WS_NST = WS_CST + 64 * MiB;
constexpr size_t WS_NPV = WS_NST + 1 * MiB;
constexpr size_t WS_CPV = WS_XN;
constexpr size_t WS_MST = 17 * MiB + 65536;
constexpr float L2E = 1.4426950408889634f;
constexpr float QK_SCALE = 0.08838834764831845f;
#define ML_MFMA(a, b, c) __builtin_amdgcn_mfma_f32_32x32x16_bf16(a, b, c, 0, 0, 0)
__device__ __forceinline__ void chunk_scalars(const float* GA, int row0, int h, float* sc, float* tmp, int tid) {
    const int lane = tid & 63, wave = tid >> 6, dir = tid >> 7, jj = tid & 127, j = dir ? 127 - jj : jj;
    float x = 0.f, ig = 0.f;
    if (tid < 256) { const size_t m = (size_t)(row0 + j); ig = GA[m * 16 + 8 * dir + h]; x = GA[m * 16 + 8 * dir + 4 + h]; }
#pragma unroll
    for (int o = 1; o < 64; o <<= 1) { const float y = __uint_as_float((unsigned)__builtin_amdgcn_ds_bpermute((lane >= o ? lane - o : lane) << 2, (int)__float_as_uint(x))); if (lane >= o) x += y; }
    if (lane == 63 && tid < 256) tmp[wave] = x;
    __syncthreads();
    if (tid < 256 && (wave & 1)) x += tmp[wave - 1];
    const float u = ig - x;
    float pm = u;
#pragma unroll
    for (int o = 1; o < 64; o <<= 1) { const float y = __uint_as_float((unsigned)__builtin_amdgcn_ds_bpermute((lane >= o ? lane - o : lane) << 2, (int)__float_as_uint(pm))); if (lane >= o) pm = fmaxf(pm, y); }
    if (lane == 63 && tid < 256) tmp[8 + wave] = pm;
    __syncthreads();
    if (tid < 256) { if (wave & 1) pm = fmaxf(pm, tmp[8 + wave - 1]); sc[dir * 384 + j] = x; sc[dir * 384 + 128 + j] = u; sc[dir * 384 + 256 + j] = pm; }
}
__device__ __forceinline__ bf16x8 trfrag(lds_cptr p) { const s16x4 lo = vtr(p), hi = vtr(p + 512); return (bf16x8){lo[0], lo[1], lo[2], lo[3], hi[0], hi[1], hi[2], hi[3]}; }
__device__ __forceinline__ bf16x8 scale8(bf16x8 f, const float4 wa, const float4 wb) {
    const u32x4 x = __builtin_bit_cast(u32x4, f); u32x4 o;
    o.x = pk2(bf2f(x.x & 0xffffu) * wa.x, bf2f(x.x >> 16) * wa.y); o.y = pk2(bf2f(x.y & 0xffffu) * wa.z, bf2f(x.y >> 16) * wa.w);
    o.z = pk2(bf2f(x.z & 0xffffu) * wb.x, bf2f(x.z >> 16) * wb.y); o.w = pk2(bf2f(x.w & 0xffffu) * wb.z, bf2f(x.w >> 16) * wb.w);
    return __builtin_bit_cast(bf16x8, o);
}
__device__ __forceinline__ void dma_vlayout(const bf16_t* src  , unsigned dst, int wid, int lane) {
#pragma unroll
    for (int q = 0; q < 4; ++q) { const int pc = wid * 4 + q, db = pc >> 3, kg = pc & 7;
        glds16(src + (size_t)(16 * kg + (lane >> 2)) * 1024 + 32 * db + 8 * (lane & 3), (unsigned)__builtin_amdgcn_readfirstlane(dst + db * 8192 + kg * 1024)); }
}
__device__ __forceinline__ void dma_klayout(const bf16_t* src, unsigned dst, int wid, int lane) {
#pragma unroll
    for (int q = 0; q < 4; ++q) { const int pc = wid * 4 + q, ch = pc >> 1, hf = pc & 1;
        glds16(src + (size_t)(64 * hf + lane) * 1024 + 8 * ch, (unsigned)__builtin_amdgcn_readfirstlane(dst + ch * 2048 + hf * 1024)); }
}
__device__ __forceinline__ void dma_linear32k(const unsigned char* src, unsigned dst, int wid, int lane) {
#pragma unroll
    for (int q = 0; q < 4; ++q) { const int pc = wid * 4 + q; glds16(src + pc * 1024 + lane * 16, (unsigned)__builtin_amdgcn_readfirstlane(dst + pc * 1024)); }
}

__device__ __forceinline__ void m1_chunk(const P& p, int l, unsigned char* smem, int rc) {
    const int tid = ltid(), lane = tid & 63, r32 = lane & 31, hi = lane >> 5; const int wid = __builtin_amdgcn_readfirstlane(tid >> 6);
    const bf16_t* QKC = (const bf16_t*)(p.ws + WS_QKC); const bf16_t* MVO = (const bf16_t*)(p.ws + WS_MVO); const float* GA = (const float*)(p.ws + WS_GATES);
    unsigned char* CST = p.ws + WS_CST; float* NST = (float*)(p.ws + WS_NST); float* MST = (float*)(p.ws + WS_MST);
    const unsigned lds0 = (unsigned)(uintptr_t)smem;
    float* sc = (float*)(smem + LDS_RING + 256); float* wts = sc + 768; float* tmp = wts + 256;
    const int laddr = ((lane >> 4) & 1) * 32 + (lane & 3) * 8 + (4 * hi + ((lane & 15) >> 2)) * 64;
    const int b = rc >> 6, c = rc & 63, row0 = b * SEQ + c * 128;
    dma_vlayout(QKC + (size_t)row0 * 1024 + 512, lds0, wid, lane);
    dma_vlayout(MVO + (size_t)row0 * 1024, lds0 + 32768, wid, lane);
    for (int h = 0; h < 4; ++h) {
        const int unit = (b * 4 + h) * 64 + c;
        const unsigned boff = (unsigned)(h & 1) * 65536u;
        const lds_cptr s3 = (lds_cptr)smem + boff;
        __syncthreads();
        chunk_scalars(GA, row0, h, sc, tmp, tid);
        __syncthreads();
        if (tid < 256) { const int dir = tid >> 7, j = tid & 127; const float umax = sc[dir * 384 + 256 + (dir ? 0 : 127)]; wts[dir * 128 + j] = __expf(sc[dir * 384 + 128 + j] - umax);
            if (j == 0) { const float blast = sc[dir * 384 + (dir ? 0 : 127)]; MST[(unit * 2 + dir) * 4] = blast + umax; MST[(unit * 2 + dir) * 4 + 1] = blast; } }
        if (h < 3) { dma_vlayout(QKC + (size_t)row0 * 1024 + 512 + 128 * (h + 1), lds0 + (65536u - boff), wid, lane);
                     dma_vlayout(MVO + (size_t)row0 * 1024 + 128 * (h + 1), lds0 + (65536u - boff) + 32768, wid, lane);
                     asm volatile("s_waitcnt vmcnt(8)" ::: "memory"); }
        else asm volatile("s_waitcnt vmcnt(0)" ::: "memory");
        __syncthreads();
        const int vb = wid & 3, kb0 = 2 * (wid >> 2), kbn = wid & 3, dirn = wid >> 2;
        f32x16 a00 = {}, a01 = {}, a10 = {}, a11 = {}, an = {};
#pragma unroll 2
        for (int ks = 0; ks < 8; ++ks) {
            const bf16x8 vf = trfrag(s3 + 32768 + vb * 8192 + ks * 1024 + laddr);
            const bf16x8 k0 = trfrag(s3 + kb0 * 8192 + ks * 1024 + laddr), k1 = trfrag(s3 + (kb0 + 1) * 8192 + ks * 1024 + laddr), kn = trfrag(s3 + kbn * 8192 + ks * 1024 + laddr);
            const float4 wfa = *(const float4*)(wts + 16 * ks + 4 * hi), wfb = *(const float4*)(wts + 16 * ks + 8 + 4 * hi);
            const float4 wba = *(const float4*)(wts + 128 + 16 * ks + 4 * hi), wbb = *(const float4*)(wts + 128 + 16 * ks + 8 + 4 * hi);
            const bf16x8 vff = scale8(vf, wfa, wfb), vfb = scale8(vf, wba, wbb);
            a00 = ML_MFMA(k0, vff, a00); a01 = ML_MFMA(k1, vff, a01); a10 = ML_MFMA(k0, vfb, a10); a11 = ML_MFMA(k1, vfb, a11);
            const float4 wna = dirn ? wba : wfa, wnb = dirn ? wbb : wfb;
            u32x4 wn; wn.x = pk2(wna.x, wna.y); wn.y = pk2(wna.z, wna.w); wn.z = pk2(wnb.x, wnb.y); wn.w = pk2(wnb.z, wnb.w);
            if (r32 != 0) wn = (u32x4){0u, 0u, 0u, 0u};
            an = ML_MFMA(kn, __builtin_bit_cast(bf16x8, wn), an);
        }
#pragma unroll
        for (int dir = 0; dir < 2; ++dir)
#pragma unroll
            for (int kk = 0; kk < 2; ++kk) { const f32x16& a = dir ? (kk ? a11 : a10) : (kk ? a01 : a00); unsigned char* img = CST + (size_t)(unit * 2 + dir) * 32768;
#pragma unroll
                for (int g = 0; g < 4; ++g) { u32x2 w; w.x = pk2(a[4 * g], a[4 * g + 1]); w.y = pk2(a[4 * g + 2], a[4 * g + 3]);
                    *(u32x2*)(img + (4 * (kb0 + kk) + g) * 2048 + (32 * vb + r32) * 16 + 8 * hi) = w; } }
        if (r32 == 0) {
#pragma unroll
            for (int r = 0; r < 16; ++r) NST[(size_t)(unit * 2 + dirn) * 128 + 32 * kbn + crow(r, hi)] = an[r]; }
    }
}

__device__ __forceinline__ void ph_m2(const P& p, int l, unsigned char* smem) {
    const int tid = ltid();
    unsigned char* CST = p.ws + WS_CST; float* NST = (float*)(p.ws + WS_NST); float* MST = (float*)(p.ws + WS_MST);
    unsigned char* CPV = p.ws + WS_CPV; float* NPV = (float*)(p.ws + WS_NPV);
    float* dold = (float*)smem; float* dnew = dold + 64; float* mpv = dnew + 64; float* ml = mpv + 64; float* bl = ml + 64;
    for (int item = blockIdx.x; item < 256; item += gridDim.x) {
        const int chain = item >> 3, slice = item & 7, bh = chain >> 1, dir = chain & 1;
        __syncthreads();
        if (tid < 64) { const int unit = bh * 64 + tid; ml[tid] = MST[(unit * 2 + dir) * 4]; bl[tid] = MST[(unit * 2 + dir) * 4 + 1]; }
        __syncthreads();
        if (tid < 64) {
            const int c = dir ? 63 - tid : tid; const float b = bl[c], mlv = ml[c];
            float Bi = b;
#pragma unroll
            for (int o = 1; o < 64; o <<= 1) { const float y = __uint_as_float((unsigned)__builtin_amdgcn_ds_bpermute((tid >= o ? tid - o : tid) << 2, (int)__float_as_uint(Bi))); if (tid >= o) Bi += y; }
            float rm = mlv - Bi;
#pragma unroll
            for (int o = 1; o < 64; o <<= 1) { const float y = __uint_as_float((unsigned)__builtin_amdgcn_ds_bpermute((tid >= o ? tid - o : tid) << 2, (int)__float_as_uint(rm))); if (tid >= o) rm = fmaxf(rm, y); }
            const float mn = Bi + fmaxf(0.f, rm);
            float m = __uint_as_float((unsigned)__builtin_amdgcn_ds_bpermute((tid >= 1 ? tid - 1 : tid) << 2, (int)__float_as_uint(mn))); if (tid == 0) m = 0.f;
            mpv[c] = m; dold[c] = __expf(b + m - mn); dnew[c] = __expf(mlv - mn); }
        __syncthreads();
        float c0 = 0.f, c1 = 0.f, c2 = 0.f, c3 = 0.f, nn = 0.f;
        const size_t eoff = (size_t)slice * 4096 + (size_t)tid * 8;
#pragma unroll 8
        for (int s = 0; s < 64; ++s) {
            const int c = dir ? 63 - s : s; const int unit = bh * 64 + c;
            const u32x2 v = *(const u32x2*)(CST + (size_t)(unit * 2 + dir) * 32768 + eoff); const float fo = dold[c], fn = dnew[c];
            u32x2 o; o.x = pk2(c0, c1); o.y = pk2(c2, c3); *(u32x2*)(CPV + (size_t)(unit * 2 + dir) * 32768 + eoff) = o;
            c0 = c0 * fo + bf2f(v.x & 0xffffu) * fn; c1 = c1 * fo + bf2f(v.x >> 16) * fn; c2 = c2 * fo + bf2f(v.y & 0xffffu) * fn; c3 = c3 * fo + bf2f(v.y >> 16) * fn;
            if (slice == 0 && tid < 128) { const float nv = NST[(size_t)(unit * 2 + dir) * 128 + tid]; NPV[(size_t)(unit * 2 + dir) * 128 + tid] = nn; nn = nn * fo + nv * fn; }
        }
        if (slice == 0 && tid < 64) MST[((bh * 64 + tid) * 2 + dir) * 4 + 2] = mpv[tid];
    }
}

__device__ __forceinline__ void ph_m3(const P& p, int l, unsigned char* smem) {
    const int tid = ltid(), lane = tid & 63, r32 = lane & 31, hi = lane >> 5; const int wid = __builtin_amdgcn_readfirstlane(tid >> 6);
    const int rb = wid >> 1, vh = wid & 1;
    const bf16_t* QKC = (const bf16_t*)(p.ws + WS_QKC); const bf16_t* MVO = (const bf16_t*)(p.ws + WS_MVO); const float* GA = (const float*)(p.ws + WS_GATES);
    const unsigned char* CST = p.ws + WS_CPV; const float* NST = (const float*)(p.ws + WS_NPV); const float* MST = (const float*)(p.ws + WS_MST);
    bf16_t* HM = (bf16_t*)(p.ws + WS_R1); const float* mg = pin(p, 6) + l * 512;
    const unsigned lds0 = (unsigned)(uintptr_t)smem;
    float* sc = (float*)(smem + LDS_RING + 256); float* Mi = sc + 768; float* ew = Mi + 256; float* npv = ew + 256; float* tmp = npv + 256; float* wsf = tmp + 16 + wid * 64;
    float* Aw = tmp + 16 + 512; float* Bw = Aw + 256;
    float* stg = (float*)smem;
    const lds_cptr s3 = (lds_cptr)smem;
    const int laddr = ((lane >> 4) & 1) * 32 + (lane & 3) * 8 + (4 * hi + ((lane & 15) >> 2)) * 64;
    for (int unit = blockIdx.x; unit < 1024; unit += gridDim.x) {
        const int b = unit >> 8, h = (unit >> 6) & 3, c = unit & 63, row0 = b * SEQ + c * 128;
        __syncthreads();
        dma_klayout(QKC + (size_t)row0 * 1024 + 512 + 128 * h, lds0, wid, lane);
        dma_vlayout(MVO + (size_t)row0 * 1024 + 128 * h, lds0 + 32768, wid, lane);
        dma_linear32k(CST + (size_t)(unit * 2) * 32768, lds0 + 65536, wid, lane);
        dma_linear32k(CST + (size_t)(unit * 2 + 1) * 32768, lds0 + 98304, wid, lane);
        bf16x8 qr[8];
#pragma unroll
        for (int ks = 0; ks < 8; ++ks) qr[ks] = *(const bf16x8*)(QKC + (size_t)(row0 + 32 * rb + r32) * 1024 + 128 * h + 16 * ks + 8 * hi);
        chunk_scalars(GA, row0, h, sc, tmp, tid);
        __syncthreads();
        if (tid < 256) { const int dir = tid >> 7, j = tid & 127; const float mp = MST[(unit * 2 + dir) * 4 + 2]; const float Mx = fmaxf(sc[dir * 384 + 256 + j], mp);
            Mi[dir * 128 + j] = Mx; ew[dir * 128 + j] = __expf(mp - Mx) * QK_SCALE; npv[dir * 128 + j] = NST[(size_t)(unit * 2 + dir) * 128 + j];
            const float umax = sc[dir * 384 + 256 + (dir ? 0 : 127)];
            Aw[dir * 128 + j] = __expf(sc[dir * 384 + 128 + j] - umax);
            Bw[dir * 128 + j] = __expf(fminf(umax - Mx, 80.f)) * QK_SCALE; }
        asm volatile("s_waitcnt vmcnt(0)" ::: "memory");
        __syncthreads();
        f32x16 hacc[2]; hacc[0] = f32x16{}; hacc[1] = f32x16{};
#pragma unroll 1
        for (int dir = 0; dir < 2; ++dir) {
            const lds_cptr Cimg = s3 + 65536 + dir * 32768;
            f32x16 o[2]; o[0] = f32x16{}; o[1] = f32x16{};
#pragma unroll
            for (int kb = 0; kb < 8; kb += 4) {
                bf16x8 cf[4][2];
#pragma unroll
                for (int k2 = 0; k2 < 4; ++k2)
#pragma unroll
                    for (int blk = 0; blk < 2; ++blk) cf[k2][blk] = *(const __attribute__((address_space(3))) bf16x8*)(Cimg + (2 * (kb + k2) + hi) * 2048 + (32 * (2 * vh + blk) + r32) * 16);
#pragma unroll
                for (int k2 = 0; k2 < 4; ++k2)
#pragma unroll
                    for (int blk = 0; blk < 2; ++blk) o[blk] = ML_MFMA(qr[kb + k2], cf[k2][blk], o[blk]);
                asm volatile("" ::: "memory");
            }
#pragma unroll
            for (int g = 0; g < 4; ++g) { const float4 e4 = *(const float4*)(ew + dir * 128 + 32 * rb + 8 * g + 4 * hi);
#pragma unroll
                for (int blk = 0; blk < 2; ++blk) { o[blk][4 * g] *= e4.x; o[blk][4 * g + 1] *= e4.y; o[blk][4 * g + 2] *= e4.z; o[blk][4 * g + 3] *= e4.w; } }
            float dq = 0.f;
#pragma unroll
            for (int ks = 0; ks < 8; ++ks) { const u32x4 x = __builtin_bit_cast(u32x4, qr[ks]); const float4 na = *(const float4*)(npv + dir * 128 + 16 * ks + 8 * hi), nb2 = *(const float4*)(npv + dir * 128 + 16 * ks + 8 * hi + 4);
                dq += bf2f(x.x & 0xffffu) * na.x + bf2f(x.x >> 16) * na.y + bf2f(x.y & 0xffffu) * na.z + bf2f(x.y >> 16) * na.w + bf2f(x.z & 0xffffu) * nb2.x + bf2f(x.z >> 16) * nb2.y + bf2f(x.w & 0xffffu) * nb2.z + bf2f(x.w >> 16) * nb2.w; }
            dq += shx<32>(dq);
            const float Mrow = Mi[dir * 128 + 32 * rb + r32]; const float Brow = Bw[dir * 128 + 32 * rb + r32];
            float dsum = 0.f;
            const int jt0 = dir ? rb : 0, jt1 = dir ? 3 : rb;
            for (int jt = jt0; jt <= jt1; ++jt) {
                f32x16 pt = f32x16{};
                bf16x8 kf[8], vfr[2][2];
#pragma unroll
                for (int ks = 0; ks < 8; ++ks) kf[ks] = *(const __attribute__((address_space(3))) bf16x8*)(s3 + (2 * ks + hi) * 2048 + (32 * jt + r32) * 16);
#pragma unroll
                for (int blk = 0; blk < 2; ++blk) { vfr[blk][0] = trfrag(s3 + 32768 + (2 * vh + blk) * 8192 + (2 * jt) * 1024 + laddr); vfr[blk][1] = trfrag(s3 + 32768 + (2 * vh + blk) * 8192 + (2 * jt + 1) * 1024 + laddr); }
#pragma unroll
                for (int ks = 0; ks < 8; ++ks) pt = ML_MFMA(kf[ks], qr[ks], pt);
                const bool diag = (jt == rb);
#pragma unroll
                for (int g = 0; g < 4; ++g) { const float4 a4 = *(const float4*)(Aw + dir * 128 + 32 * jt + 8 * g + 4 * hi);
#pragma unroll
                    for (int i = 0; i < 4; ++i) { const int kl = 8 * g + 4 * hi + i; const float aa = (i == 0) ? a4.x : (i == 1) ? a4.y : (i == 2) ? a4.z : a4.w;
                        const bool ok = !diag || (dir ? (kl >= r32) : (kl <= r32));
                        const float pv = ok ? pt[4 * g + i] * (aa * Brow) : 0.f; pt[4 * g + i] = pv; dsum += pv; } }
                u32x4 pw0, pw1;
                pw0.x = pk2(pt[0], pt[1]); pw0.y = pk2(pt[2], pt[3]); pw0.z = pk2(pt[4], pt[5]); pw0.w = pk2(pt[6], pt[7]);
                pw1.x = pk2(pt[8], pt[9]); pw1.y = pk2(pt[10], pt[11]); pw1.z = pk2(pt[12], pt[13]); pw1.w = pk2(pt[14], pt[15]);
#pragma unroll
                for (int blk = 0; blk < 2; ++blk) { o[blk] = ML_MFMA(__builtin_bit_cast(bf16x8, pw0), vfr[blk][0], o[blk]); o[blk] = ML_MFMA(__builtin_bit_cast(bf16x8, pw1), vfr[blk][1], o[blk]); }
            }
            dsum += shx<32>(dsum);
            const float den = dsum + dq * ew[dir * 128 + 32 * rb + r32];
            const float mrow = sc[dir * 384 + 32 * rb + r32] + Mrow;
            const float rinv = 1.0f / fmaxf(fabsf(den), __expf(-mrow));
            asm volatile("s_waitcnt lgkmcnt(0)" ::: "memory");
            if (hi == 0) wsf[r32] = rinv;
            asm volatile("s_waitcnt lgkmcnt(0)" ::: "memory");
#pragma unroll
            for (int r = 0; r < 16; ++r) { const float rv = wsf[crow(r, hi)]; hacc[0][r] += o[0][r] * rv; hacc[1][r] += o[1][r] * rv; }
            asm volatile("s_waitcnt lgkmcnt(0)" ::: "memory");
        }
        __syncthreads();
#pragma unroll
        for (int blk = 0; blk < 2; ++blk)
#pragma unroll
            for (int r = 0; r < 16; ++r) stg[(32 * rb + crow(r, hi)) * 132 + 64 * vh + 32 * blk + r32] = hacc[blk][r];
        __syncthreads();
        { const int row = tid >> 2, q4 = tid & 3; float v[32];
#pragma unroll
          for (int q = 0; q < 8; ++q) { const float4 t = *(const float4*)(stg + row * 132 + 32 * q4 + 4 * q); v[4 * q] = t.x; v[4 * q + 1] = t.y; v[4 * q + 2] = t.z; v[4 * q + 3] = t.w; }
          float ss = 0.f;
#pragma unroll
          for (int q = 0; q < 32; ++q) ss += v[q] * v[q];
          ss += shx<1>(ss); ss += shx<2>(ss);
          const float rn = 1.0f / sqrtf(ss * (1.0f / 128.0f) + EPS);
          const bf16_t* mo = MVO + (size_t)(row0 + row) * 1024 + 512 + 128 * h + 32 * q4; bf16_t* op = HM + (size_t)(row0 + row) * 1024 + 128 * h + 32 * q4; const float* gp = mg + 128 * h + 32 * q4;
#pragma unroll
          for (int q = 0; q < 4; ++q) { float f[8]; unpack8(*(const u32x4*)(mo + 8 * q), f); u32x4 w; const float4 ga_ = gld4(gp + 8 * q), gb_ = gld4(gp + 8 * q + 4); const float gq[8] = {ga_.x, ga_.y, ga_.z, ga_.w, gb_.x, gb_.y, gb_.z, gb_.w};
              w.x = pk2(v[8 * q] * rn * gq[0] * sigmoid_f(f[0]), v[8 * q + 1] * rn * gq[1] * sigmoid_f(f[1]));
              w.y = pk2(v[8 * q + 2] * rn * gq[2] * sigmoid_f(f[2]), v[8 * q + 3] * rn * gq[3] * sigmoid_f(f[3]));
              w.z = pk2(v[8 * q + 4] * rn * gq[4] * sigmoid_f(f[4]), v[8 * q + 5] * rn * gq[5] * sigmoid_f(f[5]));
              w.w = pk2(v[8 * q + 6] * rn * gq[6] * sigmoid_f(f[6]), v[8 * q + 7] * rn * gq[7] * sigmoid_f(f[7]));
              *(u32x4*)(op + 8 * q) = w; } }
    }
}
#undef ML_MFMA
}

__device__ __forceinline__ void ph_prep(const P& p, int l, unsigned char* smem) {
    const int tid = ltid();
    const bf16_t* R1 = (const bf16_t*)(p.ws + WS_R1); bf16_t* QKC = (bf16_t*)(p.ws + WS_QKC);
    bf16_t* AQ = (bf16_t*)(p.ws + WS_AQKV);
    const int tq0 = blockIdx.x * 512 + tid, tqs = gridDim.x * 512;
    u32x4 pre_a[2], pre_b[2];
#pragma unroll
    for (int i = 0; i < 2; ++i) { const int tq = tq0 + i * tqs; pre_a[i] = (u32x4){0u, 0u, 0u, 0u}; pre_b[i] = pre_a[i];
        if (tq < M * 2 * 4) { const int task = tq >> 2, q = tq & 3, m = task >> 1, hh = 8 + (task & 1); const bf16_t* ptr = AQ + (size_t)m * 768 + 64 * hh + 16 * q; pre_a[i] = *(const u32x4*)ptr; pre_b[i] = *(const u32x4*)(ptr + 8); } }
    {
        const int c8 = (tid & 127) * 8, rg = tid >> 7;
        const float* cw = pin(p, 3) + (size_t)l * 3 * 1024 + c8; const float* cb = pin(p, 4) + (size_t)l * 1024 + c8;
        float w0[8], w1[8], w2[8], bb[8];
#pragma unroll
        for (int q = 0; q < 8; ++q) { w0[q] = cw[q]; w1[q] = cw[1024 + q]; w2[q] = cw[2048 + q]; bb[q] = cb[q]; }
        for (int rc = blockIdx.x; rc < M / 128; rc += gridDim.x) {
            const int m0 = rc * 128 + rg * 32;
            float xm[8], xc[8], xp[8];
            if ((m0 & (SEQ - 1)) > 0) unpack8(*(const u32x4*)(R1 + (size_t)(m0 - 1) * 1024 + c8), xm); else {
#pragma unroll
                for (int q = 0; q < 8; ++q) xm[q] = 0.f; }
            unpack8(*(const u32x4*)(R1 + (size_t)m0 * 1024 + c8), xc);
            u32x4 qn[4];
#pragma unroll
            for (int u = 0; u < 4; ++u) { const int mm = m0 + 1 + u; qn[u] = ((mm & (SEQ - 1)) != 0) ? *(const u32x4*)(R1 + (size_t)mm * 1024 + c8) : (u32x4){0u, 0u, 0u, 0u}; }
            for (int i = 0; i < 32; i += 4) {
#pragma unroll
                for (int u = 0; u < 4; ++u) {
                    const int m = m0 + i + u;
                    unpack8(qn[u], xp);
                    { const int mm = m + 5; qn[u] = (i + u + 5 <= 32 && (mm & (SEQ - 1)) != 0) ? *(const u32x4*)(R1 + (size_t)mm * 1024 + c8) : (u32x4){0u, 0u, 0u, 0u}; }
                    float o[8];
#pragma unroll
                    for (int q = 0; q < 8; ++q) o[q] = silu_f(w0[q] * xm[q] + w1[q] * xc[q] + w2[q] * xp[q] + bb[q]);
                    u32x4 w; w.x = pk2(o[0], o[1]); w.y = pk2(o[2], o[3]); w.z = pk2(o[4], o[5]); w.w = pk2(o[6], o[7]);
                    *(u32x4*)(QKC + (size_t)m * 1024 + c8) = w;
#pragma unroll
                    for (int q = 0; q < 8; ++q) { xm[q] = xc[q]; xc[q] = xp[q]; }
                }
            }
            asm volatile("s_waitcnt vmcnt(0)" ::: "memory");
            __syncthreads();
            ml::m1_chunk(p, l, smem, rc);
        }
    }
    const float* rope = (const float*)(p.ws + WS_ROPE);
    const float* kg = pin(p, 8) + l * 64;
    int it = 0;
    for (int tq = tq0; tq < M * 2 * 4; tq += tqs, ++it) {
        const int task = tq >> 2, q = tq & 3, m = task >> 1, hh = 8 + (task & 1);
        bf16_t* ptr = AQ + (size_t)m * 768 + 64 * hh + 16 * q;
        float v[16];
        if (it == 0) { unpack8(pre_a[0], v); unpack8(pre_b[0], v + 8); } else if (it == 1) { unpack8(pre_a[1], v); unpack8(pre_b[1], v + 8); }
        else { unpack8(*(const u32x4*)ptr, v); unpack8(*(const u32x4*)(ptr + 8), v + 8); }
        float ss = 0.f;
#pragma unroll
        for (int d = 0; d < 16; ++d) ss += v[d] * v[d];
        ss += shx<1>(ss); ss += shx<2>(ss);
        const float r = 1.0f / sqrtf(ss * (1.0f / 64.0f) + EPS);
        const int t = m & (SEQ - 1), pos = (q >> 1) ? (t & 63) : (t >> 6);
        const float2* rp = (const float2*)rope + pos * 16;
        const bool up = (q & 1) != 0;
        float kgv[16]; { const float4 k0_ = gld4(kg + 16 * q), k1_ = gld4(kg + 16 * q + 4), k2_ = gld4(kg + 16 * q + 8), k3_ = gld4(kg + 16 * q + 12);
          kgv[0] = k0_.x; kgv[1] = k0_.y; kgv[2] = k0_.z; kgv[3] = k0_.w; kgv[4] = k1_.x; kgv[5] = k1_.y; kgv[6] = k1_.z; kgv[7] = k1_.w; kgv[8] = k2_.x; kgv[9] = k2_.y; kgv[10] = k2_.z; kgv[11] = k2_.w; kgv[12] = k3_.x; kgv[13] = k3_.y; kgv[14] = k3_.z; kgv[15] = k3_.w; }
#pragma unroll
        for (int d = 0; d < 16; ++d) { const float x = v[d] * r * kgv[d]; const float o = shx<1>(x); const float2 cs = rp[d]; v[d] = x * cs.x + (up ? o : -o) * cs.y; }
        u32x4 w0, w1;
        w0.x = pk2(v[0], v[1]); w0.y = pk2(v[2], v[3]); w0.z = pk2(v[4], v[5]); w0.w = pk2(v[6], v[7]);
        w1.x = pk2(v[8], v[9]); w1.y = pk2(v[10], v[11]); w1.z = pk2(v[12], v[13]); w1.w = pk2(v[14], v[15]);
        *(u32x4*)ptr = w0; *(u32x4*)(ptr + 8) = w1;
    }
}

namespace pg8 {
#define PG8_LAS __attribute__((address_space(3)))
typedef short bf16x8 __attribute__((ext_vector_type(8)));
typedef float f32x4 __attribute__((ext_vector_type(4)));
constexpr int BM = 256, BK = 64, HALF = 128, HTB = HALF * BK * 2, STAGE_BYTES = 8 * HTB, NXCD = 8, WGM = 8;
__host__ __device__ __forceinline__ int lds_byte(int r, int c) { const int st = (r >> 4) * 2 + (c >> 5), rr = r & 15, cc = c & 31, ob = rr * 64 + cc * 2; return st * 1024 + (ob ^ (((ob >> 9) & 1) << 5)); }
__host__ __device__ __forceinline__ void stage_rc(int b, int& R, int& C) { const int st = b / 1024, sb = b % 1024, swz = sb ^ (((sb >> 9) & 1) << 5); R = (st >> 1) * 16 + swz / 64; C = (st & 1) * 32 + (swz % 64) / 2; }
__host__ __device__ __forceinline__ int perm32(int rho) { const int n = rho >> 4, i = rho & 15; return 8 * (i >> 2) + 4 * n + (i & 3); }
struct Unit { int pm, pn, e; };
struct Gemm { const bf16_t* A; const bf16_t* Bt; int K; size_t bstride; const int* rowtok; };
struct StaticOrder {
    int nM, nN, nwg, G, c;
    __device__ void init(int M_, int N_, int G_, int c_) { nM = M_ / BM; nN = N_ / BM; nwg = nM * nN; G = G_; c = c_; }
    __device__ bool next(int i, Unit& u) const {
        const long L = (long)i * G + c; if (L >= nwg) return false;
        int wgid = (int)L; { const int q = nwg / NXCD, r = nwg % NXCD, xcd = wgid % NXCD, off = wgid / NXCD; wgid = (xcd < r ? xcd * (q + 1) : r * (q + 1) + (xcd - r) * q) + off; }
        const int nig = WGM * nN, gid = wgid / nig, fm = gid * WGM, gsz = (nM - fm) < WGM ? (nM - fm) : WGM;
        u.pm = fm + ((wgid % nig) % gsz); u.pn = (wgid % nig) / gsz; u.e = 0; return true;
    }
};
struct MoeOrder {
    const PG8_LAS int* ps; int G, c;
    __device__ bool next(int i, Unit& u) const {
        const int L = i * G + c, mt = L >> 2, s0 = mt * 256;
        const int total = __builtin_amdgcn_readfirstlane(ps[32]);
        if (s0 >= total) return false;
        int e = 0;
#pragma unroll
        for (int q = 1; q < 32; ++q) e += (s0 >= ps[q]) ? 1 : 0;
        u.pm = mt; u.pn = L & 3; u.e = __builtin_amdgcn_readfirstlane(e); return true;
    }
};
__device__ __forceinline__ unsigned cvt_pk_bf16(float lo, float hi) { unsigned r; asm volatile("v_cvt_pk_bf16_f32 %0, %1, %2" : "=v"(r) : "v"(lo), "v"(hi)); return r; }

struct EpiInproj {
    static constexpr bool PERM = true;
    bf16_t* R1; bf16_t* MVO; bf16_t* AQKV;
    __device__ __forceinline__ void operator()(const f32x4 (&acc)[2][2][4][2], const Unit& u, int wr, int wc, int fr, int fq) const {
        bf16_t* base; int ldc, colt;
        if (u.pn < 4) { base = R1; ldc = 1024; colt = u.pn * 256; } else if (u.pn < 8) { base = MVO; ldc = 1024; colt = (u.pn - 4) * 256; } else { base = AQKV; ldc = 768; colt = (u.pn - 8) * 256; }
        const int row0 = u.pm * BM + wr * 64 + fr, col0 = colt + wc * 32 + 8 * fq;
#pragma unroll
        for (int ai = 0; ai < 2; ++ai)
#pragma unroll
            for (int m = 0; m < 4; ++m) { bf16_t* rowp = base + (size_t)(row0 + ai * HALF + m * 16) * ldc + col0;
#pragma unroll
                for (int bj = 0; bj < 2; ++bj) { const f32x4 v0 = acc[ai][bj][m][0], v1 = acc[ai][bj][m][1];
                    u32x4 w; w.x = cvt_pk_bf16(v0[0], v0[1]); w.y = cvt_pk_bf16(v0[2], v0[3]); w.z = cvt_pk_bf16(v1[0], v1[1]); w.w = cvt_pk_bf16(v1[2], v1[3]);
                    *(u32x4*)(rowp + bj * HALF) = w; } }
    }
};
struct EpiOutproj {
    static constexpr bool PERM = true;
    const bf16_t* xres; bf16_t* out;
    __device__ __forceinline__ void operator()(const f32x4 (&acc)[2][2][4][2], const Unit& u, int wr, int wc, int fr, int fq) const {
        const int row0 = u.pm * BM + wr * 64 + fr, col0 = u.pn * BM + wc * 32 + 8 * fq;
        u32x4 rb[2][4][2];
#pragma unroll
        for (int ai = 0; ai < 2; ++ai)
#pragma unroll
            for (int m = 0; m < 4; ++m) { const size_t off = (size_t)(row0 + ai * HALF + m * 16) * 1024 + col0;
#pragma unroll
                for (int bj = 0; bj < 2; ++bj) rb[ai][m][bj] = *(const u32x4*)(xres + off + bj * HALF); }
        asm volatile("" ::: "memory");
#pragma unroll
        for (int ai = 0; ai < 2; ++ai)
#pragma unroll
            for (int m = 0; m < 4; ++m) { const size_t off = (size_t)(row0 + ai * HALF + m * 16) * 1024 + col0;
#pragma unroll
                for (int bj = 0; bj < 2; ++bj) { const f32x4 v0 = acc[ai][bj][m][0], v1 = acc[ai][bj][m][1]; const u32x4 r = rb[ai][m][bj];
                    u32x4 w; w.x = cvt_pk_bf16(v0[0] + __uint_as_float(r.x << 16), v0[1] + __uint_as_float(r.x & 0xffff0000u)); w.y = cvt_pk_bf16(v0[2] + __uint_as_float(r.y << 16), v0[3] + __uint_as_float(r.y & 0xffff0000u));
                    w.z = cvt_pk_bf16(v1[0] + __uint_as_float(r.z << 16), v1[1] + __uint_as_float(r.z & 0xffff0000u)); w.w = cvt_pk_bf16(v1[2] + __uint_as_float(r.w << 16), v1[3] + __uint_as_float(r.w & 0xffff0000u));
                    *(u32x4*)(out + off + bj * HALF) = w; } }
    }
};
struct EpiMoe1 {
    static constexpr bool PERM = true;
    bf16_t* HID;
    __device__ __forceinline__ void operator()(const f32x4 (&acc)[2][2][4][2], const Unit& u, int wr, int wc, int fr, int fq) const {
        const int row0 = u.pm * BM + wr * 64 + fr, hc0 = (u.pn * BM + wc * 32 + 8 * fq) >> 1;
#pragma unroll
        for (int ai = 0; ai < 2; ++ai)
#pragma unroll
            for (int m = 0; m < 4; ++m) { bf16_t* rowp = HID + (size_t)(row0 + ai * HALF + m * 16) * 512 + hc0;
#pragma unroll
                for (int bj = 0; bj < 2; ++bj) { const f32x4 a = acc[ai][bj][m][0], b = acc[ai][bj][m][1];
                    u32x2 w; w.x = cvt_pk_bf16(silu_f(a[0]) * b[0], silu_f(a[1]) * b[1]); w.y = cvt_pk_bf16(silu_f(a[2]) * b[2], silu_f(a[3]) * b[3]);
                    *(u32x2*)(rowp + bj * 64) = w; } }
    }
};
struct EpiMoe2 {
    static constexpr bool PERM = true;
    bf16_t* Y; const int* slot_tok; const float* slot_w;
    __device__ __forceinline__ void operator()(const f32x4 (&acc)[2][2][4][2], const Unit& u, int wr, int wc, int fr, int fq) const {
        const int row0 = u.pm * BM + wr * 64 + fr, col0 = u.pn * BM + wc * 32 + 8 * fq;
        int aid[8]; float tw[8];
#pragma unroll
        for (int q = 0; q < 8; ++q) aid[q] = slot_tok[row0 + (q >> 2) * HALF + (q & 3) * 16];
#pragma unroll
        for (int q = 0; q < 8; ++q) tw[q] = slot_w[row0 + (q >> 2) * HALF + (q & 3) * 16];
#pragma unroll
        for (int ai = 0; ai < 2; ++ai)
#pragma unroll
            for (int m = 0; m < 4; ++m) { const int a = aid[ai * 4 + m];
                if (a >= 0) { const float t = tw[ai * 4 + m]; bf16_t* rowp = Y + (size_t)a * 1024 + col0;
#pragma unroll
                    for (int bj = 0; bj < 2; ++bj) { const f32x4 v0 = acc[ai][bj][m][0] * t, v1 = acc[ai][bj][m][1] * t;
                        u32x4 w; w.x = cvt_pk_bf16(v0[0], v0[1]); w.y = cvt_pk_bf16(v0[2], v0[3]); w.z = cvt_pk_bf16(v1[0], v1[1]); w.w = cvt_pk_bf16(v1[2], v1[3]);
                        *(u32x4*)(rowp + bj * HALF) = w; } } }
    }
};

template <class Epi, class Sched, bool GATHER>
__device__ __forceinline__ void gemm_phase(PG8_LAS unsigned char* lds, const Gemm g, const Sched& S, const Epi& E) {
    const int tid = ltid(), wid = __builtin_amdgcn_readfirstlane(tid >> 6), lane = tid & 63, wr = wid >> 2, wc = wid & 3, fr = lane & 15, fq = lane >> 4;
    const int K = g.K, nt = K / BK;
    unsigned voffA[2], voffB[2]; int RA[2]; unsigned CA2[2];
#pragma unroll
    for (int i = 0; i < 2; ++i) { int R, C; stage_rc(tid * 16 + i * 8192, R, C); const int Rb = Epi::PERM ? ((R & ~31) + perm32(R & 31)) : R;
        voffA[i] = (unsigned)(R * K + C) * 2u; voffB[i] = (unsigned)(Rb * K + C) * 2u; RA[i] = R; CA2[i] = (unsigned)C * 2u; }
    const size_t kstep = (size_t)(BK * 2);
    const size_t hstep = (size_t)HALF * K * 2;
    const size_t tstep = 2 * hstep;
    const unsigned ldsw = (unsigned)wid * 1024u;
    const int aoff = lds_byte(wr * 64 + fr, fq * 8), boff = lds_byte(wc * 32 + fr, fq * 8);
#define PG8_SA(b, h) (((b) * 2 + (h)) * HTB)
#define PG8_SB(b, h) ((4 + (b) * 2 + (h)) * HTB)
#define PG8_STAGE(bufoff, gbase, voff) do { _Pragma("unroll") for (int _i = 0; _i < 2; ++_i) \
        __builtin_amdgcn_global_load_lds((const unsigned*)((const char*)(gbase) + (voff)[_i]), (PG8_LAS unsigned*)(lds + (bufoff) + ldsw + _i * 8192), 16, 0, 0); } while (0)
#define PG8_STAGE_A(bufoff, ptr, h, V0, V1) do { if constexpr (GATHER) { if (h) PG8_STAGE(bufoff, ptr, V1); else PG8_STAGE(bufoff, ptr, V0); } else { PG8_STAGE(bufoff, (ptr) + (h) * hstep, voffA); } } while (0)
#define PG8_LDA(dst, b, h) do { _Pragma("unroll") for (int m = 0; m < 4; ++m) _Pragma("unroll") for (int k = 0; k < 2; ++k) dst[m][k] = *(const PG8_LAS bf16x8*)(lds + PG8_SA(b, h) + aoff + m * 2048 + k * 1024); } while (0)
#define PG8_LDB(dst, b, h) do { _Pragma("unroll") for (int n = 0; n < 2; ++n) _Pragma("unroll") for (int k = 0; k < 2; ++k) dst[n][k] = *(const PG8_LAS bf16x8*)(lds + PG8_SB(b, h) + boff + n * 2048 + k * 1024); } while (0)
#define PG8_MMA(ai, bj, At, Bt) do { __builtin_amdgcn_s_setprio(1); _Pragma("unroll") for (int m = 0; m < 4; ++m) _Pragma("unroll") for (int n = 0; n < 2; ++n) _Pragma("unroll") for (int k = 0; k < 2; ++k) \
        acc[ai][bj][m][n] = __builtin_amdgcn_mfma_f32_16x16x32_bf16(Bt[n][k], At[m][k], acc[ai][bj][m][n], 0, 0, 0); __builtin_amdgcn_s_setprio(0); } while (0)
#define PG8_WAIT_V(n) asm volatile("s_waitcnt vmcnt(" #n ")" ::: "memory")
#define PG8_WAIT_L(n) asm volatile("s_waitcnt lgkmcnt(" #n ")" ::: "memory")
#define PG8_BAR __builtin_amdgcn_s_barrier()
#define PG8_SCHED __builtin_amdgcn_sched_barrier(0)
#define PG8_GOFF(D0, D1, U) do { _Pragma("unroll") for (int _i = 0; _i < 2; ++_i) { const int _s = (U).pm * BM + RA[_i]; const int _a0 = g.rowtok[_s], _a1 = g.rowtok[_s + HALF]; \
        D0[_i] = (unsigned)((_a0 >= 0 ? (_a0 >> 1) : 0) * K) * 2u + CA2[_i]; D1[_i] = (unsigned)((_a1 >= 0 ? (_a1 >> 1) : 0) * K) * 2u + CA2[_i]; } } while (0)
    Unit cur, nxt; int ui = 0;
    if (!S.next(0, cur)) return;
    unsigned vc0[2] = {0u, 0u}, vc1[2] = {0u, 0u}, vn0[2] = {0u, 0u}, vn1[2] = {0u, 0u};
    if constexpr (GATHER) PG8_GOFF(vc0, vc1, cur);
    f32x4 acc[2][2][4][2];
#pragma unroll
    for (int a = 0; a < 2; ++a)
#pragma unroll
        for (int b = 0; b < 2; ++b)
#pragma unroll
            for (int m = 0; m < 4; ++m)
#pragma unroll
                for (int n = 0; n < 2; ++n) acc[a][b][m][n] = (f32x4){0.f, 0.f, 0.f, 0.f};
    bf16x8 At[4][2], B0[2][2], B1[2][2];
    const char* cA = GATHER ? (const char*)g.A : (const char*)g.A + (size_t)cur.pm * tstep;
    const char* cB = (const char*)g.Bt + (size_t)cur.e * g.bstride + (size_t)cur.pn * tstep;
    PG8_STAGE(PG8_SB(0, 0), cB, voffB); PG8_STAGE(PG8_SB(0, 1), cB + hstep, voffB); PG8_STAGE_A(PG8_SA(0, 0), cA, 0, vc0, vc1); PG8_STAGE_A(PG8_SA(0, 1), cA, 1, vc0, vc1);
    if (wr == 1) PG8_BAR;
    PG8_WAIT_V(2); PG8_BAR;
    PG8_STAGE(PG8_SB(1, 0), cB + kstep, voffB); PG8_STAGE_A(PG8_SA(1, 0), cA + kstep, 0, vc0, vc1); PG8_STAGE(PG8_SB(1, 1), cB + hstep + kstep, voffB);
    PG8_WAIT_V(6); PG8_BAR;
    for (;;) {
        const bool has_next = S.next(ui + 1, nxt);
        if constexpr (GATHER) { if (has_next) PG8_GOFF(vn0, vn1, nxt); else { vn0[0] = vc0[0]; vn0[1] = vc0[1]; vn1[0] = vc1[0]; vn1[1] = vc1[1]; } }
        const char* nA = GATHER ? (const char*)g.A : (has_next ? (const char*)g.A + (size_t)nxt.pm * tstep : cA);
        const char* nB = has_next ? (const char*)g.Bt + (size_t)nxt.e * g.bstride + (size_t)nxt.pn * tstep : cB;
        for (int t = 0; t < nt; t += 2) {
            const bool last = (t == nt - 2);
            const char* a1 = cA + (size_t)(t + 1) * kstep;
            const char* a2 = last ? nA : cA + (size_t)(t + 2) * kstep; const char* b2 = last ? nB : cB + (size_t)(t + 2) * kstep;
            const char* a3 = a2 + kstep; const char* b3 = b2 + kstep;
            unsigned w0[2], w1[2];
            w0[0] = vc0[0]; w0[1] = vc0[1]; w1[0] = vc1[0]; w1[1] = vc1[1];
            if constexpr (GATHER) { if (last) {
                asm volatile("" : "+v"(vn0[0]), "+v"(vn0[1]), "+v"(vn1[0]), "+v"(vn1[1]));
                w0[0] = vn0[0]; w0[1] = vn0[1]; w1[0] = vn1[0]; w1[1] = vn1[1]; } }
            PG8_LDB(B0, 0, 0); PG8_LDB(B1, 0, 1); PG8_SCHED; PG8_LDA(At, 0, 0); PG8_STAGE_A(PG8_SA(1, 1), a1, 1, vc0, vc1);
            PG8_WAIT_V(8); PG8_WAIT_L(0); PG8_BAR; PG8_MMA(0, 0, At, B0); PG8_MMA(0, 1, At, B1); PG8_BAR; PG8_SCHED;
            PG8_LDA(At, 0, 1); PG8_STAGE(PG8_SB(0, 0), b2, voffB); PG8_STAGE(PG8_SB(0, 1), b2 + hstep, voffB); PG8_STAGE_A(PG8_SA(0, 0), a2, 0, w0, w1);
            PG8_WAIT_V(8); PG8_WAIT_L(0); PG8_BAR; PG8_MMA(1, 0, At, B0); PG8_MMA(1, 1, At, B1); PG8_BAR; PG8_SCHED;
            PG8_LDB(B0, 1, 0); PG8_LDB(B1, 1, 1); PG8_SCHED; PG8_LDA(At, 1, 0); PG8_STAGE_A(PG8_SA(0, 1), a2, 1, w0, w1);
            PG8_WAIT_V(8); PG8_WAIT_L(0); PG8_BAR; PG8_MMA(0, 0, At, B0); PG8_MMA(0, 1, At, B1); PG8_BAR; PG8_SCHED;
            PG8_LDA(At, 1, 1); PG8_STAGE(PG8_SB(1, 0), b3, voffB); PG8_STAGE(PG8_SB(1, 1), b3 + hstep, voffB); PG8_STAGE_A(PG8_SA(1, 0), a3, 0, w0, w1);
            PG8_WAIT_V(8); PG8_WAIT_L(0); PG8_BAR; PG8_MMA(1, 0, At, B0); PG8_MMA(1, 1, At, B1); PG8_BAR; PG8_SCHED;
        }
        if (wr == 0) PG8_BAR;
        E(acc, cur, wr, wc, fr, fq);
        if (!has_next) break;
#pragma unroll
        for (int a = 0; a < 2; ++a)
#pragma unroll
            for (int b = 0; b < 2; ++b)
#pragma unroll
                for (int m = 0; m < 4; ++m)
#pragma unroll
                    for (int n = 0; n < 2; ++n) acc[a][b][m][n] = (f32x4){0.f, 0.f, 0.f, 0.f};
        cur = nxt; cA = nA; cB = nB; ++ui;
        if constexpr (GATHER) { vc0[0] = vn0[0]; vc0[1] = vn0[1]; vc1[0] = vn1[0]; vc1[1] = vn1[1]; }
        if (wr == 1) PG8_BAR;
    }
    PG8_WAIT_V(0);
    PG8_BAR;
#undef PG8_SA
#undef PG8_SB
#undef PG8_STAGE
#undef PG8_STAGE_A
#undef PG8_LDA
#undef PG8_LDB
#undef PG8_MMA
#undef PG8_WAIT_V
#undef PG8_WAIT_L
#undef PG8_BAR
#undef PG8_SCHED
#undef PG8_GOFF
}
}

template <int EPI> __device__ __forceinline__ void ph_gemm_mfma(const P& p, int l, unsigned char* smem) {
    PG8_LAS unsigned char* lds = (PG8_LAS unsigned char*)smem;
    const int G = gridDim.x, bx = blockIdx.x;
    if (EPI == EPI_INPROJ) {
        pg8::Gemm g{(const bf16_t*)(p.ws + WS_XN), (const bf16_t*)(p.ws + WS_WIN) + (size_t)l * NWIN * 1024, 1024, 0, nullptr};
        pg8::StaticOrder S; S.init(M, NWIN, G, bx);
        pg8::EpiInproj E{(bf16_t*)(p.ws + WS_R1), (bf16_t*)(p.ws + WS_MVO), (bf16_t*)(p.ws + WS_AQKV)};
        pg8::gemm_phase<pg8::EpiInproj, pg8::StaticOrder, false>(lds, g, S, E);
    } else if (EPI == EPI_OUTPROJ) {
        pg8::Gemm g{(const bf16_t*)(p.ws + WS_R1), (const bf16_t*)(p.ws + WS_WOUT) + (size_t)l * 1024 * 1024, 1024, 0, nullptr};
        pg8::StaticOrder S; S.init(M, 1024, G, bx);
        pg8::EpiOutproj E{(const bf16_t*)p.out, (bf16_t*)(p.ws + WS_XB)};
        pg8::gemm_phase<pg8::EpiOutproj, pg8::StaticOrder, false>(lds, g, S, E);
    } else {
        PG8_LAS int* ps = (PG8_LAS int*)(lds + LDS_MISC);
        if (ltid() == 0) { const unsigned* cnt = (const unsigned*)(p.ws + WS_CTL) + CW_CNT + l * 32; int acc = 0; for (int e = 0; e < 32; ++e) { ps[e] = acc; acc += ((int)cnt[e] + 255) & ~255; } ps[32] = acc; }
        __syncthreads();
        const int vcu = (G % 8 == 0) ? (bx % 8) * (G / 8) + bx / 8 : bx;
        pg8::MoeOrder S{ps, G, vcu};
        if (EPI == EPI_MOE1) {
            pg8::Gemm g{(const bf16_t*)(p.ws + WS_XN), (const bf16_t*)(p.ws + WS_W13), 1024, (size_t)1024 * 1024 * 2, (const int*)(p.ws + WS_SLOT)};
            pg8::EpiMoe1 E{(bf16_t*)(p.ws + WS_HID)};
            pg8::gemm_phase<pg8::EpiMoe1, pg8::MoeOrder, true>(lds, g, S, E);
        } else {
            pg8::Gemm g{(const bf16_t*)(p.ws + WS_HID), (const bf16_t*)(p.ws + WS_W2), 512, (size_t)1024 * 512 * 2, nullptr};
            pg8::EpiMoe2 E{(bf16_t*)(p.ws + WS_Y), (const int*)(p.ws + WS_SLOT), (const float*)(p.ws + WS_SLOTW)};
            pg8::gemm_phase<pg8::EpiMoe2, pg8::MoeOrder, false>(lds, g, S, E);
        }
    }
}


#define LAS __attribute__((address_space(3)))
constexpr int CW_BAR = 4096;
#define XB_TMO      128
#define XB_XCNT(j)  (256  + 64 * (j))
#define XB_XSUB(j)  (1280 + 64 * (j))
#define XB_XGEN(j)  (2304 + 64 * (j))
#define XB_TOP      3328
#define XB_TOPGEN   3392
#define XCD_BAR_WORDS 3456
#define XB_SPIN_CAP (1u << 18)

__device__ __forceinline__ unsigned xb_ld(unsigned* p)              { return __hip_atomic_load(p, __ATOMIC_RELAXED, __HIP_MEMORY_SCOPE_AGENT); }
__device__ __forceinline__ unsigned xb_add(unsigned* p, unsigned v) { return __hip_atomic_fetch_add(p, v, __ATOMIC_RELAXED, __HIP_MEMORY_SCOPE_AGENT); }
__device__ __forceinline__ unsigned xb_xcc_id() { return (unsigned)__builtin_amdgcn_s_getreg((3 << 11) | 20) & 0xFu; }
#define XB_SPIN(cond, bar) do { unsigned _sp = 0; while (cond) { __builtin_amdgcn_s_sleep(1); \
    if ((++_sp & 255u) == 0u) { if (xb_ld(&(bar)[XB_TMO])) break; if (_sp > XB_SPIN_CAP) { atomicAdd(&(bar)[XB_TMO], 1u); break; } } } } while (0)

struct XcdBarrier {
    unsigned* bar; unsigned x;
    volatile LAS unsigned* st;
};

__device__ __forceinline__ XcdBarrier xcd_barrier_post(unsigned* bar, volatile LAS unsigned* st) {
    XcdBarrier b; b.bar = bar; b.x = xb_xcc_id(); b.st = st;
    if (threadIdx.x == 0) (void)xb_add(&bar[XB_XCNT(b.x)], 1u);
    return b;
}
__device__ __forceinline__ void xcd_barrier_complete(unsigned* bar, unsigned x, unsigned& nloc, unsigned& nx) {
    const unsigned G = gridDim.x * gridDim.y * gridDim.z;
    unsigned sum, cnt, mine, sp = 0u;
    for (;;) {
        sum = 0u; cnt = 0u; mine = 0u;
#pragma unroll
        for (unsigned j = 0; j < 16; ++j) { const unsigned c = xb_ld(&bar[XB_XCNT(j)]); sum += c; cnt += (c > 0u) ? 1u : 0u; mine = (j == x) ? c : mine; }
        if (sum == G) break;
        __builtin_amdgcn_s_sleep(1);
        if ((++sp & 255u) == 0u) { if (xb_ld(&bar[XB_TMO])) break; if (sp > XB_SPIN_CAP) { atomicAdd(&bar[XB_TMO], 1u); break; } }
    }
    nloc = mine > 0u ? mine : 1u; nx = cnt > 0u ? cnt : 1u;
}

__device__ __forceinline__ void xcd_barrier(const XcdBarrier& b) {
    asm volatile("s_waitcnt vmcnt(0)" ::: "memory");
    __syncthreads();
    if (threadIdx.x == 0) {
        unsigned* bar = b.bar;
        __builtin_amdgcn_s_waitcnt(0);
        unsigned nloc = b.st[0], nx = b.st[1];
        if (nloc == 0u) { xcd_barrier_complete(bar, b.x, nloc, nx); b.st[0] = nloc; b.st[1] = nx; }
        const unsigned old = xb_add(&bar[XB_XSUB(b.x)], 1u);
        const unsigned gen = old / nloc;
        if (old + 1u == (gen + 1u) * nloc) {
            __builtin_amdgcn_fence(__ATOMIC_RELEASE, "agent");
            asm volatile("s_waitcnt vmcnt(0)" ::: "memory");
            const unsigned og = xb_add(&bar[XB_TOP], 1u);
            const unsigned tg = og / nx;
            if (og + 1u == (tg + 1u) * nx) xb_add(&bar[XB_TOPGEN], 1u);
            else XB_SPIN(xb_ld(&bar[XB_TOPGEN]) == tg, bar);
            __builtin_amdgcn_fence(__ATOMIC_ACQUIRE, "agent");
            xb_add(&bar[XB_XGEN(b.x)], 1u);
            asm volatile("s_waitcnt vmcnt(0)" ::: "memory");
        } else {
            XB_SPIN(xb_ld(&bar[XB_XGEN(b.x)]) == gen, bar);
            __builtin_amdgcn_fence(__ATOMIC_ACQUIRE, "agent");
            asm volatile("s_waitcnt vmcnt(0)" ::: "memory");
        }
    }
    __syncthreads();
}

namespace cg = cooperative_groups;
#ifndef REP_KIND
#define REP_KIND -1
#define REP_L 0
#define REP_N 0
#endif
#ifndef MFMA_MLSTM
#define MFMA_MLSTM 1
#endif
#ifndef MFMA_ATTN
#define MFMA_ATTN 1
#endif
#ifndef MFMA_INPROJ
#define MFMA_INPROJ 1
#endif
#ifndef MFMA_OUTPROJ
#define MFMA_OUTPROJ 1
#endif
#ifndef MFMA_MOE1
#define MFMA_MOE1 1
#endif
#ifndef MFMA_MOE2
#define MFMA_MOE2 1
#endif
constexpr int LDS_BYTES = 163840;
enum { PH_ROW1 = 0, PH_INPROJ, PH_PREP, PH_M2, PH_MIX, PH_OUTPROJ, PH_ROW2, PH_SCATTER, PH_MOE1, PH_MOE2, PH_ROW3 };
constexpr int NPL = 10, NPHASE = 2 * NPL + 1;
__device__ __forceinline__ void phase_decode(int ph, int& kind, int& l) {
    if (ph == NPHASE - 1) { kind = PH_ROW3; l = 0; } else { l = ph / NPL; kind = ph % NPL; }
}
struct Args { const float* in[19]; float* out; unsigned char* ws; int ph_lo, ph_hi; };
__global__ void __launch_bounds__(512) k_mega(Args a) {
    extern __shared__ __attribute__((aligned(16))) unsigned char smem[];
    cg::grid_group grid = cg::this_grid();
    volatile LAS unsigned* xst = (volatile LAS unsigned*)((LAS unsigned char*)smem + LDS_BYTES - 64);
    if (threadIdx.x < 2) xst[threadIdx.x] = 0u;
    if (threadIdx.x == 0) {
#pragma unroll
        for (int i = 0; i < 19; ++i) ((unsigned long long*)(smem + LDS_PTAB))[i] = (unsigned long long)a.in[i];
    }
    __syncthreads();
    if (blockIdx.x == 0) { unsigned* c = (unsigned*)(a.ws + WS_CTL);
#pragma unroll 4
        for (int i = threadIdx.x; i < 16384; i += 512) c[i] = 0u; }
    XcdBarrier xbar; xbar.bar = nullptr; xbar.x = 0u; xbar.st = xst;
    for (int ph = a.ph_lo; ph < a.ph_hi; ++ph) {
        int kind, l; phase_decode(ph, kind, l);
        int nrep = (kind == REP_KIND && l == REP_L) ? 1 + REP_N : 1;
        for (int rep = 0; rep < nrep; ++rep) {
        unsigned z; asm volatile("s_mov_b32 %0, 0" : "=s"(z));
        P p; p.out = a.out + z; p.ws = a.ws + z; p.tab = smem + LDS_PTAB;
        switch (kind) {
        case PH_ROW1:
            if (l == 0) {
                ph_prep_small(p); ph_router_image(p);
                for (int ll = 0; ll < 2; ++ll) { ph_transpose<0>(p, ll, smem); ph_transpose<1>(p, ll, smem); }
                __syncthreads();
                rowpass<1, false>(p, l, gridDim.x, blockIdx.x, smem);
            } else { rowpass<1, true>(p, l, gridDim.x, blockIdx.x, smem, rep + 1 == nrep); }
            break;
        case PH_INPROJ: ph_gemm_mfma<EPI_INPROJ>(p, l, smem); break;
        case PH_PREP: ph_prep(p, l, smem); break;
        case PH_M2: ml::ph_m2(p, l, smem); break;
        case PH_MIX: ml::ph_m3(p, l, smem); __syncthreads(); ph_attn_mfma(p, l, smem); break;
        case PH_OUTPROJ: ph_gemm_mfma<EPI_OUTPROJ>(p, l, smem); break;
        case PH_ROW2: ph_row2_mfma(p, l, smem, rep + 1 == nrep); break;
        case PH_SCATTER: ph_scatter(p, l, smem); break;
        case PH_MOE1: ph_gemm_mfma<EPI_MOE1>(p, l, smem); break;
        case PH_MOE2: ph_gemm_mfma<EPI_MOE2>(p, l, smem); break;
        case PH_ROW3: rowpass<3, true>(p, l, gridDim.x, blockIdx.x, smem, rep + 1 == nrep); break;
        }
        if (rep + 1 < nrep) __syncthreads();
        }
        if (ph + 1 < a.ph_hi) { if (ph == a.ph_lo) { grid.sync(); xbar = xcd_barrier_post((unsigned*)(a.ws + WS_CTL) + CW_BAR, xst); } else xcd_barrier(xbar); }
    }
}

extern "C" void kernel_launch(void* const* d_in, const int* in_sizes, int n_in, void* d_out, int out_size, void* d_ws, size_t ws_size, hipStream_t stream) {
    static int grid = 0;
    if (grid == 0) {
        if (n_in != 19 || ws_size < WS_END) { fprintf(stderr, "kernel_launch: unexpected n_in %d / ws_size %zu\n", n_in, ws_size); grid = -1; return; }
        int dev = 0, cus = 0, per_cu = 0;
        (void)hipGetDevice(&dev); (void)hipDeviceGetAttribute(&cus, hipDeviceAttributeMultiprocessorCount, dev);
        if (hipFuncSetAttribute((const void*)k_mega, hipFuncAttributeMaxDynamicSharedMemorySize, LDS_BYTES) != hipSuccess) { fprintf(stderr, "kernel_launch: hipFuncSetAttribute failed\n"); grid = -1; return; }
        if (hipOccupancyMaxActiveBlocksPerMultiprocessor(&per_cu, (const void*)k_mega, 512, LDS_BYTES) != hipSuccess || per_cu < 1) { fprintf(stderr, "kernel_launch: occupancy query failed (%d)\n", per_cu); grid = -1; return; }
        grid = cus * per_cu;
        fprintf(stderr, "kernel_launch: cus %d per_cu %d grid %d ws %zu\n", cus, per_cu, grid, ws_size);
    }
    if (grid < 0) return;
    Args a{};
    for (int i = 0; i < 19; ++i) a.in[i] = (const float*)d_in[i];
    a.out = (float*)d_out; a.ws = (unsigned char*)d_ws;
    a.ph_lo = 0; a.ph_hi = NPHASE;
    void* args[] = {&a};
    hipError_t e = hipLaunchCooperativeKernel((const void*)k_mega, dim3(grid), dim3(512), args, LDS_BYTES, stream);
    if (e != hipSuccess) fprintf(stderr, "kernel_launch: cooperative launch failed: %s (grid %d)\n", hipGetErrorString(e), grid);
}
```

```cpp
#include <hip/hip_runtime.h>
#include <hip/hip_cooperative_groups.h>
#include <cstdint>
#include <cstdio>

typedef unsigned short bf16_t;
typedef unsigned u32x4 __attribute__((ext_vector_type(4)));
typedef unsigned u32x2 __attribute__((ext_vector_type(2)));

constexpr int NB = 4, SEQ = 8192, M = NB * SEQ, D = 1024;
constexpr int NWIN = 2816;
constexpr int PIN_ = 2832;
constexpr int NSLOT = 2 * M + 32 * 256;
constexpr float EPS = 1e-6f;
constexpr float QSCALE = 0.125f * 1.4426950408889634f;

constexpr size_t MiB = 1u << 20;
constexpr size_t WS_CTL = 0;
constexpr size_t WS_WIN = 1 * MiB;
constexpr size_t WS_WOUT = 12 * MiB;
constexpr size_t WS_ROPE = 17 * MiB;
constexpr size_t WS_GATES = 18 * MiB;
constexpr size_t WS_TOPE = 20 * MiB;
constexpr size_t WS_TOPW = 20 * MiB + 256 * 1024;
constexpr size_t WS_SLOT = 20 * MiB + 512 * 1024;
constexpr size_t WS_SLOTW = 21 * MiB;
constexpr size_t WS_W13 = 22 * MiB;
constexpr size_t WS_W2 = 86 * MiB;
constexpr size_t WS_XN = 118 * MiB;
constexpr size_t WS_R1 = 182 * MiB;
constexpr size_t WS_QKC = 246 * MiB;
constexpr size_t WS_MVO = 310 * MiB;
constexpr size_t WS_AQKV = 374 * MiB;
constexpr size_t WS_CST = 422 * MiB;
constexpr size_t WS_HID = 246 * MiB;
constexpr size_t WS_Y = 318 * MiB;
constexpr size_t WS_XB = 446 * MiB;
constexpr size_t WS_RIMG = 510 * MiB;
constexpr size_t WS_END = 511 * MiB;
constexpr int CW_CNT = 1024;
constexpr int CW_FILL = 1024 + 64;

struct P {
    float* out;
    unsigned char* ws;
    const unsigned char* tab;
};
__device__ __forceinline__ const float* pin(const P& p, int k) {
    const u32x2 v = *(const u32x2*)(p.tab + 8 * k);
    const unsigned lo = (unsigned)__builtin_amdgcn_readfirstlane((int)v.x), hi = (unsigned)__builtin_amdgcn_readfirstlane((int)v.y);
    return (const float*)(((unsigned long long)hi << 32) | lo);
}

typedef float f4g_t __attribute__((ext_vector_type(4)));
__device__ __forceinline__ float4 gld4(const float* p) { const f4g_t t = *(const __attribute__((address_space(1))) f4g_t*)p; return float4{t[0], t[1], t[2], t[3]}; }
__device__ __forceinline__ float gld1(const float* p) { return *(const __attribute__((address_space(1))) float*)p; }

__device__ __forceinline__ int ltid() { int t = threadIdx.x; asm volatile("" : "+v"(t)); return t; }
__device__ __forceinline__ float bf2f(unsigned v) { return __uint_as_float(v << 16); }
__device__ __forceinline__ unsigned f2bf(float f) { unsigned u = __float_as_uint(f); return (u + 0x7fffu + ((u >> 16) & 1u)) >> 16; }
typedef float pk_f32x2 __attribute__((ext_vector_type(2))); typedef __bf16 pk_bf16x2 __attribute__((ext_vector_type(2)));
__device__ __forceinline__ unsigned pk2(float lo, float hi) { const pk_f32x2 v = {lo, hi}; return __builtin_bit_cast(unsigned, __builtin_convertvector(v, pk_bf16x2)); }
template <int MASK> __device__ __forceinline__ float shx(float x) {
    if constexpr (MASK == 32) { const auto rr = __builtin_amdgcn_permlane32_swap(__float_as_uint(x), __float_as_uint(x), false, false);
        const unsigned a = rr[0], b = rr[1]; return __uint_as_float(a ^ b ^ __float_as_uint(x)); }
    else if constexpr (MASK == 1) return __uint_as_float((unsigned)__builtin_amdgcn_mov_dpp((int)__float_as_uint(x), 0xB1, 0xF, 0xF, true));
    else if constexpr (MASK == 2) return __uint_as_float((unsigned)__builtin_amdgcn_mov_dpp((int)__float_as_uint(x), 0x4E, 0xF, 0xF, true));
    else return __uint_as_float((unsigned)__builtin_amdgcn_ds_swizzle((int)__float_as_uint(x), (MASK << 10) | 0x1f));
}
__device__ __forceinline__ float wave_sum(float v) {
    v += shx<1>(v); v += shx<2>(v); v += shx<4>(v); v += shx<8>(v); v += shx<16>(v); v += shx<32>(v);
    return v;
}
__device__ __forceinline__ float lane_bcast(float v, int srclane  ) { return __uint_as_float((unsigned)__builtin_amdgcn_readlane((int)__float_as_uint(v), srclane)); }
__device__ __forceinline__ float silu_f(float x) { return x * __builtin_amdgcn_rcpf(1.f + __expf(-x)); }
__device__ __forceinline__ float sigmoid_f(float x) { return __builtin_amdgcn_rcpf(1.f + __expf(-x)); }
__device__ __forceinline__ float logsigmoid_f(float x) { const float y = __expf(-fabsf(x));
    const float l1p = (y < 0.0625f) ? y * (1.f - y * (0.5f - y * (0.33333334f - 0.25f * y))) : __logf(1.f + y); return fminf(x, 0.f) - l1p; }
__device__ __forceinline__ void unpack8(u32x4 w, float* f) {
    f[0] = bf2f(w.x & 0xffffu); f[1] = bf2f(w.x >> 16); f[2] = bf2f(w.y & 0xffffu); f[3] = bf2f(w.y >> 16);
    f[4] = bf2f(w.z & 0xffffu); f[5] = bf2f(w.z >> 16); f[6] = bf2f(w.w & 0xffffu); f[7] = bf2f(w.w >> 16);
}

__device__ __forceinline__ void ph_prep_small(const P& p) {
    float* rope = (float*)(p.ws + WS_ROPE);
    const int gt = blockIdx.x * 512 + ltid();
    if (gt < 2048) {
        const double C1[16] = {0.54030230586813977, 0.84600910641876459, 0.95041528091621519, 0.98423023475537852, 0.99500416512926237, 0.99841927779381845, 0.99950004171911222, 0.99984189027985781, 0.99995000041890036, 0.99998418865337735, 0.99999500000426333, 0.99999841886154905, 0.99999949999999416, 0.99999984188613433, 0.99999995000000319, 0.99999998418861191};
        const double S1[16] = {0.8414709848078965, 0.53316844604357783, 0.31098359088696603, 0.17689218465882672, 0.099833418129499904, 0.056204499194192764, 0.031617504700607077, 0.017781857090886144, 0.0099998331106604232, 0.0056233836119069999, 0.0031622723591389961, 0.0017782784939288374, 0.00099999988083076933, 0.00056234127206397698, 0.00031622775186866914, 0.00017782793926880789};
        double c1 = 0.0, s1 = 0.0;
        const int fq = gt & 15, pos = gt >> 4;
#pragma unroll
        for (int f = 0; f < 16; ++f) { c1 = (fq == f) ? C1[f] : c1; s1 = (fq == f) ? S1[f] : s1; }
        double c = 1.0, sn = 0.0;
#pragma unroll
        for (int bit = 0; bit < 7; ++bit) {
            if ((pos >> bit) & 1) { const double cn = c * c1 - sn * s1; sn = sn * c1 + c * s1; c = cn; }
            const double c2 = c1 * c1 - s1 * s1; s1 = 2.0 * c1 * s1; c1 = c2; }
        rope[2 * gt] = (float)c; rope[2 * gt + 1] = (float)sn;
    }
}

constexpr int RIMG_PART = (2 * 32 * 64 + 32 * 16) * 8;
__device__ __forceinline__ void ph_router_image(const P& p) {
    bf16_t* img = (bf16_t*)(p.ws + WS_RIMG);
    for (int idx = blockIdx.x * 512 + ltid(); idx < 2 * 36 * 1024; idx += gridDim.x * 512) {
        const int l = idx / 36864, r = idx % 36864, k = r / 36, col = r % 36;
        const float w = pin(p, 10)[l * 1024 + k] * (col < 32 ? pin(p, 13)[(size_t)l * 32768 + k * 32 + col] : pin(p, 11)[l * 4096 + k * 4 + (col - 32)]);
        const unsigned h = f2bf(w); const unsigned lo = f2bf(w - bf2f(h));
        const int ks = k >> 5, kq = (k >> 3) & 3, j = k & 7;
        const int off = (col < 32) ? (((col >> 4) * 32 + ks) * 64 + kq * 16 + (col & 15)) * 8 + j : 32768 + ((ks * 4 + kq) * 4 + (col - 32)) * 8 + j;
        bf16_t* base = img + (size_t)l * 2 * RIMG_PART;
        base[off] = (bf16_t)h; base[RIMG_PART + off] = (bf16_t)lo;
    }
}

template <int MODE> __device__ __forceinline__ int transpose_nitems() { return MODE == 0 ? 16 * 44 : MODE == 1 ? 16 * 16 : MODE == 2 ? 32 * 16 * 16 : 32 * 8 * 16; }
template <int MODE> __device__ __forceinline__ void transpose_load(const P& p, int l, int item, float4 (&v)[2]) {
    constexpr int K = (MODE == 3) ? 512 : 1024, NT = (MODE == 0) ? 44 : 16, KT = K / 64;
    const int tid = ltid();
    const int e = item / (KT * NT), r = item % (KT * NT), kt = r / NT, nt = r % NT, k0 = kt * 64, n0 = nt * 64;
#pragma unroll
    for (int i = 0; i < 2; ++i) {
        const int idx = tid + 512 * i, kk = idx >> 4, j = idx & 15;
        const float* src;
        if (MODE == 0) { const int sc = (n0 < 2048 ? n0 : n0 + 16) + 4 * j; src = pin(p, 2) + ((size_t)l * 1024 + k0 + kk) * PIN_ + sc; }
        else if (MODE == 1) { src = pin(p, 9) + ((size_t)l * 1024 + k0 + kk) * 1024 + n0 + 4 * j; }
        else if (MODE == 2) { const int g = (n0 >> 3) + (j >> 1); const float* base = (j & 1) ? pin(p, 16) : pin(p, 15);
            src = base + (((size_t)l * 32 + e) * 1024 + k0 + kk) * 512 + 4 * g; }
        else { src = pin(p, 17) + (((size_t)l * 32 + e) * 512 + k0 + kk) * 1024 + n0 + 4 * j; }
        v[i] = gld4(src);
    }
}
template <int MODE> __device__ __forceinline__ void transpose_to_lds(const float4 (&v)[2], float* tile) {
    const int tid = ltid();
#pragma unroll
    for (int i = 0; i < 2; ++i) {
        const int idx = tid + 512 * i, kk = idx >> 4, j = idx & 15;
        const int dcol = (MODE == 2) ? 8 * (j >> 1) + 4 * (j & 1) : 4 * j;
        float* t = tile + kk * 65 + dcol; t[0] = v[i].x; t[1] = v[i].y; t[2] = v[i].z; t[3] = v[i].w;
    }
}
template <int MODE> __device__ __forceinline__ void transpose_from_lds(const P& p, int l, int item, const float* tile) {
    constexpr int K = (MODE == 3) ? 512 : 1024, NT = (MODE == 0) ? 44 : 16, KT = K / 64;
    const int tid = ltid();
    const int e = item / (KT * NT), r = item % (KT * NT), kt = r / NT, nt = r % NT, k0 = kt * 64, n0 = nt * 64;
    const int n = tid >> 3, c = tid & 7; const float* s = tile + (8 * c) * 65 + n;
    u32x4 o; o.x = pk2(s[0], s[65]); o.y = pk2(s[2 * 65], s[3 * 65]); o.z = pk2(s[4 * 65], s[5 * 65]); o.w = pk2(s[6 * 65], s[7 * 65]);
    bf16_t* dst;
    if (MODE == 0) dst = (bf16_t*)(p.ws + WS_WIN) + (size_t)l * NWIN * 1024;
    else if (MODE == 1) dst = (bf16_t*)(p.ws + WS_WOUT) + (size_t)l * 1024 * 1024;
    else if (MODE == 2) dst = (bf16_t*)(p.ws + WS_W13) + (size_t)e * 1024 * 1024;
    else dst = (bf16_t*)(p.ws + WS_W2) + (size_t)e * 1024 * 512;
    *(u32x4*)(dst + (size_t)(n0 + n) * K + k0 + 8 * c) = o;
}
template <int MODE> __device__ __forceinline__ void ph_transpose(const P& p, int l, unsigned char* smem, int it0 = 0, int it1 = -1, int vb = -1, int vg = 0) {
    float* tile0 = (float*)smem; float* tile1 = tile0 + 64 * 65 + 32;
    const int n = (it1 < 0) ? transpose_nitems<MODE>() : it1, G = (vb < 0) ? (int)gridDim.x : vg;
    int it = it0 + ((vb < 0) ? (int)blockIdx.x : vb);
    float4 na[2], nb[2];
    if (it >= n) return;
    transpose_load<MODE>(p, l, it, na);
    transpose_load<MODE>(p, l, it + G < n ? it + G : n - 1, nb);
    for (; it < n; it += 2 * G) {
        const bool hb = it + G < n;
        float4 ca[2], cb[2]; ca[0] = na[0]; ca[1] = na[1]; cb[0] = nb[0]; cb[1] = nb[1];
        transpose_load<MODE>(p, l, it + 2 * G < n ? it + 2 * G : n - 1, na);
        transpose_load<MODE>(p, l, it + 3 * G < n ? it + 3 * G : n - 1, nb);
        transpose_to_lds<MODE>(ca, tile0); if (hb) transpose_to_lds<MODE>(cb, tile1);
        asm volatile("s_waitcnt lgkmcnt(0)\n\ts_barrier" ::: "memory");
        transpose_from_lds<MODE>(p, l, it, tile0); if (hb) transpose_from_lds<MODE>(p, l, it + G, tile1);
        asm volatile("s_waitcnt lgkmcnt(0)\n\ts_barrier" ::: "memory");
    }
}

constexpr int BG_HALF2 = 2 * 8192, BG_TOTAL = BG_HALF2 + 2 * 4096;
struct BgJob { int next, stride; };
__device__ __forceinline__ void bg_decode(int hid, bool& m2, int& e, int& k0, int& n0) {
    m2 = hid < BG_HALF2; const int item = (m2 ? hid : hid - BG_HALF2) >> 1, half = hid & 1;
    const int sh = m2 ? 8 : 7;
    e = item >> sh; const int r = item & ((1 << sh) - 1), kt = r >> 4, nt = r & 15; k0 = kt * 64 + 32 * half; n0 = nt * 64;
}
__device__ __forceinline__ void bg_glds16(const void* gsrc, unsigned lds_dst) { unsigned keep;
    asm volatile("s_mov_b32 %0, m0\n\ts_mov_b32 m0, %2\n\ts_nop 0\n\tglobal_load_lds_dwordx4 %1, off\n\ts_mov_b32 m0, %0" : "=&s"(keep) : "v"(gsrc), "s"(lds_dst) : "memory"); }
__device__ __forceinline__ void bg_dma(const P& p, int l, int hid, unsigned tile_lds) {
    const int lane = ltid() & 63; bool m2; int e, k0, n0; bg_decode(hid, m2, e, k0, n0);
    const int kk = lane >> 4, j = lane & 15;
    const float* w1 = pin(p, 15); const float* w3 = pin(p, 16); const float* w2 = pin(p, 17);
    const float* src = m2 ? ((j & 1) ? w3 : w1) + (((size_t)l * 32 + e) * 1024 + k0 + kk) * 512 + 4 * ((n0 >> 3) + (j >> 1))
                          : w2 + (((size_t)l * 32 + e) * 512 + k0 + kk) * 1024 + n0 + 4 * j;
    const size_t step = m2 ? 4 * 512 : 4 * 1024;
#pragma unroll
    for (int i = 0; i < 8; ++i) bg_glds16(src + (size_t)i * step, (unsigned)__builtin_amdgcn_readfirstlane(tile_lds + i * 1024));
}
__device__ __forceinline__ void bg_finish(const P& p, int hid, const float* tile  ) {
    const int lane = ltid() & 63; bool m2; int e, k0, n0; bg_decode(hid, m2, e, k0, n0);
    const int ng = lane & 15, kg = lane >> 4;
    float4 tv[8];
#pragma unroll
    for (int i = 0; i < 8; ++i) tv[i] = *(const float4*)(tile + (8 * kg + i) * 64 + 4 * ng);
    bf16_t* dst = m2 ? (bf16_t*)(p.ws + WS_W13) + (size_t)e * 1024 * 1024 + (size_t)(n0 + 4 * ng) * 1024 + k0 + 8 * kg : (bf16_t*)(p.ws + WS_W2) + (size_t)e * 1024 * 512 + (size_t)(n0 + 4 * ng) * 512 + k0 + 8 * kg;
    const int K = m2 ? 1024 : 512;
    { u32x4 o; o.x = pk2(tv[0].x, tv[1].x); o.y = pk2(tv[2].x, tv[3].x); o.z = pk2(tv[4].x, tv[5].x); o.w = pk2(tv[6].x, tv[7].x); *(u32x4*)(dst) = o; }
    { u32x4 o; o.x = pk2(tv[0].y, tv[1].y); o.y = pk2(tv[2].y, tv[3].y); o.z = pk2(tv[4].y, tv[5].y); o.w = pk2(tv[6].y, tv[7].y); *(u32x4*)(dst + K) = o; }
    { u32x4 o; o.x = pk2(tv[0].z, tv[1].z); o.y = pk2(tv[2].z, tv[3].z); o.z = pk2(tv[4].z, tv[5].z); o.w = pk2(tv[6].z, tv[7].z); *(u32x4*)(dst + 2 * K) = o; }
    { u32x4 o; o.x = pk2(tv[0].w, tv[1].w); o.y = pk2(tv[2].w, tv[3].w); o.z = pk2(tv[4].w, tv[5].w); o.w = pk2(tv[6].w, tv[7].w); *(u32x4*)(dst + 3 * K) = o; }
    asm volatile("s_waitcnt lgkmcnt(0)" ::: "memory");
}

constexpr int LDS_RING = 131072;
constexpr int LDS_MISC = LDS_RING;
constexpr int LDS_LCNT = 148480;
constexpr int LDS_BIAS = 148032;
constexpr int WROW = 1028;
constexpr int LDS_PTAB = 163840 - 512;
__device__ __forceinline__ float dot4(const float4 a, const float4 b) { return (a.x * b.x + a.y * b.y) + (a.z * b.z + a.w * b.w); }
__device__ __forceinline__ void dot4acc(pk_f32x2& acc, const float4 a, const float4 b) {
    acc = __builtin_elementwise_fma((pk_f32x2){a.x, a.y}, (pk_f32x2){b.x, b.y}, acc); acc = __builtin_elementwise_fma((pk_f32x2){a.z, a.w}, (pk_f32x2){b.z, b.w}, acc); }
template <int NH, int MASK, int N> __device__ __forceinline__ void tree_step(float (&v)[N], int lane) {
    const bool up = (lane & MASK) != 0;
#pragma unroll
    for (int i = 0; i < NH; ++i) { const float send = up ? v[i] : v[i + NH], keep = up ? v[i + NH] : v[i]; v[i] = keep + shx<MASK>(send); }
}
template <int N> __device__ __forceinline__ float tree_reduce(float (&v)[N], int lane) {
    static_assert(N == 4 || N == 8 || N == 16, "tree_reduce: N");
    if constexpr (N == 16) { tree_step<8, 32>(v, lane); tree_step<4, 16>(v, lane); tree_step<2, 8>(v, lane); tree_step<1, 4>(v, lane); float r = v[0]; r += shx<2>(r); r += shx<1>(r); return r; }
    else if constexpr (N == 8) { tree_step<4, 32>(v, lane); tree_step<2, 16>(v, lane); tree_step<1, 8>(v, lane); float r = v[0]; r += shx<4>(r); r += shx<2>(r); r += shx<1>(r); return r; }
    else { tree_step<2, 32>(v, lane); tree_step<1, 16>(v, lane); float r = v[0]; r += shx<8>(r); r += shx<4>(r); r += shx<2>(r); r += shx<1>(r); return r; }
}
template <int MODE, bool COMB> __device__ __forceinline__ void rowpass(const P& p, int l, int nblk, int bid, unsigned char* smem, bool real = true) {
    float* const outp = real ? p.out : (float*)(p.ws + WS_R1);
    constexpr bool XBF = !(MODE == 1 && !COMB);
    const int tid = ltid(), lane = tid & 63, wave = tid >> 6;
    const int gw = bid * 8 + wave, NGW = nblk * 8;
    float* W = (float*)smem; unsigned* lcnt = (unsigned*)(smem + LDS_LCNT);
    if (MODE == 1) { const float* src = pin(p, 2) + (size_t)l * 1024 * PIN_ + 2048;
        float4 gw[8];
#pragma unroll
        for (int q = 0; q < 8; ++q) { const int t = tid + 512 * q; gw[q] = gld4(src + (size_t)(t >> 2) * PIN_ + (t & 3) * 4); }
#pragma unroll
        for (int q = 0; q < 8; ++q) { const int t = tid + 512 * q, k = t >> 2, c4 = (t & 3) * 4; W[(c4 + 0) * WROW + k] = gw[q].x; W[(c4 + 1) * WROW + k] = gw[q].y; W[(c4 + 2) * WROW + k] = gw[q].z; W[(c4 + 3) * WROW + k] = gw[q].w; } }
    if (MODE == 2) { const float* sg = pin(p, 11) + (size_t)l * 4096; const float* se = pin(p, 13) + (size_t)l * 32768;
#pragma unroll 8
        for (int i = tid; i < 4096; i += 512) W[(i & 3) * WROW + (i >> 2)] = sg[i];
#pragma unroll 16
        for (int i = tid; i < 32768; i += 512) W[(4 + (i & 31)) * WROW + (i >> 5)] = se[i];
        if (tid < 32) lcnt[tid] = 0u;
        if (tid < 4) ((float*)(smem + LDS_BIAS))[tid] = pin(p, 12)[l * 4 + tid];
        if (tid >= 64 && tid < 96) ((float*)(smem + LDS_BIAS))[4 + tid - 64] = pin(p, 14)[l * 32 + tid - 64]; }
    if (MODE == 1) { if (tid < 16) ((float*)(smem + LDS_BIAS))[tid] = pin(p, 5)[l * 16 + tid]; }
    const float* biasl = (const float*)(smem + LDS_BIAS);
    if (MODE != 3) __syncthreads();
    const float* gain = (MODE == 1) ? pin(p, 1) + l * 1024 : (MODE == 2) ? pin(p, 10) + l * 1024 : pin(p, 18);
    float4 g4[4];
#pragma unroll
    for (int j = 0; j < 4; ++j) g4[j] = ((const float4*)gain)[lane + 64 * j];
    bf16_t* XN = (bf16_t*)(p.ws + WS_XN);
    const bf16_t* Y = (const bf16_t*)(p.ws + WS_Y);
    const float* xbase = pin(p, 0); const bf16_t* xbb = (const bf16_t*)(p.ws + WS_XB);
    constexpr int R = 2;
    float4 nv[R][4]; u32x2 nx[R][4], na[R][4], nb[R][4];
#define ROW_LOAD(r, mm) do { _Pragma("unroll") for (int j = 0; j < 4; ++j) { if (XBF) nx[r][j] = ((const u32x2*)(xbb + (size_t)(mm) * 1024))[lane + 64 * j]; else nv[r][j] = gld4(xbase + (size_t)(mm) * 1024 + 4 * (lane + 64 * j)); \
        if (COMB) { na[r][j] = ((const u32x2*)(Y + (size_t)(2 * (mm)) * 1024))[lane + 64 * j]; nb[r][j] = ((const u32x2*)(Y + (size_t)(2 * (mm) + 1) * 1024))[lane + 64 * j]; } } } while (0)
#pragma unroll
    for (int r = 0; r < R; ++r) { const int mm_ = gw + r * NGW; ROW_LOAD(r, mm_ < M ? mm_ : M - 1); }
    for (int m0 = gw; m0 < M; m0 += R * NGW) {
        float4 v[R][4]; int mr[R]; bool ok[R];
#pragma unroll
        for (int r = 0; r < R; ++r) { mr[r] = m0 + r * NGW; if (mr[r] >= M) mr[r] = M - 1; ok[r] = true;
#pragma unroll
            for (int j = 0; j < 4; ++j) { if (XBF) { v[r][j].x = bf2f(nx[r][j].x & 0xffffu); v[r][j].y = bf2f(nx[r][j].x >> 16); v[r][j].z = bf2f(nx[r][j].y & 0xffffu); v[r][j].w = bf2f(nx[r][j].y >> 16); } else v[r][j] = nv[r][j];
                if (COMB) { v[r][j].x += bf2f(na[r][j].x & 0xffffu) + bf2f(nb[r][j].x & 0xffffu); v[r][j].y += bf2f(na[r][j].x >> 16) + bf2f(nb[r][j].x >> 16);
                            v[r][j].z += bf2f(na[r][j].y & 0xffffu) + bf2f(nb[r][j].y & 0xffffu); v[r][j].w += bf2f(na[r][j].y >> 16) + bf2f(nb[r][j].y >> 16); } } }
#pragma unroll
        for (int r = 0; r < R; ++r) { const int mm_ = m0 + (R + r) * NGW; ROW_LOAD(r, mm_ < M ? mm_ : M - 1); }
        if (MODE == 1) {
#pragma unroll
            for (int r = 0; r < R; ++r) if (ok[r]) {
#pragma unroll
                for (int j = 0; j < 4; ++j) { u32x2 o; o.x = pk2(v[r][j].x, v[r][j].y); o.y = pk2(v[r][j].z, v[r][j].w); ((u32x2*)((bf16_t*)outp + (size_t)mr[r] * 1024))[lane + 64 * j] = o; } }
        }
        float ss[R];
#pragma unroll
        for (int r = 0; r < R; ++r) { ss[r] = 0.f;
#pragma unroll
            for (int j = 0; j < 4; ++j) ss[r] += dot4(v[r][j], v[r][j]); }
#pragma unroll
        for (int r = 0; r < R; ++r) ss[r] = wave_sum(ss[r]);
#pragma unroll
        for (int r = 0; r < R; ++r) { const float rn = 1.0f / sqrtf(ss[r] * (1.0f / 1024.0f) + EPS);
#pragma unroll
            for (int j = 0; j < 4; ++j) { v[r][j].x *= rn * g4[j].x; v[r][j].y *= rn * g4[j].y; v[r][j].z *= rn * g4[j].z; v[r][j].w *= rn * g4[j].w; } }
        if (MODE == 3) {
#pragma unroll
            for (int r = 0; r < R; ++r) if (ok[r]) {
#pragma unroll
                for (int j = 0; j < 4; ++j) ((float4*)(outp + (size_t)mr[r] * 1024))[lane + 64 * j] = v[r][j]; }
            continue;
        }
#pragma unroll
        for (int r = 0; r < R; ++r) if (ok[r]) {
#pragma unroll
            for (int j = 0; j < 4; ++j) { u32x2 o; o.x = pk2(v[r][j].x, v[r][j].y); o.y = pk2(v[r][j].z, v[r][j].w); ((u32x2*)(XN + (size_t)mr[r] * 1024))[lane + 64 * j] = o; } }
        if (MODE == 1) {
            float acc[R][16];
#pragma unroll
            for (int g = 0; g < 16; ++g) { pk_f32x2 s0 = {0.f, 0.f}, s1 = {0.f, 0.f};
#pragma unroll
                for (int j = 0; j < 4; ++j) { const float4 w = ((const float4*)(W + g * WROW))[lane + 64 * j]; dot4acc(s0, v[0][j], w); dot4acc(s1, v[1][j], w); }
                acc[0][g] = s0.x + s0.y; acc[1][g] = s1.x + s1.y; if ((g & 3) == 3) asm volatile("" ::: "memory"); }
            float val[R];
#pragma unroll
            for (int r = 0; r < R; ++r) val[r] = tree_reduce<16>(acc[r], lane);
            if ((lane & 3) == 0) { const int o = ((lane >> 5) & 1) * 8 + ((lane >> 4) & 1) * 4 + ((lane >> 3) & 1) * 2 + ((lane >> 2) & 1); const float gb = biasl[o];
#pragma unroll
                for (int r = 0; r < R; ++r) if (ok[r]) { float pre = val[r] + gb; if ((o >> 2) & 1) pre = logsigmoid_f(pre); ((float*)(p.ws + WS_GATES))[(size_t)mr[r] * 16 + o] = pre; } }
        } else {
            float ga[R][4];
#pragma unroll
            for (int g = 0; g < 4; ++g) { pk_f32x2 s0 = {0.f, 0.f}, s1 = {0.f, 0.f};
#pragma unroll
                for (int j = 0; j < 4; ++j) { const float4 w = ((const float4*)(W + g * WROW))[lane + 64 * j]; dot4acc(s0, v[0][j], w); dot4acc(s1, v[1][j], w); }
                ga[0][g] = s0.x + s0.y; ga[1][g] = s1.x + s1.y; }
            float gv[R];
#pragma unroll
            for (int r = 0; r < R; ++r) gv[r] = tree_reduce<4>(ga[r], lane);
            const float* bg = biasl; const float* be = biasl + 4;
            int gi[R]; float gval[R];
#pragma unroll
            for (int r = 0; r < R; ++r) { float gl[4];
#pragma unroll
                for (int g = 0; g < 4; ++g) gl[g] = lane_bcast(gv[r], 16 * g) + bg[g];
                int gix = 0; float gm = gl[0];
#pragma unroll
                for (int g = 1; g < 4; ++g) if (gl[g] > gm) { gm = gl[g]; gix = g; }
                float gs = 0.f;
#pragma unroll
                for (int g = 0; g < 4; ++g) gs += __expf(gl[g] - gm);
                gval[r] = 1.0f / gs; gi[r] = __builtin_amdgcn_readfirstlane(gix); }
            float ea[R][8];
#pragma unroll
            for (int i = 0; i < 8; ++i) {
#pragma unroll
                for (int r = 0; r < R; ++r) { const float* We = W + (4 + 8 * gi[r] + i) * WROW; pk_f32x2 sacc = {0.f, 0.f};
#pragma unroll
                    for (int j = 0; j < 4; ++j) dot4acc(sacc, v[r][j], ((const float4*)We)[lane + 64 * j]);
                    ea[r][i] = sacc.x + sacc.y; }
                if (i & 1) asm volatile("" ::: "memory"); }
            float ev[R];
#pragma unroll
            for (int r = 0; r < R; ++r) ev[r] = tree_reduce<8>(ea[r], lane);
#pragma unroll
            for (int r = 0; r < R; ++r) {
                float sel[8];
#pragma unroll
                for (int i = 0; i < 8; ++i) sel[i] = lane_bcast(ev[r], 32 * ((i >> 2) & 1) + 16 * ((i >> 1) & 1) + 8 * (i & 1)) + be[8 * gi[r] + i];
                int i0 = 0; float v0 = sel[0];
#pragma unroll
                for (int i = 1; i < 8; ++i) if (sel[i] > v0) { v0 = sel[i]; i0 = i; }
                int i1 = -1; float v1 = -INFINITY;
#pragma unroll
                for (int i = 0; i < 8; ++i) if (i != i0 && sel[i] > v1) { v1 = sel[i]; i1 = i; }
                const float e1 = __expf(v1 - v0); const float w0 = gval[r] / (1.f + e1), w1 = gval[r] * e1 / (1.f + e1);
                if (lane == 0 && ok[r]) {
                    const int m = mr[r], ea_ = gi[r] * 8 + i0, eb_ = gi[r] * 8 + i1;
                    ((int*)(p.ws + WS_TOPE))[2 * m] = ea_; ((int*)(p.ws + WS_TOPE))[2 * m + 1] = eb_;
                    ((float*)(p.ws + WS_TOPW))[2 * m] = w0; ((float*)(p.ws + WS_TOPW))[2 * m + 1] = w1;
                    atomicAdd(&lcnt[ea_], 1u); atomicAdd(&lcnt[eb_], 1u);
                }
            }
        }
    }
#undef ROW_LOAD
    if (MODE == 2) { __syncthreads(); if (real && tid < 32 && lcnt[tid]) atomicAdd((unsigned*)(p.ws + WS_CTL) + CW_CNT + l * 32 + tid, lcnt[tid]); }
}

__device__ __forceinline__ void moe_pad_start(const unsigned* cnt, int* ps  ) {
    int acc = 0;
#pragma unroll
    for (int e = 0; e < 32; ++e) { ps[e] = acc; acc += ((int)cnt[e] + 255) & ~255; }
    ps[32] = acc;
}
__device__ __forceinline__ void ph_scatter(const P& p, int l, unsigned char* smem) {
    unsigned* lcnt = (unsigned*)smem; unsigned* lbase = lcnt + 32; int* lps = (int*)(lbase + 32);
    const int tid = ltid();
    const unsigned* cnt = (const unsigned*)(p.ws + WS_CTL) + CW_CNT + l * 32;
    unsigned* fill = (unsigned*)(p.ws + WS_CTL) + CW_FILL + l * 32;
    int* slot_tok = (int*)(p.ws + WS_SLOT); float* slot_w = (float*)(p.ws + WS_SLOTW); const float* topw = (const float*)(p.ws + WS_TOPW);
    const int* tope = (const int*)(p.ws + WS_TOPE);
    if (tid == 0) { int acc = 0; for (int e = 0; e < 32; ++e) { lps[e] = acc; acc += ((int)cnt[e] + 255) & ~255; } lps[32] = acc; }
    __syncthreads();
    for (int e = blockIdx.x; e < 32; e += gridDim.x) for (int s = lps[e] + (int)cnt[e] + tid; s < lps[e + 1]; s += 512) slot_tok[s] = -1;
    for (int t0 = blockIdx.x * 128; t0 < M; t0 += gridDim.x * 128) {
        if (tid < 32) lcnt[tid] = 0u;
        __syncthreads();
        const bool act = tid < 128; const int m = t0 + (tid & 127);
        int ea = 0, eb = 0; unsigned ia = 0u, ib = 0u; float wa = 0.f, wb = 0.f;
        if (act) { ea = tope[2 * m]; eb = tope[2 * m + 1]; wa = topw[2 * m]; wb = topw[2 * m + 1]; ia = atomicAdd(&lcnt[ea], 1u); ib = atomicAdd(&lcnt[eb], 1u); }
        __syncthreads();
        if (tid < 32) lbase[tid] = lcnt[tid] ? atomicAdd(&fill[tid], lcnt[tid]) : 0u;
        __syncthreads();
        if (act) { const int sa = lps[ea] + (int)(lbase[ea] + ia), sb = lps[eb] + (int)(lbase[eb] + ib); slot_tok[sa] = 2 * m; slot_tok[sb] = 2 * m + 1; slot_w[sa] = wa; slot_w[sb] = wb; }
        __syncthreads();
    }
}

enum { EPI_INPROJ = 0, EPI_OUTPROJ = 1, EPI_MOE1 = 2, EPI_MOE2 = 3 };
#ifndef NTAIL2
#define NTAIL2 2048
#endif
__device__ __forceinline__ int tail_items() { return gridDim.x == 256 ? NTAIL2 : 0; }
namespace attn_body {
using bf16=unsigned short;
using bf16x8=__attribute__((ext_vector_type(8)))short;
using s16x4=__attribute__((ext_vector_type(4)))short;
using f32x16=__attribute__((ext_vector_type(16)))float;
using u32x4=__attribute__((ext_vector_type(4)))unsigned;
constexpr int SEQ=8192,D=64,QP=768,OP=1024;
constexpr int NW=8,QBLK=32,QB=QBLK*NW,KVBLK=64,NQB=SEQ/QB;
constexpr int ATTN_UNIT_ROWS=QB;
__device__ __forceinline__ int crow(int r,int hi){return (r&3)+8*(r>>2)+4*hi;}
#define SBAR() __builtin_amdgcn_sched_barrier(0)
__device__ __forceinline__ void cmask(f32x16&p0,f32x16&p1,int jb,int qrel,int hi){
  const float NEG=-INFINITY; int kb=64*jb+4*hi;
  #pragma unroll
  for(int r=0;r<16;++r){int kv=kb+(r&3)+8*(r>>2); if(kv>qrel)p0[r]=NEG; if(kv+32>qrel)p1[r]=NEG;}
}

constexpr int NSLOT=4, SLOTB=8192;
constexpr int LDS_K=0, LDS_V=NSLOT*SLOTB, LDS_WS=2*NSLOT*SLOTB, LDS_OST=LDS_WS+NW*64*4, LDS_BYTES=LDS_OST+NW*4096;
constexpr float C2=0.125f*1.4426950408889634f;
__device__ __forceinline__ void glds16(const void*gsrc,unsigned lds_dst){unsigned keep;
  asm volatile("s_mov_b32 %0, m0\n\ts_mov_b32 m0, %2\n\ts_nop 0\n\tglobal_load_lds_dwordx4 %1, off\n\ts_mov_b32 m0, %0":"=&s"(keep):"v"(gsrc),"s"(lds_dst):"memory");}
__device__ __forceinline__ float max3f(float a,float b,float c){float r;asm("v_max3_f32 %0, %1, %2, %3":"=v"(r):"v"(a),"v"(b),"v"(c));return r;}
__device__ __forceinline__ float max2f(float a,float b){float r;asm("v_max_f32_e32 %0, %1, %2":"=v"(r):"v"(a),"v"(b));return r;}
__device__ __forceinline__ float fadd_s(float a,float b){float r;asm("v_add_f32_e32 %0, %1, %2":"=v"(r):"v"(a),"v"(b));return r;}
__device__ __forceinline__ float fsub_s(float a,float b){float r;asm("v_sub_f32_e32 %0, %1, %2":"=v"(r):"v"(a),"v"(b));return r;}
typedef float f32x2_t __attribute__((ext_vector_type(2))); typedef __bf16 bf16x2_t __attribute__((ext_vector_type(2)));
__device__ __forceinline__ unsigned cvtpk_s(float lo,float hi){f32x2_t v={lo,hi};bf16x2_t b=__builtin_convertvector(v,bf16x2_t);return __builtin_bit_cast(unsigned,b);}
#define WAIT_BAR(N) asm volatile("s_waitcnt vmcnt(" #N ") lgkmcnt(0)\n\ts_barrier":::"memory")

__device__ __forceinline__ void qkt(f32x16&p0,f32x16&p1,const char*Kslot,const bf16x8*qr,const f32x16&negm,int r32,int hi){
  const char*kb=Kslot+hi*1024+r32*16;
  #pragma unroll
  for(int d0=0;d0<4;++d0){
    const bf16x8 b0=*reinterpret_cast<const bf16x8*>(kb+d0*2048);
    const bf16x8 b1=*reinterpret_cast<const bf16x8*>(kb+d0*2048+512);
    if(d0==0){p0=__builtin_amdgcn_mfma_f32_32x32x16_bf16(b0,qr[0],negm,0,0,0);p1=__builtin_amdgcn_mfma_f32_32x32x16_bf16(b1,qr[0],negm,0,0,0);}
    else{p0=__builtin_amdgcn_mfma_f32_32x32x16_bf16(b0,qr[d0],p0,0,0,0);p1=__builtin_amdgcn_mfma_f32_32x32x16_bf16(b1,qr[d0],p1,0,0,0);}}
}
typedef __attribute__((address_space(3))) const char* lds_cptr;
typedef short v4i16_t __attribute__((ext_vector_type(4)));
__device__ __forceinline__ void kload8(bf16x8*kf,lds_cptr kp){
  kf[0]=*(const __attribute__((address_space(3))) bf16x8*)(kp);      kf[1]=*(const __attribute__((address_space(3))) bf16x8*)(kp+512);
  kf[2]=*(const __attribute__((address_space(3))) bf16x8*)(kp+2048); kf[3]=*(const __attribute__((address_space(3))) bf16x8*)(kp+2560);
  kf[4]=*(const __attribute__((address_space(3))) bf16x8*)(kp+4096); kf[5]=*(const __attribute__((address_space(3))) bf16x8*)(kp+4608);
  kf[6]=*(const __attribute__((address_space(3))) bf16x8*)(kp+6144); kf[7]=*(const __attribute__((address_space(3))) bf16x8*)(kp+6656);
}
__device__ __forceinline__ void kload2(bf16x8*kf,lds_cptr kp,int j){ kf[2*j]=*(const __attribute__((address_space(3))) bf16x8*)(kp+j*2048); kf[2*j+1]=*(const __attribute__((address_space(3))) bf16x8*)(kp+j*2048+512); }
__device__ __forceinline__ s16x4 vtr(lds_cptr p){ return __builtin_bit_cast(s16x4,__builtin_amdgcn_ds_read_tr16_b64_v4i16((__attribute__((address_space(3))) v4i16_t*)p)); }
__device__ __forceinline__ float rowmax(const f32x16&p0,const f32x16&p1){
  float a=max3f(p0[0],p0[1],p1[0]),b=max3f(p0[2],p0[3],p1[1]);a=max3f(a,p1[2],p1[3]);
  #pragma unroll
  for(int r=4;r<16;r+=4){a=max3f(a,p0[r],p0[r+1]);b=max3f(b,p0[r+2],p0[r+3]);a=max3f(a,p1[r],p1[r+1]);b=max3f(b,p1[r+2],p1[r+3]);}
  const float m=max2f(a,b);
  auto rr=__builtin_amdgcn_permlane32_swap(__float_as_uint(m),__float_as_uint(m),false,false);
  return max2f(__uint_as_float(rr[0]),__uint_as_float(rr[1]));
}
__device__ __forceinline__ void pv(f32x16*o,int vb,bf16x8 pa0,bf16x8 pa1,bf16x8 pa2,bf16x8 pa3){
  #pragma unroll
  for(int d0=0;d0<2;++d0){s16x4 lo[4],hi[4];
    #pragma unroll
    for(int ks=0;ks<4;++ks){
      asm volatile("ds_read_b64_tr_b16 %0,%1 offset:%c2":"=&v"(lo[ks]):"v"(vb),"i"(d0*4096+ks*1024):"memory");
      asm volatile("ds_read_b64_tr_b16 %0,%1 offset:%c2":"=&v"(hi[ks]):"v"(vb),"i"(d0*4096+ks*1024+512):"memory");}
    asm volatile("s_waitcnt lgkmcnt(0)":::"memory");SBAR();
    #define PK(k) (bf16x8){lo[k][0],lo[k][1],lo[k][2],lo[k][3],hi[k][0],hi[k][1],hi[k][2],hi[k][3]}
    o[d0]=__builtin_amdgcn_mfma_f32_32x32x16_bf16(pa0,PK(0),o[d0],0,0,0);
    o[d0]=__builtin_amdgcn_mfma_f32_32x32x16_bf16(pa1,PK(1),o[d0],0,0,0);
    o[d0]=__builtin_amdgcn_mfma_f32_32x32x16_bf16(pa2,PK(2),o[d0],0,0,0);
    o[d0]=__builtin_amdgcn_mfma_f32_32x32x16_bf16(pa3,PK(3),o[d0],0,0,0);
    #undef PK
  }
}

#ifndef ATTN_STORE16
#define ATTN_STORE16(p,v) (*(u32x4*)(p)=(v))
#endif
typedef float f32x4v __attribute__((ext_vector_type(4)));
__device__ __forceinline__ void qload(bf16x8 (&qr)[4],const bf16*Qrow,int hi){
  #pragma unroll
  for(int d0=0;d0<4;++d0)qr[d0]=*reinterpret_cast<const bf16x8*>(&Qrow[d0*16+hi*8]);
}
__device__ __forceinline__ void qfetch(bf16x8 (&qr0)[4],bf16x8 (&qr1)[4],const bf16*AQ,int b,int hh,int qb){
  const int tid=ltid(),lane=tid&63,r32=lane&31,hi=lane>>5,wq=(tid>>6)&3;
  const bf16*Qw=AQ+((long)b*SEQ+qb*QB+wq*64)*QP+hh*D;
  qload(qr0,Qw+(long)r32*QP,hi); qload(qr1,Qw+(long)(32+r32)*QP,hi);
}
__device__ __forceinline__ void qprep(bf16x8 (&qr)[4],int tpos,int hi,const float*qgain,const float*rope){
  float qv[4][8]; float ss=0.f;
  #pragma unroll
  for(int d0=0;d0<4;++d0){ const u32x4 x=__builtin_bit_cast(u32x4,qr[d0]);
    qv[d0][0]=__uint_as_float(x.x<<16);qv[d0][1]=__uint_as_float(x.x&0xffff0000u);qv[d0][2]=__uint_as_float(x.y<<16);qv[d0][3]=__uint_as_float(x.y&0xffff0000u);
    qv[d0][4]=__uint_as_float(x.z<<16);qv[d0][5]=__uint_as_float(x.z&0xffff0000u);qv[d0][6]=__uint_as_float(x.w<<16);qv[d0][7]=__uint_as_float(x.w&0xffff0000u);
    #pragma unroll
    for(int j=0;j<8;++j)ss+=qv[d0][j]*qv[d0][j]; }
  { auto rr=__builtin_amdgcn_permlane32_swap(__float_as_uint(ss),__float_as_uint(ss),false,false); ss=__uint_as_float(rr[0])+__uint_as_float(rr[1]); }
  const float rn=(1.0f/sqrtf(ss*(1.0f/64.0f)+1e-6f))*C2;
  #pragma unroll
  for(int d0=0;d0<4;++d0){ const float4 g0=*reinterpret_cast<const float4*>(qgain+16*d0+8*hi), g1=*reinterpret_cast<const float4*>(qgain+16*d0+8*hi+4);
    qv[d0][0]*=rn*g0.x;qv[d0][1]*=rn*g0.y;qv[d0][2]*=rn*g0.z;qv[d0][3]*=rn*g0.w;qv[d0][4]*=rn*g1.x;qv[d0][5]*=rn*g1.y;qv[d0][6]*=rn*g1.z;qv[d0][7]*=rn*g1.w; }
  #pragma unroll
  for(int a=0;a<2;++a){ const int pos=a?(tpos&63):(tpos>>6); const float4*rp=reinterpret_cast<const float4*>(rope+2*(pos*16+8*hi));
    #pragma unroll
    for(int j2=0;j2<4;++j2){ const float4 cs=rp[j2];
      { const float x0=qv[2*a][2*j2],x1=qv[2*a+1][2*j2]; qv[2*a][2*j2]=x0*cs.x-x1*cs.y; qv[2*a+1][2*j2]=x1*cs.x+x0*cs.y; }
      { const float x0=qv[2*a][2*j2+1],x1=qv[2*a+1][2*j2+1]; qv[2*a][2*j2+1]=x0*cs.z-x1*cs.w; qv[2*a+1][2*j2+1]=x1*cs.z+x0*cs.w; } } }
  #pragma unroll
  for(int d0=0;d0<4;++d0){ u32x4 w; w.x=cvtpk_s(qv[d0][0],qv[d0][1]);w.y=cvtpk_s(qv[d0][2],qv[d0][3]);w.z=cvtpk_s(qv[d0][4],qv[d0][5]);w.w=cvtpk_s(qv[d0][6],qv[d0][7]); qr[d0]=__builtin_bit_cast(bf16x8,w); }
}
template<int THRL> __device__ __forceinline__ void attn_unit(int b,int hh,int kvh,int qb,const bf16*AQ,bf16*O,char*shm,float sref,const float*qgain,const float*rope,bf16x8 (&qr0)[4],bf16x8 (&qr1)[4],int nxt,const P&pp,int layer,BgJob&jb){
  const int tid=ltid(),lane=tid&63,r32=lane&31,hi=lane>>5; const int wid=__builtin_amdgcn_readfirstlane(tid>>6);
  const long rowbase=(long)b*SEQ; const int q0=qb*QB;
  const bf16*Kh=AQ+rowbase*QP+512+kvh*D,*Vh=AQ+rowbase*QP+640+kvh*D;
  const unsigned lds0=(unsigned)(uintptr_t)shm;
  const int NT=SEQ/KVBLK;
  if(wid>=4){
    const int lw=wid-4;
    const bf16*ksrc=Kh+(long)lane*QP+(2*lw)*8;
    const bf16*vsrc=Vh+(long)(16*((2*lw)&3)+(lane>>2))*QP+((2*lw)>>2)*32+(lane&3)*8;
    const unsigned kdst=lds0+LDS_K+(2*lw)*1024, vdst=lds0+LDS_V+(2*lw)*1024;
    #define LD_K(t) do{ const unsigned d_=(unsigned)__builtin_amdgcn_readfirstlane(kdst+((t)&3)*SLOTB); glds16(ksrc+(long)(t)*KVBLK*QP,d_); glds16(ksrc+(long)(t)*KVBLK*QP+8,d_+1024); }while(0)
    #define LD_V(t) do{ const unsigned d_=(unsigned)__builtin_amdgcn_readfirstlane(vdst+((t)&3)*SLOTB); glds16(vsrc+(long)(t)*KVBLK*QP,d_); glds16(vsrc+((long)(t)*KVBLK+16)*QP,d_+1024); }while(0)
    LD_K(0);LD_V(0);LD_K(1);LD_K(2);LD_V(1);
    asm volatile("s_waitcnt vmcnt(4)\n\ts_barrier":::"memory");
    bool active=false; const unsigned bgl=lds0+LDS_BYTES+lw*8192; const float*bgt=(const float*)(shm+LDS_BYTES+lw*8192);
    for(int t=-1;t<NT-1;++t){
      const int ph=(t+1+lw)&3;
      if(ph==0)active=(jb.next<BG_TOTAL)&&(t+8<NT);
      if(t+4<NT){
        if(active&&ph==0){ bg_dma(pp,layer,jb.next,bgl); LD_K(t+4); LD_V(t+3); asm volatile("s_waitcnt vmcnt(12)\n\ts_barrier":::"memory"); }
        else if(active&&ph==2){ LD_K(t+4); LD_V(t+3); bg_finish(pp,jb.next,bgt); asm volatile("s_waitcnt vmcnt(8)\n\ts_barrier":::"memory"); }
        else { LD_K(t+4); LD_V(t+3); asm volatile("s_waitcnt vmcnt(4)\n\ts_barrier":::"memory"); if(active&&ph==3){active=false;jb.next+=jb.stride;} }
      }
      else { if(t+3<NT)LD_V(t+3); asm volatile("s_waitcnt vmcnt(0)\n\ts_barrier":::"memory"); }
    }
    #undef LD_K
    #undef LD_V
    _Pragma("unroll") for(int i=0;i<4;++i){qr0[i]=bf16x8{};qr1[i]=bf16x8{};}
    return;
  }
  const int wq=wid;
  float*wsf=(float*)(shm+LDS_WS)+wid*64;
  bf16x8 kf[4];
  const lds_cptr shm3=(lds_cptr)shm; const lds_cptr kp0=shm3+LDS_K+hi*1024+r32*16; const lds_cptr vp0=shm3+LDS_V+((lane>>4)&1)*32+(lane&3)*8+(4*hi+((lane&15)>>2))*64;
  { const int tpos=(q0+wq*64+r32)&(SEQ-1);
    qprep(qr0,tpos,hi,qgain,rope); qprep(qr1,tpos+32,hi,qgain,rope); }
  float l0=0.f,l1=0.f; f32x16 o00=f32x16{},o01=f32x16{},o10=f32x16{},o11=f32x16{}; f32x16 negm;
  float nsref=-sref; asm volatile("":"+v"(nsref),"+v"(qr1[3]));
  _Pragma("unroll") for(int r=0;r<16;++r)negm[r]=nsref;
  asm volatile("":"+v"(negm));
  f32x16 pA0,pA1,pB0,pB1;
  #define MFMA_(a,b,c) __builtin_amdgcn_mfma_f32_32x32x16_bf16(a,b,c,0,0,0)
  #define KLD(j,base) (*(const __attribute__((address_space(3))) bf16x8*)((base)+(j)*2048))
  #define WAIT_BARC() asm volatile("s_waitcnt lgkmcnt(0)\n\ts_barrier":::"memory")
  WAIT_BARC();
  { _Pragma("unroll") for(int d0=0;d0<4;++d0){ const bf16x8 kk=KLD(d0,kp0);
      if(d0==0){pA0=MFMA_(kk,qr0[0],negm);pA1=MFMA_(kk,qr1[0],negm);} else {pA0=MFMA_(kk,qr0[d0],pA0);pA1=MFMA_(kk,qr1[d0],pA1);} } }
  asm volatile("s_nop 15\n\ts_nop 7":"+v"(pA0),"+v"(pA1));
  _Pragma("unroll") for(int r=0;r<16;++r)pA0[r]=__builtin_amdgcn_exp2f(pA0[r]);
  _Pragma("unroll") for(int r=0;r<16;++r)pA1[r]=__builtin_amdgcn_exp2f(pA1[r]);
  { _Pragma("unroll") for(int j=0;j<4;++j)kf[j]=KLD(j,kp0+512); }
  s16x4 vlo[4],vhi[4]; u32x4 pw00,pw01,pw10,pw11;
  #define PKW(P,B) cvtpk_s(P[B],P[B+1])
  #define PAF(k) __builtin_bit_cast(bf16x8,pw##k)
  #define VFR(i) (bf16x8){vlo[i][0],vlo[i][1],vlo[i][2],vlo[i][3],vhi[i][0],vhi[i][1],vhi[i][2],vhi[i][3]}
  #define PIN(x) asm volatile("":"+v"(x))
  #define GAPA(MF,ADDS,W0,W1,PW) do{ MF; ADDS; W0; W1; PIN(PW); SBAR(); }while(0)
  #define EX(v) __builtin_amdgcn_exp2f(v)
  #define GAPB(MF,X,B) do{ MF; X[B]=EX(X[B]); X[B+1]=EX(X[B+1]); X[B+2]=EX(X[B+2]); X[B+3]=EX(X[B+3]); PIN(X); SBAR(); }while(0)
  #define VRD(i) do{ vlo[i]=vtr(vp_+(((i)>>1)*4096+((i)&1)*1024)); vhi[i]=vtr(vp_+(((i)>>1)*4096+((i)&1)*1024+512)); }while(0)
  #define KRD(G,j) do{ if(G){ kf[j]=KLD(j,kp_); SBAR(); } }while(0)
  #define STEP(C0,C1,P0,P1,VOFF,KOFF,GL) do{ SBAR(); \
    const lds_cptr vp_=vp0+(VOFF); const lds_cptr kp_=kp0+(KOFF); \
    VRD(0); SBAR(); float s0=(P0[0]+P0[1]); float s1; \
    GAPA(C0=MFMA_(kf[0],qr0[0],negm), s0+=P0[2];s0+=P0[3];s0+=P0[4];s0+=P0[5];PIN(s0),     pw00[0]=PKW(P0,0), pw00[1]=PKW(P0,2), pw00); \
    GAPA(C1=MFMA_(kf[0],qr1[0],negm), s0+=P0[6];s0+=P0[7];s0+=P0[8];s0+=P0[9];PIN(s0),     pw00[2]=PKW(P0,4), pw00[3]=PKW(P0,6), pw00); \
    VRD(2); SBAR(); \
    GAPA(C0=MFMA_(kf[1],qr0[1],C0),   s0+=P0[10];s0+=P0[11];s0+=P0[12];s0+=P0[13];PIN(s0), pw10[0]=PKW(P1,0), pw10[1]=PKW(P1,2), pw10); \
    GAPA(C1=MFMA_(kf[1],qr1[1],C1),   s0+=P0[14];s0+=P0[15];s1=(P1[0]+P1[1]);s1+=P1[2];PIN(s0);PIN(s1), pw10[2]=PKW(P1,4), pw10[3]=PKW(P1,6), pw10); \
    VRD(1); SBAR(); \
    GAPA(C0=MFMA_(kf[2],qr0[2],C0),   s1+=P1[3];s1+=P1[4];s1+=P1[5];s1+=P1[6];PIN(s1),     pw01[0]=PKW(P0,8), pw01[1]=PKW(P0,10), pw01); \
    GAPA(C1=MFMA_(kf[2],qr1[2],C1),   s1+=P1[7];s1+=P1[8];s1+=P1[9];s1+=P1[10];PIN(s1),    pw01[2]=PKW(P0,12),pw01[3]=PKW(P0,14), pw01); \
    VRD(3); SBAR(); \
    GAPA(C0=MFMA_(kf[3],qr0[3],C0),   s1+=P1[11];s1+=P1[12];s1+=P1[13];s1+=P1[14];PIN(s1), pw11[0]=PKW(P1,8), pw11[1]=PKW(P1,10), pw11); \
    GAPA(C1=MFMA_(kf[3],qr1[3],C1),   s1+=P1[15];PIN(s1),                                  pw11[2]=PKW(P1,12),pw11[3]=PKW(P1,14), pw11); \
    l0+=s0; l1+=s1; \
    SBAR(); \
    KRD(GL,0); GAPB(o00=MFMA_(PAF(00),VFR(0),o00), C0,0); \
    KRD(GL,1); GAPB(o10=MFMA_(PAF(10),VFR(0),o10), C0,4); \
    KRD(GL,2); GAPB(o01=MFMA_(PAF(00),VFR(2),o01), C0,8); \
    KRD(GL,3); GAPB(o11=MFMA_(PAF(10),VFR(2),o11), C0,12); \
    GAPB(o00=MFMA_(PAF(01),VFR(1),o00), C1,0); \
    GAPB(o10=MFMA_(PAF(11),VFR(1),o10), C1,4); \
    GAPB(o01=MFMA_(PAF(01),VFR(3),o01), C1,8); \
    GAPB(o11=MFMA_(PAF(11),VFR(3),o11), C1,12); \
    }while(0)
  STEP(pB0,pB1,pA0,pA1,0,SLOTB,true); WAIT_BARC();
  for(int t=1;t<NT-1;++t){
    const int sc_=(t&3)*SLOTB, sp_=((t-1)&3)*SLOTB, sn_=((t+1)&3)*SLOTB;
    STEP(pA0,pA1,pB0,pB1,sp_+2048,sc_+512,true);
    STEP(pB0,pB1,pA0,pA1,sc_,sn_,true);
    WAIT_BARC();
  }
  { const int sc_=((NT-1)&3)*SLOTB, sp_=((NT-2)&3)*SLOTB;
    STEP(pA0,pA1,pB0,pB1,sp_+2048,sc_+512,true);
    STEP(pB0,pB1,pA0,pA1,sc_,0,false);
    WAIT_BARC();
    float s0=pB0[0]+pB0[1],s1=pB1[0]+pB1[1]; _Pragma("unroll") for(int r=2;r<16;++r){s0+=pB0[r];s1+=pB1[r];} l0+=s0; l1+=s1;
    pw00=(u32x4){PKW(pB0,0),PKW(pB0,2),PKW(pB0,4),PKW(pB0,6)};pw01=(u32x4){PKW(pB0,8),PKW(pB0,10),PKW(pB0,12),PKW(pB0,14)};pw10=(u32x4){PKW(pB1,0),PKW(pB1,2),PKW(pB1,4),PKW(pB1,6)};pw11=(u32x4){PKW(pB1,8),PKW(pB1,10),PKW(pB1,12),PKW(pB1,14)};
    SBAR(); const lds_cptr vp_=vp0+sc_+2048; VRD(0);VRD(1);VRD(2);VRD(3);
    o00=MFMA_(PAF(00),VFR(0),o00); o10=MFMA_(PAF(10),VFR(0),o10); o01=MFMA_(PAF(00),VFR(2),o01); o11=MFMA_(PAF(10),VFR(2),o11);
    o00=MFMA_(PAF(01),VFR(1),o00); o10=MFMA_(PAF(11),VFR(1),o10); o01=MFMA_(PAF(01),VFR(3),o01); o11=MFMA_(PAF(11),VFR(3),o11); }
  #undef PKW
  #undef PAF
  #undef VFR
  #undef PIN
  #undef GAPA
  #undef GAPB
  #undef EX
  #undef VRD
  #undef KRD
  #undef STEP
  {auto rr=__builtin_amdgcn_permlane32_swap(__float_as_uint(l0),__float_as_uint(l0),false,false);l0=__uint_as_float(rr[0])+__uint_as_float(rr[1]);}
  {auto rr=__builtin_amdgcn_permlane32_swap(__float_as_uint(l1),__float_as_uint(l1),false,false);l1=__uint_as_float(rr[0])+__uint_as_float(rr[1]);}
  if(hi==0){wsf[r32]=l0;wsf[32+r32]=l1;} asm volatile("s_waitcnt lgkmcnt(0)":::"memory");
  bf16*Ow=O+(rowbase+q0+wq*64)*OP+512+hh*D; bf16*stg=(bf16*)(shm+LDS_OST)+wid*4096;
  #define FINAL(OA,OB,LOFF,ROFF) do{ _Pragma("unroll") for(int r=0;r<16;++r){ const int orow=crow(r,hi); const float rl=__builtin_amdgcn_rcpf(wsf[(LOFF)+orow]); \
      stg[((ROFF)+orow)*64+r32]=(bf16)f2bf(OA[r]*rl); stg[((ROFF)+orow)*64+32+r32]=(bf16)f2bf(OB[r]*rl);} }while(0)
  FINAL(o00,o01,0,0); FINAL(o10,o11,32,32);
  #undef FINAL
  if(nxt>=0){ qfetch(qr0,qr1,AQ,nxt>>16,(nxt>>8)&255,nxt&255); } else { _Pragma("unroll") for(int i=0;i<4;++i){qr0[i]=bf16x8{};qr1[i]=bf16x8{};} }
  asm volatile("s_waitcnt lgkmcnt(0)":::"memory");
  #pragma unroll
  for(int i=0;i<8;++i){const int row=i*8+(lane>>3),ch=lane&7; const u32x4 v=*(const u32x4*)(stg+row*64+ch*8); ATTN_STORE16(Ow+(long)row*OP+ch*8,v);}
  asm volatile("s_waitcnt lgkmcnt(0)":::"memory");
  #undef MFMA_
  #undef KLD
  #undef WAIT_BARC
}
constexpr int ATTN_LDS_BYTES=LDS_BYTES;
#undef SBAR
#undef WAIT_BAR
}

__device__ __forceinline__ void ph_attn_mfma(const P& p, int l, unsigned char* smem) {
    const int G = gridDim.x, bx = blockIdx.x;
    const attn_body::bf16* AQ = (const attn_body::bf16*)(p.ws + WS_AQKV); attn_body::bf16* O = (attn_body::bf16*)(p.ws + WS_R1);
    const int vcu = (bx % 8) * (G / 8) + bx / 8;
    float sref;
    { const int lane = ltid() & 63; float mq = fabsf(pin(p, 7)[l * 64 + lane]), mk = fabsf(pin(p, 8)[l * 64 + lane]);
#define AMX(M_) mq = fmaxf(mq, shx<M_>(mq)); mk = fmaxf(mk, shx<M_>(mk));
      AMX(1) AMX(2) AMX(4) AMX(8) AMX(16) AMX(32)
#undef AMX
      sref = 8.0f * 1.4426950408889634f * mq * mk * 1.002f; sref = __uint_as_float((unsigned)__builtin_amdgcn_readfirstlane((int)__float_as_uint(sref))); }
#define ATTN_UNIT_L(i) ((G == 256) ? ((i) < 4 ? (((vcu >> 5) << 7) | ((i) << 5) | (vcu & 31)) : -1) : ((i) * G + bx < 1024 ? (i) * G + bx : -1))
#define ATTN_DESC(L) ((((L) >> 7) >> 1) << 16 | (4 * (((L) >> 7) & 1) + (((L) >> 5) & 3)) << 8 | ((L) & 31))
    attn_body::bf16x8 qr0[4], qr1[4];
    BgJob jb; jb.stride = G * 4; { const int w_ = __builtin_amdgcn_readfirstlane(ltid() >> 6); jb.next = (w_ >= 4) ? bx * 4 + w_ - 4 : BG_TOTAL; }
    int L = ATTN_UNIT_L(0);
    if (L >= 0 && (ltid() >> 6) < 4) { const int d = ATTN_DESC(L); attn_body::qfetch(qr0, qr1, AQ, d >> 16, (d >> 8) & 255, d & 255); }
    for (int i = 0; L >= 0; ++i) {
        const int Ln = ATTN_UNIT_L(i + 1);
        const int pair = L >> 7, h4 = (L >> 5) & 3, qb = L & 31;
        attn_body::attn_unit<8>(pair >> 1, 4 * (pair & 1) + h4, pair & 1, qb, AQ, O, (char*)smem, sref, pin(p, 7) + l * 64, (const float*)(p.ws + WS_ROPE), qr0, qr1, Ln >= 0 ? ATTN_DESC(Ln) : -1, p, l, jb);
        L = Ln;
    }
#undef ATTN_UNIT_L
#undef ATTN_DESC
    { const int w_ = __builtin_amdgcn_readfirstlane(ltid() >> 6) & 3; const unsigned bgl = (unsigned)(uintptr_t)smem + attn_body::LDS_BYTES + w_ * 8192; const float* bgt = (const float*)(smem + attn_body::LDS_BYTES + w_ * 8192);
      while (jb.next < BG_TOTAL) { bg_dma(p, l, jb.next, bgl); asm volatile("s_waitcnt vmcnt(0)" ::: "memory"); bg_finish(p, jb.next, bgt); jb.next += jb.stride; } }
}

constexpr int R2_GAIN = 147456, R2_SCR = R2_GAIN + 4096, R2_BIAS = R2_SCR + 8 * 8 * 36 * 4, R2_CNT = R2_BIAS + 256, R2_RN = R2_CNT + 128;
__device__ __forceinline__ void ph_row2_mfma(const P& p, int l, unsigned char* smem, bool real) {
    typedef short bf16x8_t __attribute__((ext_vector_type(8)));
    typedef float f32x4_t __attribute__((ext_vector_type(4)));
    const int tid = ltid(), lane = tid & 63, r = lane & 15, kq = lane >> 4; const int wid = __builtin_amdgcn_readfirstlane(tid >> 6);
    const bf16_t* XB = (const bf16_t*)(p.ws + WS_XB); bf16_t* XN = (bf16_t*)(p.ws + WS_XN);
    const unsigned lds0 = (unsigned)(uintptr_t)smem;
    float* gainl = (float*)(smem + R2_GAIN); float* scr = (float*)(smem + R2_SCR) + wid * 8 * 36; float* biasl = (float*)(smem + R2_BIAS); unsigned* lcnt = (unsigned*)(smem + R2_CNT); float* rnb = (float*)(smem + R2_RN) + wid * 16;
    const int NG = M / 16; int g = blockIdx.x * 8 + wid;
    bf16x8_t xa[32];
    if (g < NG) {
#pragma unroll
        for (int ks = 0; ks < 32; ++ks) xa[ks] = *(const bf16x8_t*)(XB + (size_t)(g * 16 + r) * 1024 + 32 * ks + 8 * kq);
    }
    { const unsigned char* img = p.ws + WS_RIMG + (size_t)l * 2 * RIMG_PART * 2;
      for (int pc = wid; pc < 144; pc += 8) attn_body::glds16(img + (size_t)pc * 1024 + lane * 16, (unsigned)__builtin_amdgcn_readfirstlane(lds0 + pc * 1024)); }
    if (tid < 256) ((float4*)gainl)[tid] = ((const float4*)(pin(p, 10) + l * 1024))[tid];
    if (tid < 32) { lcnt[tid] = 0u; biasl[tid] = pin(p, 14)[l * 32 + tid]; }
    if (tid >= 64 && tid < 68) biasl[32 + tid - 64] = pin(p, 12)[l * 4 + tid - 64];
    asm volatile("s_waitcnt vmcnt(0)" ::: "memory");
    __syncthreads();
    const __attribute__((address_space(3))) unsigned char* wl = (const __attribute__((address_space(3))) unsigned char*)smem;
    for (; g < NG; g += gridDim.x * 8) {
        const int row0 = g * 16;
        f32x4_t d0 = {0.f, 0.f, 0.f, 0.f}, d1 = d0, d2 = d0, dss = d0;
#pragma unroll
        for (int ks = 0; ks < 32; ++ks) {
            const bf16x8_t b0h = *(const __attribute__((address_space(3))) bf16x8_t*)(wl + ((0 * 32 + ks) * 64 + lane) * 16), b1h = *(const __attribute__((address_space(3))) bf16x8_t*)(wl + ((1 * 32 + ks) * 64 + lane) * 16);
            const bf16x8_t b2h = *(const __attribute__((address_space(3))) bf16x8_t*)(wl + 65536 + ((ks * 4 + kq) * 4 + (r & 3)) * 16);
            const bf16x8_t b0l = *(const __attribute__((address_space(3))) bf16x8_t*)(wl + RIMG_PART * 2 + ((0 * 32 + ks) * 64 + lane) * 16), b1l = *(const __attribute__((address_space(3))) bf16x8_t*)(wl + RIMG_PART * 2 + ((1 * 32 + ks) * 64 + lane) * 16);
            const bf16x8_t b2l = *(const __attribute__((address_space(3))) bf16x8_t*)(wl + RIMG_PART * 2 + 65536 + ((ks * 4 + kq) * 4 + (r & 3)) * 16);
            d0 = __builtin_amdgcn_mfma_f32_16x16x32_bf16(xa[ks], b0h, d0, 0, 0, 0); d1 = __builtin_amdgcn_mfma_f32_16x16x32_bf16(xa[ks], b1h, d1, 0, 0, 0); d2 = __builtin_amdgcn_mfma_f32_16x16x32_bf16(xa[ks], b2h, d2, 0, 0, 0);
            d0 = __builtin_amdgcn_mfma_f32_16x16x32_bf16(xa[ks], b0l, d0, 0, 0, 0); d1 = __builtin_amdgcn_mfma_f32_16x16x32_bf16(xa[ks], b1l, d1, 0, 0, 0); d2 = __builtin_amdgcn_mfma_f32_16x16x32_bf16(xa[ks], b2l, d2, 0, 0, 0);
            dss = __builtin_amdgcn_mfma_f32_16x16x32_bf16(xa[ks], xa[ks], dss, 0, 0, 0);
        }
        { const int i = r & 3; const float dg = (i == 0) ? dss[0] : (i == 1) ? dss[1] : (i == 2) ? dss[2] : dss[3];
          if ((r >> 2) == kq) rnb[r] = 1.0f / sqrtf(dg * (1.0f / 1024.0f) + EPS); }
        asm volatile("s_waitcnt lgkmcnt(0)" ::: "memory");
        const float rnr = rnb[r];
        const f32x4_t rnd = *(const f32x4_t*)(rnb + 4 * kq);
#pragma unroll
        for (int ks = 0; ks < 32; ++ks) {
            const float4 ga = *(const float4*)(gainl + 32 * ks + 8 * kq), gb = *(const float4*)(gainl + 32 * ks + 8 * kq + 4);
            const u32x4 x = __builtin_bit_cast(u32x4, xa[ks]); u32x4 w;
            w.x = pk2(bf2f(x.x & 0xffffu) * rnr * ga.x, bf2f(x.x >> 16) * rnr * ga.y); w.y = pk2(bf2f(x.y & 0xffffu) * rnr * ga.z, bf2f(x.y >> 16) * rnr * ga.w);
            w.z = pk2(bf2f(x.z & 0xffffu) * rnr * gb.x, bf2f(x.z >> 16) * rnr * gb.y); w.w = pk2(bf2f(x.w & 0xffffu) * rnr * gb.z, bf2f(x.w >> 16) * rnr * gb.w);
            *(u32x4*)(XN + (size_t)(row0 + r) * 1024 + 32 * ks + 8 * kq) = w;
        }
        const int gn = g + gridDim.x * 8;
        if (gn < NG) {
#pragma unroll
            for (int ks = 0; ks < 32; ++ks) xa[ks] = *(const bf16x8_t*)(XB + (size_t)(gn * 16 + r) * 1024 + 32 * ks + 8 * kq);
        }
#pragma unroll
        for (int half = 0; half < 2; ++half) {
            if ((kq >> 1) == half) {
#pragma unroll
                for (int i = 0; i < 4; ++i) { const int rl = 4 * (kq & 1) + i; const float rv = rnd[i];
                    scr[rl * 36 + r] = d0[i] * rv; scr[rl * 36 + 16 + r] = d1[i] * rv; if (r < 4) scr[rl * 36 + 32 + r] = d2[i] * rv; }
            }
            asm volatile("s_waitcnt lgkmcnt(0)" ::: "memory");
            if (lane < 8) {
                const float* lg = scr + lane * 36; const int m = row0 + 8 * half + lane;
                int gix = 0; float gm = lg[32] + biasl[32]; float gl[4]; gl[0] = gm;
#pragma unroll
                for (int q = 1; q < 4; ++q) { gl[q] = lg[32 + q] + biasl[32 + q]; if (gl[q] > gm) { gm = gl[q]; gix = q; } }
                float gs = 0.f;
#pragma unroll
                for (int q = 0; q < 4; ++q) gs += __expf(gl[q] - gm);
                const float gval = 1.0f / gs;
                float sel[8];
#pragma unroll
                for (int i = 0; i < 8; ++i) sel[i] = lg[8 * gix + i] + biasl[8 * gix + i];
                int i0 = 0; float v0 = sel[0];
#pragma unroll
                for (int i = 1; i < 8; ++i) if (sel[i] > v0) { v0 = sel[i]; i0 = i; }
                int i1 = -1; float v1 = -INFINITY;
#pragma unroll
                for (int i = 0; i < 8; ++i) if (i != i0 && sel[i] > v1) { v1 = sel[i]; i1 = i; }
                const float e1 = __expf(v1 - v0); const float w0 = gval / (1.f + e1), w1 = gval * e1 / (1.f + e1);
                const int ea_ = gix * 8 + i0, eb_ = gix * 8 + i1;
                ((int*)(p.ws + WS_TOPE))[2 * m] = ea_; ((int*)(p.ws + WS_TOPE))[2 * m + 1] = eb_;
                ((float*)(p.ws + WS_TOPW))[2 * m] = w0; ((float*)(p.ws + WS_TOPW))[2 * m + 1] = w1;
                atomicAdd(&lcnt[ea_], 1u); atomicAdd(&lcnt[eb_], 1u);
            }
            asm volatile("s_waitcnt lgkmcnt(0)" ::: "memory");
        }
    }
    __syncthreads();
    if (real && tid < 32 && lcnt[tid]) atomicAdd((unsigned*)(p.ws + WS_CTL) + CW_CNT + l * 32 + tid, lcnt[tid]);
}

namespace ml {
using attn_body::bf16x8; using attn_body::s16x4; using attn_body::f32x16; using attn_body::lds_cptr; using attn_body::vtr; using attn_body::glds16; using attn_body::crow;
constexpr size_t WS_NST = WS_CST + 64 * MiB;
constexpr size_t WS_NPV = WS_NST + 1 * MiB;
constexpr size_t WS_CPV = WS_XN;
constexpr size_t WS_MST = 17 * MiB + 65536;
constexpr float L2E = 1.4426950408889634f;
constexpr float QK_SCALE = 0.08838834764831845f;
#define ML_MFMA(a, b, c) __builtin_amdgcn_mfma_f32_32x32x16_bf16(a, b, c, 0, 0, 0)
__device__ __forceinline__ void chunk_scalars(const float* GA, int row0, int h, float* sc, float* tmp, int tid) {
    const int lane = tid & 63, wave = tid >> 6, dir = tid >> 7, jj = tid & 127, j = dir ? 127 - jj : jj;
    float x = 0.f, ig = 0.f;
    if (tid < 256) { const size_t m = (size_t)(row0 + j); ig = GA[m * 16 + 8 * dir + h]; x = GA[m * 16 + 8 * dir + 4 + h]; }
#pragma unroll
    for (int o = 1; o < 64; o <<= 1) { const float y = __uint_as_float((unsigned)__builtin_amdgcn_ds_bpermute((lane >= o ? lane - o : lane) << 2, (int)__float_as_uint(x))); if (lane >= o) x += y; }
    if (lane == 63 && tid < 256) tmp[wave] = x;
    __syncthreads();
    if (tid < 256 && (wave & 1)) x += tmp[wave - 1];
    const float u = ig - x;
    float pm = u;
#pragma unroll
    for (int o = 1; o < 64; o <<= 1) { const float y = __uint_as_float((unsigned)__builtin_amdgcn_ds_bpermute((lane >= o ? lane - o : lane) << 2, (int)__float_as_uint(pm))); if (lane >= o) pm = fmaxf(pm, y); }
    if (lane == 63 && tid < 256) tmp[8 + wave] = pm;
    __syncthreads();
    if (tid < 256) { if (wave & 1) pm = fmaxf(pm, tmp[8 + wave - 1]); sc[dir * 384 + j] = x; sc[dir * 384 + 128 + j] = u; sc[dir * 384 + 256 + j] = pm; }
}
#define ML_LBAR() asm volatile("s_waitcnt lgkmcnt(0)\n\ts_barrier" ::: "memory")
__device__ __forceinline__ void chunk_scalars_pre(float ig, float x, float* sc, float* tmp, int tid) {
    const int lane = tid & 63, wave = tid >> 6, dir = tid >> 7, jj = tid & 127, j = dir ? 127 - jj : jj;
#pragma unroll
    for (int o = 1; o < 64; o <<= 1) { const float y = __uint_as_float((unsigned)__builtin_amdgcn_ds_bpermute((lane >= o ? lane - o : lane) << 2, (int)__float_as_uint(x))); if (lane >= o) x += y; }
    if (lane == 63 && tid < 256) tmp[wave] = x;
    ML_LBAR();
    if (tid < 256 && (wave & 1)) x += tmp[wave - 1];
    const float u = ig - x;
    float pm = u;
#pragma unroll
    for (int o = 1; o < 64; o <<= 1) { const float y = __uint_as_float((unsigned)__builtin_amdgcn_ds_bpermute((lane >= o ? lane - o : lane) << 2, (int)__float_as_uint(pm))); if (lane >= o) pm = fmaxf(pm, y); }
    if (lane == 63 && tid < 256) tmp[8 + wave] = pm;
    ML_LBAR();
    if (tid < 256) { if (wave & 1) pm = fmaxf(pm, tmp[8 + wave - 1]); sc[dir * 384 + j] = x; sc[dir * 384 + 128 + j] = u; sc[dir * 384 + 256 + j] = pm; }
}
__device__ __forceinline__ bf16x8 trfrag(lds_cptr p) { const s16x4 lo = vtr(p), hi = vtr(p + 512); return (bf16x8){lo[0], lo[1], lo[2], lo[3], hi[0], hi[1], hi[2], hi[3]}; }
__device__ __forceinline__ bf16x8 scale8(bf16x8 f, const float4 wa, const float4 wb) {
    const u32x4 x = __builtin_bit_cast(u32x4, f); u32x4 o;
    o.x = pk2(bf2f(x.x & 0xffffu) * wa.x, bf2f(x.x >> 16) * wa.y); o.y = pk2(bf2f(x.y & 0xffffu) * wa.z, bf2f(x.y >> 16) * wa.w);
    o.z = pk2(bf2f(x.z & 0xffffu) * wb.x, bf2f(x.z >> 16) * wb.y); o.w = pk2(bf2f(x.w & 0xffffu) * wb.z, bf2f(x.w >> 16) * wb.w);
    return __builtin_bit_cast(bf16x8, o);
}
__device__ __forceinline__ void dma_vlayout(const bf16_t* src  , unsigned dst, int wid, int lane) {
#pragma unroll
    for (int q = 0; q < 4; ++q) { const int pc = wid * 4 + q, db = pc >> 3, kg = pc & 7;
        glds16(src + (size_t)(16 * kg + (lane >> 2)) * 1024 + 32 * db + 8 * (lane & 3), (unsigned)__builtin_amdgcn_readfirstlane(dst + db * 8192 + kg * 1024)); }
}
__device__ __forceinline__ void dma_klayout(const bf16_t* src, unsigned dst, int wid, int lane) {
#pragma unroll
    for (int q = 0; q < 4; ++q) { const int pc = wid * 4 + q, ch = pc >> 1, hf = pc & 1;
        glds16(src + (size_t)(64 * hf + lane) * 1024 + 8 * ch, (unsigned)__builtin_amdgcn_readfirstlane(dst + ch * 2048 + hf * 1024)); }
}
__device__ __forceinline__ void dma_linear32k(const unsigned char* src, unsigned dst, int wid, int lane) {
#pragma unroll
    for (int q = 0; q < 4; ++q) { const int pc = wid * 4 + q; glds16(src + pc * 1024 + lane * 16, (unsigned)__builtin_amdgcn_readfirstlane(dst + pc * 1024)); }
}

__device__ __forceinline__ void m1_chunk(const P& p, int l, unsigned char* smem, int rc) {
    const int tid = ltid(), lane = tid & 63, r32 = lane & 31, hi = lane >> 5; const int wid = __builtin_amdgcn_readfirstlane(tid >> 6);
    const bf16_t* QKC = (const bf16_t*)(p.ws + WS_QKC); const bf16_t* MVO = (const bf16_t*)(p.ws + WS_MVO); const float* GA = (const float*)(p.ws + WS_GATES);
    unsigned char* CST = p.ws + WS_CST; float* NST = (float*)(p.ws + WS_NST); float* MST = (float*)(p.ws + WS_MST);
    const unsigned lds0 = (unsigned)(uintptr_t)smem;
    float* sc = (float*)(smem + LDS_RING + 256); float* wts = sc + 768; float* tmp = wts + 256;
    const int laddr = ((lane >> 4) & 1) * 32 + (lane & 3) * 8 + (4 * hi + ((lane & 15) >> 2)) * 64;
    const int b = rc >> 6, c = rc & 63, row0 = b * SEQ + c * 128;
    dma_vlayout(QKC + (size_t)row0 * 1024 + 512, lds0, wid, lane);
    dma_vlayout(MVO + (size_t)row0 * 1024, lds0 + 32768, wid, lane);
    for (int h = 0; h < 4; ++h) {
        const int unit = (b * 4 + h) * 64 + c;
        const unsigned boff = (unsigned)(h & 1) * 65536u;
        const lds_cptr s3 = (lds_cptr)smem + boff;
        __syncthreads();
        chunk_scalars(GA, row0, h, sc, tmp, tid);
        __syncthreads();
        if (tid < 256) { const int dir = tid >> 7, j = tid & 127; const float umax = sc[dir * 384 + 256 + (dir ? 0 : 127)]; wts[dir * 128 + j] = __expf(sc[dir * 384 + 128 + j] - umax);
            if (j == 0) { const float blast = sc[dir * 384 + (dir ? 0 : 127)]; MST[(unit * 2 + dir) * 4] = blast + umax; MST[(unit * 2 + dir) * 4 + 1] = blast; } }
        if (h < 3) { dma_vlayout(QKC + (size_t)row0 * 1024 + 512 + 128 * (h + 1), lds0 + (65536u - boff), wid, lane);
                     dma_vlayout(MVO + (size_t)row0 * 1024 + 128 * (h + 1), lds0 + (65536u - boff) + 32768, wid, lane);
                     asm volatile("s_waitcnt vmcnt(8)" ::: "memory"); }
        else asm volatile("s_waitcnt vmcnt(0)" ::: "memory");
        __syncthreads();
        const int vb = wid & 3, kb0 = 2 * (wid >> 2), kbn = wid & 3, dirn = wid >> 2;
        f32x16 a00 = {}, a01 = {}, a10 = {}, a11 = {}, an = {};
#pragma unroll 2
        for (int ks = 0; ks < 8; ++ks) {
            const bf16x8 vf = trfrag(s3 + 32768 + vb * 8192 + ks * 1024 + laddr);
            const bf16x8 k0 = trfrag(s3 + kb0 * 8192 + ks * 1024 + laddr), k1 = trfrag(s3 + (kb0 + 1) * 8192 + ks * 1024 + laddr), kn = trfrag(s3 + kbn * 8192 + ks * 1024 + laddr);
            const float4 wfa = *(const float4*)(wts + 16 * ks + 4 * hi), wfb = *(const float4*)(wts + 16 * ks + 8 + 4 * hi);
            const float4 wba = *(const float4*)(wts + 128 + 16 * ks + 4 * hi), wbb = *(const float4*)(wts + 128 + 16 * ks + 8 + 4 * hi);
            const bf16x8 vff = scale8(vf, wfa, wfb), vfb = scale8(vf, wba, wbb);
            a00 = ML_MFMA(k0, vff, a00); a01 = ML_MFMA(k1, vff, a01); a10 = ML_MFMA(k0, vfb, a10); a11 = ML_MFMA(k1, vfb, a11);
            const float4 wna = dirn ? wba : wfa, wnb = dirn ? wbb : wfb;
            u32x4 wn; wn.x = pk2(wna.x, wna.y); wn.y = pk2(wna.z, wna.w); wn.z = pk2(wnb.x, wnb.y); wn.w = pk2(wnb.z, wnb.w);
            if (r32 != 0) wn = (u32x4){0u, 0u, 0u, 0u};
            an = ML_MFMA(kn, __builtin_bit_cast(bf16x8, wn), an);
        }
#pragma unroll
        for (int dir = 0; dir < 2; ++dir)
#pragma unroll
            for (int kk = 0; kk < 2; ++kk) { const f32x16& a = dir ? (kk ? a11 : a10) : (kk ? a01 : a00); unsigned char* img = CST + (size_t)(unit * 2 + dir) * 32768;
#pragma unroll
                for (int g = 0; g < 4; ++g) { u32x2 w; w.x = pk2(a[4 * g], a[4 * g + 1]); w.y = pk2(a[4 * g + 2], a[4 * g + 3]);
                    *(u32x2*)(img + (4 * (kb0 + kk) + g) * 2048 + (32 * vb + r32) * 16 + 8 * hi) = w; } }
        if (r32 == 0) {
#pragma unroll
            for (int r = 0; r < 16; ++r) NST[(size_t)(unit * 2 + dirn) * 128 + 32 * kbn + crow(r, hi)] = an[r]; }
    }
}

__device__ __forceinline__ void ph_m2(const P& p, int l, unsigned char* smem) {
    const int tid = ltid();
    unsigned char* CST = p.ws + WS_CST; float* NST = (float*)(p.ws + WS_NST); float* MST = (float*)(p.ws + WS_MST);
    unsigned char* CPV = p.ws + WS_CPV; float* NPV = (float*)(p.ws + WS_NPV);
    float* dold = (float*)smem; float* dnew = dold + 64; float* mpv = dnew + 64; float* ml = mpv + 64; float* bl = ml + 64;
    for (int item = blockIdx.x; item < 256; item += gridDim.x) {
        const int chain = item >> 3, slice = item & 7, bh = chain >> 1, dir = chain & 1;
        __syncthreads();
        if (tid < 64) { const int unit = bh * 64 + tid; ml[tid] = MST[(unit * 2 + dir) * 4]; bl[tid] = MST[(unit * 2 + dir) * 4 + 1]; }
        __syncthreads();
        if (tid < 64) {
            const int c = dir ? 63 - tid : tid; const float b = bl[c], mlv = ml[c];
            float Bi = b;
#pragma unroll
            for (int o = 1; o < 64; o <<= 1) { const float y = __uint_as_float((unsigned)__builtin_amdgcn_ds_bpermute((tid >= o ? tid - o : tid) << 2, (int)__float_as_uint(Bi))); if (tid >= o) Bi += y; }
            float rm = mlv - Bi;
#pragma unroll
            for (int o = 1; o < 64; o <<= 1) { const float y = __uint_as_float((unsigned)__builtin_amdgcn_ds_bpermute((tid >= o ? tid - o : tid) << 2, (int)__float_as_uint(rm))); if (tid >= o) rm = fmaxf(rm, y); }
            const float mn = Bi + fmaxf(0.f, rm);
            float m = __uint_as_float((unsigned)__builtin_amdgcn_ds_bpermute((tid >= 1 ? tid - 1 : tid) << 2, (int)__float_as_uint(mn))); if (tid == 0) m = 0.f;
            mpv[c] = m; dold[c] = __expf(b + m - mn); dnew[c] = __expf(mlv - mn); }
        __syncthreads();
        float c0 = 0.f, c1 = 0.f, c2 = 0.f, c3 = 0.f, nn = 0.f;
        const size_t eoff = (size_t)slice * 4096 + (size_t)tid * 8;
#pragma unroll 8
        for (int s = 0; s < 64; ++s) {
            const int c = dir ? 63 - s : s; const int unit = bh * 64 + c;
            const u32x2 v = *(const u32x2*)(CST + (size_t)(unit * 2 + dir) * 32768 + eoff); const float fo = dold[c], fn = dnew[c];
            u32x2 o; o.x = pk2(c0, c1); o.y = pk2(c2, c3); *(u32x2*)(CPV + (size_t)(unit * 2 + dir) * 32768 + eoff) = o;
            c0 = c0 * fo + bf2f(v.x & 0xffffu) * fn; c1 = c1 * fo + bf2f(v.x >> 16) * fn; c2 = c2 * fo + bf2f(v.y & 0xffffu) * fn; c3 = c3 * fo + bf2f(v.y >> 16) * fn;
            if (slice == 0 && tid < 128) { const float nv = NST[(size_t)(unit * 2 + dir) * 128 + tid]; NPV[(size_t)(unit * 2 + dir) * 128 + tid] = nn; nn = nn * fo + nv * fn; }
        }
        if (slice == 0 && tid < 64) MST[((bh * 64 + tid) * 2 + dir) * 4 + 2] = mpv[tid];
    }
}

__device__ __forceinline__ void ph_m3(const P& p, int l, unsigned char* smem) {
    const int tid = ltid(), lane = tid & 63, r32 = lane & 31, hi = lane >> 5; const int wid = __builtin_amdgcn_readfirstlane(tid >> 6);
    const int rb = wid >> 1, vh = wid & 1;
    const bf16_t* QKC = (const bf16_t*)(p.ws + WS_QKC); const bf16_t* MVO = (const bf16_t*)(p.ws + WS_MVO); const float* GA = (const float*)(p.ws + WS_GATES);
    const unsigned char* CST = p.ws + WS_CPV; const float* NST = (const float*)(p.ws + WS_NPV); const float* MST = (const float*)(p.ws + WS_MST);
    bf16_t* HM = (bf16_t*)(p.ws + WS_R1); const float* mg = pin(p, 6) + l * 512;
    const unsigned lds0 = (unsigned)(uintptr_t)smem;
    float* sc = (float*)(smem + LDS_RING + 256); float* Mi = sc + 768; float* ew = Mi + 256; float* npv = ew + 256; float* tmp = npv + 256; float* wsf = tmp + 16 + wid * 64;
    float* Aw = tmp + 16 + 512; float* Bw = Aw + 256;
    float* stg = (float*)smem;
    const lds_cptr s3 = (lds_cptr)smem;
    const int laddr = ((lane >> 4) & 1) * 32 + (lane & 3) * 8 + (4 * hi + ((lane & 15) >> 2)) * 64;
    float pre_ig = 0.f, pre_x = 0.f, pre_mp = 0.f, pre_nst = 0.f;
#define M3_PRELOAD(U) do { const int u_ = (U); if (u_ < 1024 && tid < 256) { const int d_ = tid >> 7, jj_ = tid & 127, j_ = d_ ? 127 - jj_ : jj_, h_ = (u_ >> 6) & 3; const size_t m_ = (size_t)((u_ >> 8) * SEQ + (u_ & 63) * 128 + j_); \
        pre_ig = GA[m_ * 16 + 8 * d_ + h_]; pre_x = GA[m_ * 16 + 8 * d_ + 4 + h_]; pre_mp = MST[(u_ * 2 + d_) * 4 + 2]; pre_nst = NST[(size_t)(u_ * 2 + d_) * 128 + jj_]; } } while (0)
    M3_PRELOAD(blockIdx.x);
    for (int unit = blockIdx.x; unit < 1024; unit += gridDim.x) {
        const int b = unit >> 8, h = (unit >> 6) & 3, c = unit & 63, row0 = b * SEQ + c * 128;
        const float cur_ig = pre_ig, cur_x = pre_x, cur_mp = pre_mp, cur_nst = pre_nst;
        ML_LBAR();
        dma_klayout(QKC + (size_t)row0 * 1024 + 512 + 128 * h, lds0, wid, lane);
        dma_vlayout(MVO + (size_t)row0 * 1024 + 128 * h, lds0 + 32768, wid, lane);
        dma_linear32k(CST + (size_t)(unit * 2) * 32768, lds0 + 65536, wid, lane);
        dma_linear32k(CST + (size_t)(unit * 2 + 1) * 32768, lds0 + 98304, wid, lane);
        bf16x8 qr[8];
#pragma unroll
        for (int ks = 0; ks < 8; ++ks) qr[ks] = *(const bf16x8*)(QKC + (size_t)(row0 + 32 * rb + r32) * 1024 + 128 * h + 16 * ks + 8 * hi);
        chunk_scalars_pre(cur_ig, cur_x, sc, tmp, tid);
        ML_LBAR();
        if (tid < 256) { const int dir = tid >> 7, j = tid & 127; const float mp = cur_mp; const float Mx = fmaxf(sc[dir * 384 + 256 + j], mp);
            Mi[dir * 128 + j] = Mx; ew[dir * 128 + j] = __expf(mp - Mx) * QK_SCALE; npv[dir * 128 + j] = cur_nst;
            const float umax = sc[dir * 384 + 256 + (dir ? 0 : 127)];
            Aw[dir * 128 + j] = __expf(sc[dir * 384 + 128 + j] - umax);
            Bw[dir * 128 + j] = __expf(fminf(umax - Mx, 80.f)) * QK_SCALE; }
        asm volatile("s_waitcnt vmcnt(0)" ::: "memory");
        __syncthreads();
        M3_PRELOAD(unit + (int)gridDim.x);
        f32x16 hacc[2]; hacc[0] = f32x16{}; hacc[1] = f32x16{};
#pragma unroll 1
        for (int dir = 0; dir < 2; ++dir) {
            const lds_cptr Cimg = s3 + 65536 + dir * 32768;
            f32x16 o[2]; o[0] = f32x16{}; o[1] = f32x16{};
#pragma unroll
            for (int kb = 0; kb < 8; kb += 4) {
                bf16x8 cf[4][2];
#pragma unroll
                for (int k2 = 0; k2 < 4; ++k2)
#pragma unroll
                    for (int blk = 0; blk < 2; ++blk) cf[k2][blk] = *(const __attribute__((address_space(3))) bf16x8*)(Cimg + (2 * (kb + k2) + hi) * 2048 + (32 * (2 * vh + blk) + r32) * 16);
#pragma unroll
                for (int k2 = 0; k2 < 4; ++k2)
#pragma unroll
                    for (int blk = 0; blk < 2; ++blk) o[blk] = ML_MFMA(qr[kb + k2], cf[k2][blk], o[blk]);
                asm volatile("" ::: "memory");
            }
#pragma unroll
            for (int g = 0; g < 4; ++g) { const float4 e4 = *(const float4*)(ew + dir * 128 + 32 * rb + 8 * g + 4 * hi);
#pragma unroll
                for (int blk = 0; blk < 2; ++blk) { o[blk][4 * g] *= e4.x; o[blk][4 * g + 1] *= e4.y; o[blk][4 * g + 2] *= e4.z; o[blk][4 * g + 3] *= e4.w; } }
            float dq = 0.f;
#pragma unroll
            for (int ks = 0; ks < 8; ++ks) { const u32x4 x = __builtin_bit_cast(u32x4, qr[ks]); const float4 na = *(const float4*)(npv + dir * 128 + 16 * ks + 8 * hi), nb2 = *(const float4*)(npv + dir * 128 + 16 * ks + 8 * hi + 4);
                dq += bf2f(x.x & 0xffffu) * na.x + bf2f(x.x >> 16) * na.y + bf2f(x.y & 0xffffu) * na.z + bf2f(x.y >> 16) * na.w + bf2f(x.z & 0xffffu) * nb2.x + bf2f(x.z >> 16) * nb2.y + bf2f(x.w & 0xffffu) * nb2.z + bf2f(x.w >> 16) * nb2.w; }
            dq += shx<32>(dq);
            const float Mrow = Mi[dir * 128 + 32 * rb + r32]; const float Brow = Bw[dir * 128 + 32 * rb + r32];
            float dsum = 0.f;
            const int jt0 = dir ? rb : 0, jt1 = dir ? 3 : rb;
            for (int jt = jt0; jt <= jt1; ++jt) {
                f32x16 pt = f32x16{};
                bf16x8 kf[8], vfr[2][2];
#pragma unroll
                for (int ks = 0; ks < 8; ++ks) kf[ks] = *(const __attribute__((address_space(3))) bf16x8*)(s3 + (2 * ks + hi) * 2048 + (32 * jt + r32) * 16);
#pragma unroll
                for (int blk = 0; blk < 2; ++blk) { vfr[blk][0] = trfrag(s3 + 32768 + (2 * vh + blk) * 8192 + (2 * jt) * 1024 + laddr); vfr[blk][1] = trfrag(s3 + 32768 + (2 * vh + blk) * 8192 + (2 * jt + 1) * 1024 + laddr); }
#pragma unroll
                for (int ks = 0; ks < 8; ++ks) pt = ML_MFMA(kf[ks], qr[ks], pt);
                const bool diag = (jt == rb);
#pragma unroll
                for (int g = 0; g < 4; ++g) { const float4 a4 = *(const float4*)(Aw + dir * 128 + 32 * jt + 8 * g + 4 * hi);
#pragma unroll
                    for (int i = 0; i < 4; ++i) { const int kl = 8 * g + 4 * hi + i; const float aa = (i == 0) ? a4.x : (i == 1) ? a4.y : (i == 2) ? a4.z : a4.w;
                        const bool ok = !diag || (dir ? (kl >= r32) : (kl <= r32));
                        const float pv = ok ? pt[4 * g + i] * (aa * Brow) : 0.f; pt[4 * g + i] = pv; dsum += pv; } }
                u32x4 pw0, pw1;
                pw0.x = pk2(pt[0], pt[1]); pw0.y = pk2(pt[2], pt[3]); pw0.z = pk2(pt[4], pt[5]); pw0.w = pk2(pt[6], pt[7]);
                pw1.x = pk2(pt[8], pt[9]); pw1.y = pk2(pt[10], pt[11]); pw1.z = pk2(pt[12], pt[13]); pw1.w = pk2(pt[14], pt[15]);
#pragma unroll
                for (int blk = 0; blk < 2; ++blk) { o[blk] = ML_MFMA(__builtin_bit_cast(bf16x8, pw0), vfr[blk][0], o[blk]); o[blk] = ML_MFMA(__builtin_bit_cast(bf16x8, pw1), vfr[blk][1], o[blk]); }
            }
            dsum += shx<32>(dsum);
            const float den = dsum + dq * ew[dir * 128 + 32 * rb + r32];
            const float mrow = sc[dir * 384 + 32 * rb + r32] + Mrow;
            const float rinv = 1.0f / fmaxf(fabsf(den), __expf(-mrow));
            asm volatile("s_waitcnt lgkmcnt(0)" ::: "memory");
            if (hi == 0) wsf[r32] = rinv;
            asm volatile("s_waitcnt lgkmcnt(0)" ::: "memory");
#pragma unroll
            for (int r = 0; r < 16; ++r) { const float rv = wsf[crow(r, hi)]; hacc[0][r] += o[0][r] * rv; hacc[1][r] += o[1][r] * rv; }
            asm volatile("s_waitcnt lgkmcnt(0)" ::: "memory");
        }
        u32x4 mog[4]; float4 gqa[4], gqb[4];
        { const bf16_t* mo_ = MVO + (size_t)(row0 + (tid >> 2)) * 1024 + 512 + 128 * h + 32 * (tid & 3); const float* gp_ = mg + 128 * h + 32 * (tid & 3);
#pragma unroll
          for (int q = 0; q < 4; ++q) { mog[q] = *(const u32x4*)(mo_ + 8 * q); gqa[q] = gld4(gp_ + 8 * q); gqb[q] = gld4(gp_ + 8 * q + 4); } }
        ML_LBAR();
#pragma unroll
        for (int blk = 0; blk < 2; ++blk)
#pragma unroll
            for (int r = 0; r < 16; ++r) stg[(32 * rb + crow(r, hi)) * 132 + 64 * vh + 32 * blk + r32] = hacc[blk][r];
        ML_LBAR();
        { const int row = tid >> 2, q4 = tid & 3; float v[32];
#pragma unroll
          for (int q = 0; q < 8; ++q) { const float4 t = *(const float4*)(stg + row * 132 + 32 * q4 + 4 * q); v[4 * q] = t.x; v[4 * q + 1] = t.y; v[4 * q + 2] = t.z; v[4 * q + 3] = t.w; }
          float ss = 0.f;
#pragma unroll
          for (int q = 0; q < 32; ++q) ss += v[q] * v[q];
          ss += shx<1>(ss); ss += shx<2>(ss);
          const float rn = 1.0f / sqrtf(ss * (1.0f / 128.0f) + EPS);
          bf16_t* op = HM + (size_t)(row0 + row) * 1024 + 128 * h + 32 * q4; const float* gp = mg + 128 * h + 32 * q4;
#pragma unroll
          for (int q = 0; q < 4; ++q) { float f[8]; unpack8(mog[q], f); u32x4 w; const float4 ga_ = gqa[q], gb_ = gqb[q]; const float gq[8] = {ga_.x, ga_.y, ga_.z, ga_.w, gb_.x, gb_.y, gb_.z, gb_.w};
              w.x = pk2(v[8 * q] * rn * gq[0] * sigmoid_f(f[0]), v[8 * q + 1] * rn * gq[1] * sigmoid_f(f[1]));
              w.y = pk2(v[8 * q + 2] * rn * gq[2] * sigmoid_f(f[2]), v[8 * q + 3] * rn * gq[3] * sigmoid_f(f[3]));
              w.z = pk2(v[8 * q + 4] * rn * gq[4] * sigmoid_f(f[4]), v[8 * q + 5] * rn * gq[5] * sigmoid_f(f[5]));
              w.w = pk2(v[8 * q + 6] * rn * gq[6] * sigmoid_f(f[6]), v[8 * q + 7] * rn * gq[7] * sigmoid_f(f[7]));
              *(u32x4*)(op + 8 * q) = w; } }
    }
}
#undef ML_MFMA
}

__device__ __forceinline__ void ph_prep(const P& p, int l, unsigned char* smem) {
    const int tid = ltid();
    const bf16_t* R1 = (const bf16_t*)(p.ws + WS_R1); bf16_t* QKC = (bf16_t*)(p.ws + WS_QKC);
    bf16_t* AQ = (bf16_t*)(p.ws + WS_AQKV);
    const int tq0 = blockIdx.x * 512 + tid, tqs = gridDim.x * 512;
    u32x4 pre_a[2], pre_b[2];
#pragma unroll
    for (int i = 0; i < 2; ++i) { const int tq = tq0 + i * tqs; pre_a[i] = (u32x4){0u, 0u, 0u, 0u}; pre_b[i] = pre_a[i];
        if (tq < M * 2 * 4) { const int task = tq >> 2, q = tq & 3, m = task >> 1, hh = 8 + (task & 1); const bf16_t* ptr = AQ + (size_t)m * 768 + 64 * hh + 16 * q; pre_a[i] = *(const u32x4*)ptr; pre_b[i] = *(const u32x4*)(ptr + 8); } }
    {
        const int c8 = (tid & 127) * 8, rg = tid >> 7;
        const float* cw = pin(p, 3) + (size_t)l * 3 * 1024 + c8; const float* cb = pin(p, 4) + (size_t)l * 1024 + c8;
        float w0[8], w1[8], w2[8], bb[8];
#pragma unroll
        for (int q = 0; q < 8; ++q) { w0[q] = cw[q]; w1[q] = cw[1024 + q]; w2[q] = cw[2048 + q]; bb[q] = cb[q]; }
        for (int rc = blockIdx.x; rc < M / 128; rc += gridDim.x) {
            const int m0 = rc * 128 + rg * 32;
            float xm[8], xc[8], xp[8];
            if ((m0 & (SEQ - 1)) > 0) unpack8(*(const u32x4*)(R1 + (size_t)(m0 - 1) * 1024 + c8), xm); else {
#pragma unroll
                for (int q = 0; q < 8; ++q) xm[q] = 0.f; }
            unpack8(*(const u32x4*)(R1 + (size_t)m0 * 1024 + c8), xc);
            u32x4 qn[4]; bool okq[4];
#pragma unroll
            for (int u = 0; u < 4; ++u) { const int mm = m0 + 1 + u; const bool ok_ = (mm & (SEQ - 1)) != 0; int mc_ = ok_ ? mm : m0; asm volatile("" : "+v"(mc_)); u32x4 t_ = *(const u32x4*)(R1 + (size_t)mc_ * 1024 + c8); qn[u] = t_; okq[u] = ok_; }
            for (int i = 0; i < 32; i += 4) {
#pragma unroll
                for (int u = 0; u < 4; ++u) {
                    const int m = m0 + i + u;
                    unpack8(qn[u], xp); if (!okq[u]) {
#pragma unroll
                        for (int q = 0; q < 8; ++q) xp[q] = 0.f; }
                    { const int mm = m + 5; const bool ok_ = (i + u + 5 <= 32 && (mm & (SEQ - 1)) != 0); int mc_ = ok_ ? mm : m0; asm volatile("" : "+v"(mc_)); u32x4 t_ = *(const u32x4*)(R1 + (size_t)mc_ * 1024 + c8); qn[u] = t_; okq[u] = ok_; }
                    float o[8];
#pragma unroll
                    for (int q = 0; q < 8; ++q) o[q] = silu_f(w0[q] * xm[q] + w1[q] * xc[q] + w2[q] * xp[q] + bb[q]);
                    u32x4 w; w.x = pk2(o[0], o[1]); w.y = pk2(o[2], o[3]); w.z = pk2(o[4], o[5]); w.w = pk2(o[6], o[7]);
                    *(u32x4*)(QKC + (size_t)m * 1024 + c8) = w;
#pragma unroll
                    for (int q = 0; q < 8; ++q) { xm[q] = xc[q]; xc[q] = xp[q]; }
                }
            }
            asm volatile("s_waitcnt vmcnt(0)" ::: "memory");
            __syncthreads();
            ml::m1_chunk(p, l, smem, rc);
        }
    }
    const float* rope = (const float*)(p.ws + WS_ROPE);
    const float* kg = pin(p, 8) + l * 64;
    int it = 0;
    for (int tq = tq0; tq < M * 2 * 4; tq += tqs, ++it) {
        const int task = tq >> 2, q = tq & 3, m = task >> 1, hh = 8 + (task & 1);
        bf16_t* ptr = AQ + (size_t)m * 768 + 64 * hh + 16 * q;
        float v[16];
        if (it == 0) { unpack8(pre_a[0], v); unpack8(pre_b[0], v + 8); } else if (it == 1) { unpack8(pre_a[1], v); unpack8(pre_b[1], v + 8); }
        else { unpack8(*(const u32x4*)ptr, v); unpack8(*(const u32x4*)(ptr + 8), v + 8); }
        float ss = 0.f;
#pragma unroll
        for (int d = 0; d < 16; ++d) ss += v[d] * v[d];
        ss += shx<1>(ss); ss += shx<2>(ss);
        const float r = 1.0f / sqrtf(ss * (1.0f / 64.0f) + EPS);
        const int t = m & (SEQ - 1), pos = (q >> 1) ? (t & 63) : (t >> 6);
        const float2* rp = (const float2*)rope + pos * 16;
        const bool up = (q & 1) != 0;
        float kgv[16]; { const float4 k0_ = gld4(kg + 16 * q), k1_ = gld4(kg + 16 * q + 4), k2_ = gld4(kg + 16 * q + 8), k3_ = gld4(kg + 16 * q + 12);
          kgv[0] = k0_.x; kgv[1] = k0_.y; kgv[2] = k0_.z; kgv[3] = k0_.w; kgv[4] = k1_.x; kgv[5] = k1_.y; kgv[6] = k1_.z; kgv[7] = k1_.w; kgv[8] = k2_.x; kgv[9] = k2_.y; kgv[10] = k2_.z; kgv[11] = k2_.w; kgv[12] = k3_.x; kgv[13] = k3_.y; kgv[14] = k3_.z; kgv[15] = k3_.w; }
#pragma unroll
        for (int d = 0; d < 16; ++d) { const float x = v[d] * r * kgv[d]; const float o = shx<1>(x); const float2 cs = rp[d]; v[d] = x * cs.x + (up ? o : -o) * cs.y; }
        u32x4 w0, w1;
        w0.x = pk2(v[0], v[1]); w0.y = pk2(v[2], v[3]); w0.z = pk2(v[4], v[5]); w0.w = pk2(v[6], v[7]);
        w1.x = pk2(v[8], v[9]); w1.y = pk2(v[10], v[11]); w1.z = pk2(v[12], v[13]); w1.w = pk2(v[14], v[15]);
        *(u32x4*)ptr = w0; *(u32x4*)(ptr + 8) = w1;
    }
}

namespace pg8 {
#define PG8_LAS __attribute__((address_space(3)))
typedef short bf16x8 __attribute__((ext_vector_type(8)));
typedef float f32x4 __attribute__((ext_vector_type(4)));
constexpr int BM = 256, BK = 64, HALF = 128, HTB = HALF * BK * 2, STAGE_BYTES = 8 * HTB, NXCD = 8, WGM = 4;
__host__ __device__ __forceinline__ int lds_byte(int r, int c) { const int st = (r >> 4) * 2 + (c >> 5), rr = r & 15, cc = c & 31, ob = rr * 64 + cc * 2; return st * 1024 + (ob ^ (((ob >> 9) & 1) << 5)); }
__host__ __device__ __forceinline__ void stage_rc(int b, int& R, int& C) { const int st = b / 1024, sb = b % 1024, swz = sb ^ (((sb >> 9) & 1) << 5); R = (st >> 1) * 16 + swz / 64; C = (st & 1) * 32 + (swz % 64) / 2; }
__host__ __device__ __forceinline__ int perm32(int rho) { const int n = rho >> 4, i = rho & 15; return 8 * (i >> 2) + 4 * n + (i & 3); }
struct Unit { int pm, pn, e; };
struct Gemm { const bf16_t* A; const bf16_t* Bt; int K; size_t bstride; const int* rowtok; };
struct StaticOrder {
    int nM, nN, nwg, G, c;
    __device__ void init(int M_, int N_, int G_, int c_) { nM = M_ / BM; nN = N_ / BM; nwg = nM * nN; G = G_; c = c_; }
    __device__ bool next(int i, Unit& u) const {
        const long L = (long)i * G + c; if (L >= nwg) return false;
        int wgid = (int)L; { const int q = nwg / NXCD, r = nwg % NXCD, xcd = wgid % NXCD, off = wgid / NXCD; wgid = (xcd < r ? xcd * (q + 1) : r * (q + 1) + (xcd - r) * q) + off; }
        const int nig = WGM * nN, gid = wgid / nig, fm = gid * WGM, gsz = (nM - fm) < WGM ? (nM - fm) : WGM;
        u.pm = fm + ((wgid % nig) % gsz); u.pn = (wgid % nig) / gsz; u.e = 0; return true;
    }
};
struct MoeOrder {
    const PG8_LAS int* ps; int G, c, cb;
    __device__ bool next(int i, Unit& u) const {
        const int total = __builtin_amdgcn_readfirstlane(ps[32]);
        const int full = (total >> 6) / G;
        const int L = i * G + (i >= full ? cb : c), mt = L >> 2, s0 = mt * 256;
        if (s0 >= total) return false;
        int e = 0;
#pragma unroll
        for (int q = 1; q < 32; ++q) e += (s0 >= ps[q]) ? 1 : 0;
        u.pm = mt; u.pn = L & 3; u.e = __builtin_amdgcn_readfirstlane(e); return true;
    }
};
__device__ __forceinline__ unsigned cvt_pk_bf16(float lo, float hi) { unsigned r; asm volatile("v_cvt_pk_bf16_f32 %0, %1, %2" : "=v"(r) : "v"(lo), "v"(hi)); return r; }

struct EpiInproj {
    static constexpr bool PERM = true;
    bf16_t* R1; bf16_t* MVO; bf16_t* AQKV;
    __device__ __forceinline__ void operator()(const f32x4 (&acc)[2][2][4][2], const Unit& u, int wr, int wc, int fr, int fq) const {
        bf16_t* base; int ldc, colt;
        if (u.pn < 4) { base = R1; ldc = 1024; colt = u.pn * 256; } else if (u.pn < 8) { base = MVO; ldc = 1024; colt = (u.pn - 4) * 256; } else { base = AQKV; ldc = 768; colt = (u.pn - 8) * 256; }
        const int row0 = u.pm * BM + wr * 64 + fr, col0 = colt + wc * 32 + 8 * fq;
#pragma unroll
        for (int ai = 0; ai < 2; ++ai)
#pragma unroll
            for (int m = 0; m < 4; ++m) { bf16_t* rowp = base + (size_t)(row0 + ai * HALF + m * 16) * ldc + col0;
#pragma unroll
                for (int bj = 0; bj < 2; ++bj) { const f32x4 v0 = acc[ai][bj][m][0], v1 = acc[ai][bj][m][1];
                    u32x4 w; w.x = cvt_pk_bf16(v0[0], v0[1]); w.y = cvt_pk_bf16(v0[2], v0[3]); w.z = cvt_pk_bf16(v1[0], v1[1]); w.w = cvt_pk_bf16(v1[2], v1[3]);
                    *(u32x4*)(rowp + bj * HALF) = w; } }
    }
};
struct EpiOutproj {
    static constexpr bool PERM = true;
    const bf16_t* xres; bf16_t* out;
    __device__ __forceinline__ void operator()(const f32x4 (&acc)[2][2][4][2], const Unit& u, int wr, int wc, int fr, int fq) const {
        const int row0 = u.pm * BM + wr * 64 + fr, col0 = u.pn * BM + wc * 32 + 8 * fq;
        u32x4 rb[2][4][2];
#pragma unroll
        for (int ai = 0; ai < 2; ++ai)
#pragma unroll
            for (int m = 0; m < 4; ++m) { const size_t off = (size_t)(row0 + ai * HALF + m * 16) * 1024 + col0;
#pragma unroll
                for (int bj = 0; bj < 2; ++bj) rb[ai][m][bj] = *(const u32x4*)(xres + off + bj * HALF); }
        asm volatile("" ::: "memory");
#pragma unroll
        for (int ai = 0; ai < 2; ++ai)
#pragma unroll
            for (int m = 0; m < 4; ++m) { const size_t off = (size_t)(row0 + ai * HALF + m * 16) * 1024 + col0;
#pragma unroll
                for (int bj = 0; bj < 2; ++bj) { const f32x4 v0 = acc[ai][bj][m][0], v1 = acc[ai][bj][m][1]; const u32x4 r = rb[ai][m][bj];
                    u32x4 w; w.x = cvt_pk_bf16(v0[0] + __uint_as_float(r.x << 16), v0[1] + __uint_as_float(r.x & 0xffff0000u)); w.y = cvt_pk_bf16(v0[2] + __uint_as_float(r.y << 16), v0[3] + __uint_as_float(r.y & 0xffff0000u));
                    w.z = cvt_pk_bf16(v1[0] + __uint_as_float(r.z << 16), v1[1] + __uint_as_float(r.z & 0xffff0000u)); w.w = cvt_pk_bf16(v1[2] + __uint_as_float(r.w << 16), v1[3] + __uint_as_float(r.w & 0xffff0000u));
                    *(u32x4*)(out + off + bj * HALF) = w; } }
    }
};
struct EpiMoe1 {
    static constexpr bool PERM = true;
    bf16_t* HID;
    __device__ __forceinline__ void operator()(const f32x4 (&acc)[2][2][4][2], const Unit& u, int wr, int wc, int fr, int fq) const {
        const int row0 = u.pm * BM + wr * 64 + fr, hc0 = (u.pn * BM + wc * 32 + 8 * fq) >> 1;
#pragma unroll
        for (int ai = 0; ai < 2; ++ai)
#pragma unroll
            for (int m = 0; m < 4; ++m) { bf16_t* rowp = HID + (size_t)(row0 + ai * HALF + m * 16) * 512 + hc0;
#pragma unroll
                for (int bj = 0; bj < 2; ++bj) { const f32x4 a = acc[ai][bj][m][0], b = acc[ai][bj][m][1];
                    u32x2 w; w.x = cvt_pk_bf16(silu_f(a[0]) * b[0], silu_f(a[1]) * b[1]); w.y = cvt_pk_bf16(silu_f(a[2]) * b[2], silu_f(a[3]) * b[3]);
                    *(u32x2*)(rowp + bj * 64) = w; } }
    }
};
struct EpiMoe2 {
    static constexpr bool PERM = true;
    bf16_t* Y; const int* slot_tok; const float* slot_w;
    __device__ __forceinline__ void operator()(const f32x4 (&acc)[2][2][4][2], const Unit& u, int wr, int wc, int fr, int fq) const {
        const int row0 = u.pm * BM + wr * 64 + fr, col0 = u.pn * BM + wc * 32 + 8 * fq;
        int aid[8]; float tw[8];
#pragma unroll
        for (int q = 0; q < 8; ++q) aid[q] = slot_tok[row0 + (q >> 2) * HALF + (q & 3) * 16];
#pragma unroll
        for (int q = 0; q < 8; ++q) tw[q] = slot_w[row0 + (q >> 2) * HALF + (q & 3) * 16];
        asm volatile("" : "+v"(aid[0]), "+v"(aid[1]), "+v"(aid[2]), "+v"(aid[3]), "+v"(aid[4]), "+v"(aid[5]), "+v"(aid[6]), "+v"(aid[7]), "+v"(tw[0]), "+v"(tw[1]), "+v"(tw[2]), "+v"(tw[3]), "+v"(tw[4]), "+v"(tw[5]), "+v"(tw[6]), "+v"(tw[7]));
#pragma unroll
        for (int ai = 0; ai < 2; ++ai)
#pragma unroll
            for (int m = 0; m < 4; ++m) { const int a = aid[ai * 4 + m];
                if (a >= 0) { const float t = tw[ai * 4 + m]; bf16_t* rowp = Y + (size_t)a * 1024 + col0;
#pragma unroll
                    for (int bj = 0; bj < 2; ++bj) { const f32x4 v0 = acc[ai][bj][m][0] * t, v1 = acc[ai][bj][m][1] * t;
                        u32x4 w; w.x = cvt_pk_bf16(v0[0], v0[1]); w.y = cvt_pk_bf16(v0[2], v0[3]); w.z = cvt_pk_bf16(v1[0], v1[1]); w.w = cvt_pk_bf16(v1[2], v1[3]);
                        *(u32x4*)(rowp + bj * HALF) = w; } } }
    }
};

template <class Epi, class Sched, bool GATHER>
__device__ __forceinline__ void gemm_phase(PG8_LAS unsigned char* lds, const Gemm g, const Sched& S, const Epi& E) {
    const int tid = ltid(), wid = __builtin_amdgcn_readfirstlane(tid >> 6), lane = tid & 63, wr = wid >> 2, wc = wid & 3, fr = lane & 15, fq = lane >> 4;
    const int K = g.K, nt = K / BK;
    unsigned voffA[2], voffB[2]; int RA[2]; unsigned CA2[2];
#pragma unroll
    for (int i = 0; i < 2; ++i) { int R, C; stage_rc(tid * 16 + i * 8192, R, C); const int Rb = Epi::PERM ? ((R & ~31) + perm32(R & 31)) : R;
        voffA[i] = (unsigned)(R * K + C) * 2u; voffB[i] = (unsigned)(Rb * K + C) * 2u; RA[i] = R; CA2[i] = (unsigned)C * 2u; }
    const size_t kstep = (size_t)(BK * 2);
    const size_t hstep = (size_t)HALF * K * 2;
    const size_t tstep = 2 * hstep;
    const unsigned ldsw = (unsigned)wid * 1024u;
    const int aoff = lds_byte(wr * 64 + fr, fq * 8), boff = lds_byte(wc * 32 + fr, fq * 8);
#define PG8_SA(b, h) (((b) * 2 + (h)) * HTB)
#define PG8_SB(b, h) ((4 + (b) * 2 + (h)) * HTB)
#define PG8_STAGE(bufoff, gbase, voff) do { _Pragma("unroll") for (int _i = 0; _i < 2; ++_i) \
        __builtin_amdgcn_global_load_lds((const unsigned*)((const char*)(gbase) + (voff)[_i]), (PG8_LAS unsigned*)(lds + (bufoff) + ldsw + _i * 8192), 16, 0, 0); } while (0)
#define PG8_STAGE_A(bufoff, ptr, h, V0, V1) do { if constexpr (GATHER) { if (h) PG8_STAGE(bufoff, ptr, V1); else PG8_STAGE(bufoff, ptr, V0); } else { PG8_STAGE(bufoff, (ptr) + (h) * hstep, voffA); } } while (0)
#define PG8_LDA(dst, b, h) do { _Pragma("unroll") for (int m = 0; m < 4; ++m) _Pragma("unroll") for (int k = 0; k < 2; ++k) dst[m][k] = *(const PG8_LAS bf16x8*)(lds + PG8_SA(b, h) + aoff + m * 2048 + k * 1024); } while (0)
#define PG8_LDB(dst, b, h) do { _Pragma("unroll") for (int n = 0; n < 2; ++n) _Pragma("unroll") for (int k = 0; k < 2; ++k) dst[n][k] = *(const PG8_LAS bf16x8*)(lds + PG8_SB(b, h) + boff + n * 2048 + k * 1024); } while (0)
#define PG8_MMA(ai, bj, At, Bt) do { __builtin_amdgcn_s_setprio(1); _Pragma("unroll") for (int m = 0; m < 4; ++m) _Pragma("unroll") for (int n = 0; n < 2; ++n) _Pragma("unroll") for (int k = 0; k < 2; ++k) \
        acc[ai][bj][m][n] = __builtin_amdgcn_mfma_f32_16x16x32_bf16(Bt[n][k], At[m][k], acc[ai][bj][m][n], 0, 0, 0); __builtin_amdgcn_s_setprio(0); } while (0)
#define PG8_WAIT_V(n) asm volatile("s_waitcnt vmcnt(" #n ")" ::: "memory")
#define PG8_WAIT_L(n) asm volatile("s_waitcnt lgkmcnt(" #n ")" ::: "memory")
#define PG8_BAR __builtin_amdgcn_s_barrier()
#define PG8_SCHED __builtin_amdgcn_sched_barrier(0)
#define PG8_GOFF(D0, D1, U) do { _Pragma("unroll") for (int _i = 0; _i < 2; ++_i) { const int _s = (U).pm * BM + RA[_i]; const int _a0 = g.rowtok[_s], _a1 = g.rowtok[_s + HALF]; \
        D0[_i] = (unsigned)((_a0 >= 0 ? (_a0 >> 1) : 0) * K) * 2u + CA2[_i]; D1[_i] = (unsigned)((_a1 >= 0 ? (_a1 >> 1) : 0) * K) * 2u + CA2[_i]; } } while (0)
#define PG8_GRAW(R0, R1, U) do { _Pragma("unroll") for (int _i = 0; _i < 2; ++_i) { const int _s = (U).pm * BM + RA[_i]; R0[_i] = g.rowtok[_s]; R1[_i] = g.rowtok[_s + HALF]; } } while (0)
#define PG8_GCALC(D0, D1, R0, R1) do { _Pragma("unroll") for (int _i = 0; _i < 2; ++_i) { D0[_i] = (unsigned)((R0[_i] >= 0 ? (R0[_i] >> 1) : 0) * K) * 2u + CA2[_i]; D1[_i] = (unsigned)((R1[_i] >= 0 ? (R1[_i] >> 1) : 0) * K) * 2u + CA2[_i]; } } while (0)
    Unit cur, nxt; int ui = 0;
    int rn0[2] = {0, 0}, rn1[2] = {0, 0};
    if (!S.next(0, cur)) return;
    unsigned vc0[2] = {0u, 0u}, vc1[2] = {0u, 0u}, vn0[2] = {0u, 0u}, vn1[2] = {0u, 0u};
    if constexpr (GATHER) PG8_GOFF(vc0, vc1, cur);
    f32x4 acc[2][2][4][2];
#pragma unroll
    for (int a = 0; a < 2; ++a)
#pragma unroll
        for (int b = 0; b < 2; ++b)
#pragma unroll
            for (int m = 0; m < 4; ++m)
#pragma unroll
                for (int n = 0; n < 2; ++n) acc[a][b][m][n] = (f32x4){0.f, 0.f, 0.f, 0.f};
    bf16x8 At[4][2], B0[2][2], B1[2][2];
    const char* cA = GATHER ? (const char*)g.A : (const char*)g.A + (size_t)cur.pm * tstep;
    const char* cB = (const char*)g.Bt + (size_t)cur.e * g.bstride + (size_t)cur.pn * tstep;
    PG8_STAGE(PG8_SB(0, 0), cB, voffB); PG8_STAGE(PG8_SB(0, 1), cB + hstep, voffB); PG8_STAGE_A(PG8_SA(0, 0), cA, 0, vc0, vc1); PG8_STAGE_A(PG8_SA(0, 1), cA, 1, vc0, vc1);
    if (wr == 1) PG8_BAR;
    PG8_WAIT_V(2); PG8_BAR;
    PG8_STAGE(PG8_SB(1, 0), cB + kstep, voffB); PG8_STAGE_A(PG8_SA(1, 0), cA + kstep, 0, vc0, vc1); PG8_STAGE(PG8_SB(1, 1), cB + hstep + kstep, voffB);
    PG8_WAIT_V(6); PG8_BAR;
    for (;;) {
        const bool has_next = S.next(ui + 1, nxt);
        if constexpr (GATHER) { if (has_next) PG8_GRAW(rn0, rn1, nxt); }
        const char* nA = GATHER ? (const char*)g.A : (has_next ? (const char*)g.A + (size_t)nxt.pm * tstep : cA);
        const char* nB = has_next ? (const char*)g.Bt + (size_t)nxt.e * g.bstride + (size_t)nxt.pn * tstep : cB;
        for (int t = 0; t < nt; t += 2) {
            const bool last = (t == nt - 2);
            const char* a1 = cA + (size_t)(t + 1) * kstep;
            const char* a2 = last ? nA : cA + (size_t)(t + 2) * kstep; const char* b2 = last ? nB : cB + (size_t)(t + 2) * kstep;
            const char* a3 = a2 + kstep; const char* b3 = b2 + kstep;
            unsigned w0[2], w1[2];
            w0[0] = vc0[0]; w0[1] = vc0[1]; w1[0] = vc1[0]; w1[1] = vc1[1];
            if constexpr (GATHER) { if (last) {
                asm volatile("" : "+v"(rn0[0]), "+v"(rn0[1]), "+v"(rn1[0]), "+v"(rn1[1]));
                if (has_next) PG8_GCALC(vn0, vn1, rn0, rn1); else { vn0[0] = vc0[0]; vn0[1] = vc0[1]; vn1[0] = vc1[0]; vn1[1] = vc1[1]; }
                w0[0] = vn0[0]; w0[1] = vn0[1]; w1[0] = vn1[0]; w1[1] = vn1[1]; } }
            PG8_LDB(B0, 0, 0); PG8_LDB(B1, 0, 1); PG8_SCHED; PG8_LDA(At, 0, 0); PG8_STAGE_A(PG8_SA(1, 1), a1, 1, vc0, vc1);
            PG8_WAIT_V(8); PG8_WAIT_L(0); PG8_BAR; PG8_MMA(0, 0, At, B0); PG8_MMA(0, 1, At, B1); PG8_BAR; PG8_SCHED;
            PG8_LDA(At, 0, 1); PG8_STAGE(PG8_SB(0, 0), b2, voffB); PG8_STAGE(PG8_SB(0, 1), b2 + hstep, voffB); PG8_STAGE_A(PG8_SA(0, 0), a2, 0, w0, w1);
            PG8_WAIT_V(8); PG8_WAIT_L(0); PG8_BAR; PG8_MMA(1, 0, At, B0); PG8_MMA(1, 1, At, B1); PG8_BAR; PG8_SCHED;
            PG8_LDB(B0, 1, 0); PG8_LDB(B1, 1, 1); PG8_SCHED; PG8_LDA(At, 1, 0); PG8_STAGE_A(PG8_SA(0, 1), a2, 1, w0, w1);
            PG8_WAIT_V(8); PG8_WAIT_L(0); PG8_BAR; PG8_MMA(0, 0, At, B0); PG8_MMA(0, 1, At, B1); PG8_BAR; PG8_SCHED;
            PG8_LDA(At, 1, 1); PG8_STAGE(PG8_SB(1, 0), b3, voffB); PG8_STAGE(PG8_SB(1, 1), b3 + hstep, voffB); PG8_STAGE_A(PG8_SA(1, 0), a3, 0, w0, w1);
            PG8_WAIT_V(8); PG8_WAIT_L(0); PG8_BAR; PG8_MMA(1, 0, At, B0); PG8_MMA(1, 1, At, B1); PG8_BAR; PG8_SCHED;
        }
        if (wr == 0) PG8_BAR;
        E(acc, cur, wr, wc, fr, fq);
        if (!has_next) break;
#pragma unroll
        for (int a = 0; a < 2; ++a)
#pragma unroll
            for (int b = 0; b < 2; ++b)
#pragma unroll
                for (int m = 0; m < 4; ++m)
#pragma unroll
                    for (int n = 0; n < 2; ++n) acc[a][b][m][n] = (f32x4){0.f, 0.f, 0.f, 0.f};
        cur = nxt; cA = nA; cB = nB; ++ui;
        if constexpr (GATHER) { vc0[0] = vn0[0]; vc0[1] = vn0[1]; vc1[0] = vn1[0]; vc1[1] = vn1[1]; }
        if (wr == 1) PG8_BAR;
    }
    PG8_WAIT_V(0);
    PG8_BAR;
#undef PG8_SA
#undef PG8_SB
#undef PG8_STAGE
#undef PG8_STAGE_A
#undef PG8_LDA
#undef PG8_LDB
#undef PG8_MMA
#undef PG8_WAIT_V
#undef PG8_WAIT_L
#undef PG8_BAR
#undef PG8_SCHED
#undef PG8_GOFF
#undef PG8_GRAW
#undef PG8_GCALC
}
}

template <int EPI> __device__ __forceinline__ void ph_gemm_mfma(const P& p, int l, unsigned char* smem) {
    PG8_LAS unsigned char* lds = (PG8_LAS unsigned char*)smem;
    const int G = gridDim.x, bx = blockIdx.x;
    if (EPI == EPI_INPROJ) {
        pg8::Gemm g{(const bf16_t*)(p.ws + WS_XN), (const bf16_t*)(p.ws + WS_WIN) + (size_t)l * NWIN * 1024, 1024, 0, nullptr};
        pg8::StaticOrder S; S.init(M, NWIN, G, bx);
        pg8::EpiInproj E{(bf16_t*)(p.ws + WS_R1), (bf16_t*)(p.ws + WS_MVO), (bf16_t*)(p.ws + WS_AQKV)};
        pg8::gemm_phase<pg8::EpiInproj, pg8::StaticOrder, false>(lds, g, S, E);
    } else if (EPI == EPI_OUTPROJ) {
        pg8::Gemm g{(const bf16_t*)(p.ws + WS_R1), (const bf16_t*)(p.ws + WS_WOUT) + (size_t)l * 1024 * 1024, 1024, 0, nullptr};
        pg8::StaticOrder S; S.init(M, 1024, G, bx);
        pg8::EpiOutproj E{(const bf16_t*)p.out, (bf16_t*)(p.ws + WS_XB)};
        pg8::gemm_phase<pg8::EpiOutproj, pg8::StaticOrder, false>(lds, g, S, E);
    } else {
        PG8_LAS int* ps = (PG8_LAS int*)(lds + LDS_MISC);
        if (ltid() == 0) { const unsigned* cnt = (const unsigned*)(p.ws + WS_CTL) + CW_CNT + l * 32; int acc = 0; for (int e = 0; e < 32; ++e) { ps[e] = acc; acc += ((int)cnt[e] + 255) & ~255; } ps[32] = acc; }
        __syncthreads();
        const int vcu = (G % 8 == 0) ? (bx % 8) * (G / 8) + bx / 8 : bx;
        pg8::MoeOrder S{ps, G, vcu, bx};
        if (EPI == EPI_MOE1) {
            pg8::Gemm g{(const bf16_t*)(p.ws + WS_XN), (const bf16_t*)(p.ws + WS_W13), 1024, (size_t)1024 * 1024 * 2, (const int*)(p.ws + WS_SLOT)};
            pg8::EpiMoe1 E{(bf16_t*)(p.ws + WS_HID)};
            pg8::gemm_phase<pg8::EpiMoe1, pg8::MoeOrder, true>(lds, g, S, E);
        } else {
            pg8::Gemm g{(const bf16_t*)(p.ws + WS_HID), (const bf16_t*)(p.ws + WS_W2), 512, (size_t)1024 * 512 * 2, nullptr};
            pg8::EpiMoe2 E{(bf16_t*)(p.ws + WS_Y), (const int*)(p.ws + WS_SLOT), (const float*)(p.ws + WS_SLOTW)};
            pg8::gemm_phase<pg8::EpiMoe2, pg8::MoeOrder, false>(lds, g, S, E);
        }
    }
}


#define LAS __attribute__((address_space(3)))
constexpr int CW_BAR = 4096;
#define XB_TMO      128
#define XB_XCNT(j)  (256  + 64 * (j))
#define XB_XSUB(j)  (1280 + 64 * (j))
#define XB_XGEN(j)  (2304 + 64 * (j))
#define XB_TOP      3328
#define XB_TOPGEN   3392
#define XCD_BAR_WORDS 3456
#define XB_SPIN_CAP (1u << 18)

__device__ __forceinline__ unsigned xb_ld(unsigned* p)              { return __hip_atomic_load(p, __ATOMIC_RELAXED, __HIP_MEMORY_SCOPE_AGENT); }
__device__ __forceinline__ unsigned xb_add(unsigned* p, unsigned v) { return __hip_atomic_fetch_add(p, v, __ATOMIC_RELAXED, __HIP_MEMORY_SCOPE_AGENT); }
__device__ __forceinline__ unsigned xb_xcc_id() { return (unsigned)__builtin_amdgcn_s_getreg((3 << 11) | 20) & 0xFu; }
#define XB_SPIN(cond, bar) do { unsigned _sp = 0; while (cond) { __builtin_amdgcn_s_sleep(1); \
    if ((++_sp & 255u) == 0u) { if (xb_ld(&(bar)[XB_TMO])) break; if (_sp > XB_SPIN_CAP) { atomicAdd(&(bar)[XB_TMO], 1u); break; } } } } while (0)

struct XcdBarrier {
    unsigned* bar; unsigned x;
    volatile LAS unsigned* st;
};

__device__ __forceinline__ XcdBarrier xcd_barrier_post(unsigned* bar, volatile LAS unsigned* st) {
    XcdBarrier b; b.bar = bar; b.x = xb_xcc_id(); b.st = st;
    if (threadIdx.x == 0) (void)xb_add(&bar[XB_XCNT(b.x)], 1u);
    return b;
}
__device__ __forceinline__ void xcd_barrier_complete(unsigned* bar, unsigned x, unsigned& nloc, unsigned& nx) {
    const unsigned G = gridDim.x * gridDim.y * gridDim.z;
    unsigned sum, cnt, mine, sp = 0u;
    for (;;) {
        sum = 0u; cnt = 0u; mine = 0u;
#pragma unroll
        for (unsigned j = 0; j < 16; ++j) { const unsigned c = xb_ld(&bar[XB_XCNT(j)]); sum += c; cnt += (c > 0u) ? 1u : 0u; mine = (j == x) ? c : mine; }
        if (sum == G) break;
        __builtin_amdgcn_s_sleep(1);
        if ((++sp & 255u) == 0u) { if (xb_ld(&bar[XB_TMO])) break; if (sp > XB_SPIN_CAP) { atomicAdd(&bar[XB_TMO], 1u); break; } }
    }
    nloc = mine > 0u ? mine : 1u; nx = cnt > 0u ? cnt : 1u;
}

__device__ __forceinline__ void xcd_barrier(const XcdBarrier& b) {
    asm volatile("s_waitcnt vmcnt(0)" ::: "memory");
    __syncthreads();
    if (threadIdx.x == 0) {
        unsigned* bar = b.bar;
        __builtin_amdgcn_s_waitcnt(0);
        unsigned nloc = b.st[0], nx = b.st[1];
        if (nloc == 0u) { xcd_barrier_complete(bar, b.x, nloc, nx); b.st[0] = nloc; b.st[1] = nx; }
        const unsigned old = xb_add(&bar[XB_XSUB(b.x)], 1u);
        const unsigned gen = old / nloc;
        if (old + 1u == (gen + 1u) * nloc) {
            __builtin_amdgcn_fence(__ATOMIC_RELEASE, "agent");
            asm volatile("s_waitcnt vmcnt(0)" ::: "memory");
            const unsigned og = xb_add(&bar[XB_TOP], 1u);
            const unsigned tg = og / nx;
            if (og + 1u == (tg + 1u) * nx) xb_add(&bar[XB_TOPGEN], 1u);
            else XB_SPIN(xb_ld(&bar[XB_TOPGEN]) == tg, bar);
            __builtin_amdgcn_fence(__ATOMIC_ACQUIRE, "agent");
            xb_add(&bar[XB_XGEN(b.x)], 1u);
            asm volatile("s_waitcnt vmcnt(0)" ::: "memory");
        } else {
            XB_SPIN(xb_ld(&bar[XB_XGEN(b.x)]) == gen, bar);
            __builtin_amdgcn_fence(__ATOMIC_ACQUIRE, "agent");
            asm volatile("s_waitcnt vmcnt(0)" ::: "memory");
        }
    }
    __syncthreads();
}

namespace cg = cooperative_groups;
#ifndef REP_KIND
#define REP_KIND -1
#define REP_L 0
#define REP_N 0
#endif
#ifndef MFMA_MLSTM
#define MFMA_MLSTM 1
#endif
#ifndef MFMA_ATTN
#define MFMA_ATTN 1
#endif
#ifndef MFMA_INPROJ
#define MFMA_INPROJ 1
#endif
#ifndef MFMA_OUTPROJ
#define MFMA_OUTPROJ 1
#endif
#ifndef MFMA_MOE1
#define MFMA_MOE1 1
#endif
#ifndef MFMA_MOE2
#define MFMA_MOE2 1
#endif
constexpr int LDS_BYTES = 163840;
enum { PH_ROW1 = 0, PH_INPROJ, PH_PREP, PH_M2, PH_MIX, PH_OUTPROJ, PH_ROW2, PH_SCATTER, PH_MOE1, PH_MOE2, PH_ROW3 };
constexpr int NPL = 10, NPHASE = 2 * NPL + 1;
__device__ __forceinline__ void phase_decode(int ph, int& kind, int& l) {
    if (ph == NPHASE - 1) { kind = PH_ROW3; l = 0; } else { l = ph / NPL; kind = ph % NPL; }
}
struct Args { const float* in[19]; float* out; unsigned char* ws; int ph_lo, ph_hi; };
__global__ void __launch_bounds__(512) k_mega(Args a) {
    extern __shared__ __attribute__((aligned(16))) unsigned char smem[];
    cg::grid_group grid = cg::this_grid();
    volatile LAS unsigned* xst = (volatile LAS unsigned*)((LAS unsigned char*)smem + LDS_BYTES - 64);
    if (threadIdx.x < 2) xst[threadIdx.x] = 0u;
    if (threadIdx.x == 0) {
#pragma unroll
        for (int i = 0; i < 19; ++i) ((unsigned long long*)(smem + LDS_PTAB))[i] = (unsigned long long)a.in[i];
    }
    __syncthreads();
    if (blockIdx.x == 0) { unsigned* c = (unsigned*)(a.ws + WS_CTL);
#pragma unroll 4
        for (int i = threadIdx.x; i < 16384; i += 512) c[i] = 0u; }
    XcdBarrier xbar; xbar.bar = nullptr; xbar.x = 0u; xbar.st = xst;
    for (int ph = a.ph_lo; ph < a.ph_hi; ++ph) {
        int kind, l; phase_decode(ph, kind, l);
        int nrep = (kind == REP_KIND && l == REP_L) ? 1 + REP_N : 1;
        for (int rep = 0; rep < nrep; ++rep) {
        unsigned z; asm volatile("s_mov_b32 %0, 0" : "=s"(z));
        P p; p.out = a.out + z; p.ws = a.ws + z; p.tab = smem + LDS_PTAB;
        switch (kind) {
        case PH_ROW1:
            if (l == 0) {
                ph_prep_small(p); ph_router_image(p);
                for (int ll = 0; ll < 2; ++ll) { ph_transpose<0>(p, ll, smem); ph_transpose<1>(p, ll, smem); }
                __syncthreads();
                rowpass<1, false>(p, l, gridDim.x, blockIdx.x, smem);
            } else { rowpass<1, true>(p, l, gridDim.x, blockIdx.x, smem, rep + 1 == nrep); }
            break;
        case PH_INPROJ: ph_gemm_mfma<EPI_INPROJ>(p, l, smem); break;
        case PH_PREP: ph_prep(p, l, smem); break;
        case PH_M2: ml::ph_m2(p, l, smem); break;
        case PH_MIX: ml::ph_m3(p, l, smem); __syncthreads(); ph_attn_mfma(p, l, smem); break;
        case PH_OUTPROJ: ph_gemm_mfma<EPI_OUTPROJ>(p, l, smem); break;
        case PH_ROW2: ph_row2_mfma(p, l, smem, rep + 1 == nrep); break;
        case PH_SCATTER: ph_scatter(p, l, smem); break;
        case PH_MOE1: ph_gemm_mfma<EPI_MOE1>(p, l, smem); break;
        case PH_MOE2: ph_gemm_mfma<EPI_MOE2>(p, l, smem); break;
        case PH_ROW3: rowpass<3, true>(p, l, gridDim.x, blockIdx.x, smem, rep + 1 == nrep); break;
        }
        if (rep + 1 < nrep) __syncthreads();
        }
        if (ph + 1 < a.ph_hi) { if (ph == a.ph_lo) { grid.sync(); xbar = xcd_barrier_post((unsigned*)(a.ws + WS_CTL) + CW_BAR, xst); } else xcd_barrier(xbar); }
    }
}

extern "C" void kernel_launch(void* const* d_in, const int* in_sizes, int n_in, void* d_out, int out_size, void* d_ws, size_t ws_size, hipStream_t stream) {
    static int grid = 0;
    if (grid == 0) {
        if (n_in != 19 || ws_size < WS_END) { fprintf(stderr, "kernel_launch: unexpected n_in %d / ws_size %zu\n", n_in, ws_size); grid = -1; return; }
        int dev = 0, cus = 0, per_cu = 0;
        (void)hipGetDevice(&dev); (void)hipDeviceGetAttribute(&cus, hipDeviceAttributeMultiprocessorCount, dev);
        if (hipFuncSetAttribute((const void*)k_mega, hipFuncAttributeMaxDynamicSharedMemorySize, LDS_BYTES) != hipSuccess) { fprintf(stderr, "kernel_launch: hipFuncSetAttribute failed\n"); grid = -1; return; }
        if (hipOccupancyMaxActiveBlocksPerMultiprocessor(&per_cu, (const void*)k_mega, 512, LDS_BYTES) != hipSuccess || per_cu < 1) { fprintf(stderr, "kernel_launch: occupancy query failed (%d)\n", per_cu); grid = -1; return; }
        grid = cus * per_cu;
        fprintf(stderr, "kernel_launch: cus %d per_cu %d grid %d ws %zu\n", cus, per_cu, grid, ws_size);
    }
    if (grid < 0) return;
    Args a{};
    for (int i = 0; i < 19; ++i) a.in[i] = (const float*)d_in[i];
    a.out = (float*)d_out; a.ws = (unsigned char*)d_ws;
    a.ph_lo = 0; a.ph_hi = NPHASE;
    void* args[] = {&a};
    hipError_t e = hipLaunchCooperativeKernel((const void*)k_mega, dim3(grid), dim3(512), args, LDS_BYTES, stream);
    if (e != hipSuccess) fprintf(stderr, "kernel_launch: cooperative launch failed: %s (grid %d)\n", hipGetErrorString(e), grid);
}
```
